# Optimizing an MI355X kernel written in HIP

```python
import jax
import jax.numpy as jnp
from jax import lax
import numpy as np

D_MODEL = 1024
BATCH = 8
SEQ = 8192
DEPTH = 1

ATT_HEADS = 8
ATT_KV_HEADS = 2
ATT_HEAD_DIM = 64
WINDOW = 128
ATT_BLOCK = 128
RET_HEADS = 4
RET_QK_DIM = 64
RET_V_DIM = 128
RET_CHUNK = 128
MEM_LEN = 256
MEM_HEADS = 4
MEM_HEAD_DIM = 128
PEER_HEADS = 8
PEER_N_KEYS = 128
PEER_N_EXPERTS = PEER_N_KEYS * PEER_N_KEYS
PEER_TOPK = 16
PEER_QUERY_DIM = 256
PEER_HALF = PEER_QUERY_DIM // 2
PEER_TOKEN_CHUNK = 128
N_BRANCHES = 3
ALPHA = (2.0 * DEPTH) ** 0.25
BETA = (8.0 * DEPTH) ** -0.25
LN_EPS = 1e-5

ATT_Q_WIDTH = ATT_HEADS * ATT_HEAD_DIM
ATT_KV_WIDTH = ATT_KV_HEADS * ATT_HEAD_DIM
RET_QK_WIDTH = RET_HEADS * RET_QK_DIM
RET_V_WIDTH = RET_HEADS * RET_V_DIM
MEM_WIDTH = MEM_HEADS * MEM_HEAD_DIM
GATE_WIDTH = N_BRANCHES * D_MODEL
IN_SIZES = (ATT_Q_WIDTH, ATT_KV_WIDTH, ATT_KV_WIDTH, RET_QK_WIDTH, RET_QK_WIDTH, RET_V_WIDTH, RET_V_WIDTH, MEM_WIDTH, GATE_WIDTH)
IN_WIDTH = sum(IN_SIZES)

kernel_name = "hybrid_swa_retention_mem_peer_deepnorm"

F32 = jnp.float32


def layer_norm(x, g, b):
    xf = x.astype(F32)
    mu = jnp.mean(xf, axis=-1, keepdims=True)
    var = jnp.mean(jnp.square(xf - mu), axis=-1, keepdims=True)
    y = (xf - mu) * lax.rsqrt(var + LN_EPS) * g.astype(F32) + b.astype(F32)
    return y.astype(x.dtype)


def sliding_window_gqa(q, k, v, sinks):
    b, s = q.shape[0], q.shape[1]
    nb = s // ATT_BLOCK
    rep = ATT_HEADS // ATT_KV_HEADS
    qb = q.reshape(b, nb, ATT_BLOCK, ATT_KV_HEADS, rep, ATT_HEAD_DIM)

    def band(t):
        tb = t.reshape(b, nb, ATT_BLOCK, ATT_KV_HEADS, ATT_HEAD_DIM)
        prev = jnp.pad(tb[:, :-1], ((0, 0), (1, 0), (0, 0), (0, 0), (0, 0)))
        return jnp.concatenate([prev, tb], axis=2)

    kb, vb = band(k), band(v)
    logits = jnp.einsum('bnqgrd,bnkgd->bngrqk', qb, kb).astype(F32) * (ATT_HEAD_DIM ** -0.5)
    qi = jnp.arange(ATT_BLOCK)[:, None]
    kj = jnp.arange(2 * ATT_BLOCK)[None, :]
    dist = qi + ATT_BLOCK - kj
    in_window = (dist >= 0) & (dist < WINDOW)
    has_prev = jnp.arange(nb)[:, None, None] > 0
    mask = in_window[None] & (has_prev | (kj >= ATT_BLOCK)[None])
    logits = jnp.where(mask[None, :, None, None], logits, -jnp.inf)
    sink = sinks.astype(F32).reshape(ATT_KV_HEADS, rep)[None, None, :, :, None, None]
    m = jnp.maximum(jnp.max(logits, axis=-1, keepdims=True), sink)
    p = jnp.exp(logits - m)
    p = p / (jnp.sum(p, axis=-1, keepdims=True) + jnp.exp(sink - m))
    out = jnp.einsum('bngrqk,bnkgd->bnqgrd', p.astype(v.dtype), vb)
    return out.reshape(b, s, ATT_Q_WIDTH)


def retention_rotate(t, pos):
    half = RET_QK_DIM // 2
    theta = 1.0 / (10000.0 ** jnp.linspace(0.0, 1.0, half, dtype=F32))
    ang = pos[:, None] * theta[None, :]
    cos = jnp.cos(ang)[None, :, None, :]
    sin = jnp.sin(ang)[None, :, None, :]
    t1, t2 = t[..., :half], t[..., half:]
    return jnp.concatenate([t1 * cos - t2 * sin, t1 * sin + t2 * cos], axis=-1)


def chunkwise_retention(q, k, v):
    b, s = q.shape[0], q.shape[1]
    nc = s // RET_CHUNK
    log_gamma = jnp.log(1.0 - 2.0 ** (-5.0 - jnp.arange(RET_HEADS, dtype=F32)))
    k = k * (RET_QK_DIM ** -0.5)
    qc = q.reshape(b, nc, RET_CHUNK, RET_HEADS, RET_QK_DIM)
    kc = k.reshape(b, nc, RET_CHUNK, RET_HEADS, RET_QK_DIM)
    vc = v.reshape(b, nc, RET_CHUNK, RET_HEADS, RET_V_DIM)
    i = jnp.arange(RET_CHUNK, dtype=F32)
    diff = i[:, None] - i[None, :]
    decay_in = jnp.where(diff >= 0, jnp.exp(log_gamma[:, None, None] * jnp.maximum(diff, 0.0)), 0.0)
    inner = jnp.einsum('bnihd,bnjhd->bnhij', qc, kc) * decay_in
    o_in = jnp.einsum('bnhij,bnjhe->bnihe', inner, vc)
    w_k = jnp.exp(log_gamma[:, None] * (RET_CHUNK - 1.0 - i)[None, :])
    kv = jnp.einsum('bnjhd,bnjhe,hj->nbhde', kc, vc, w_k)
    chunk_decay = jnp.exp(log_gamma * RET_CHUNK)[None, :, None, None]

    def step(state, kv_n):
        return chunk_decay * state + kv_n, state

    init = jnp.zeros((b, RET_HEADS, RET_QK_DIM, RET_V_DIM), F32)
    _, states = lax.scan(step, init, kv)
    w_q = jnp.exp(log_gamma[:, None] * (i + 1.0)[None, :])
    o_x = jnp.einsum('bnihd,nbhde,hi->bnihe', qc, states, w_q)
    return (o_in + o_x).reshape(b, s, RET_HEADS, RET_V_DIM)


def head_group_norm(t, g):
    mu = jnp.mean(t, axis=-1, keepdims=True)
    var = jnp.mean(jnp.square(t - mu), axis=-1, keepdims=True)
    return (t - mu) * lax.rsqrt(var + LN_EPS) * g.astype(F32).reshape(RET_HEADS, RET_V_DIM)


def memory_cross_attention(q, mem, mem_ln_g, mem_ln_b, w_mem_kv):
    b, s = q.shape[0], q.shape[1]
    m_len = mem.shape[1]
    mkv = layer_norm(mem, mem_ln_g, mem_ln_b) @ w_mem_kv
    mk, mv = jnp.split(mkv, 2, axis=-1)
    mk = mk.reshape(b, m_len, MEM_HEADS, MEM_HEAD_DIM)
    mv = mv.reshape(b, m_len, MEM_HEADS, MEM_HEAD_DIM)
    qh = q.reshape(b, s, MEM_HEADS, MEM_HEAD_DIM)
    logits = jnp.einsum('bshd,bmhd->bhsm', qh, mk).astype(F32) * (MEM_HEAD_DIM ** -0.5)
    p = jax.nn.softmax(logits, axis=-1).astype(mv.dtype)
    return jnp.einsum('bhsm,bmhd->bshd', p, mv).reshape(b, s, MEM_WIDTH)


def peer(h, w_peer_q, peer_sub_keys, peer_u, peer_v):
    b, s, d = h.shape
    n_chunks = (b * s) // PEER_TOKEN_CHUNK
    hc = h.reshape(n_chunks, PEER_TOKEN_CHUNK, d)

    def chunk(ht):
        t = ht.shape[0]
        q = (ht @ w_peer_q).reshape(t, PEER_HEADS, 2, PEER_HALF)
        sc = jnp.einsum('thpd,hpnd->thpn', q, peer_sub_keys).astype(F32)
        sv, si = lax.top_k(sc, PEER_TOPK)
        cand = (sv[:, :, 0, :, None] + sv[:, :, 1, None, :]).reshape(t, PEER_HEADS, PEER_TOPK * PEER_TOPK)
        cidx = (si[:, :, 0, :, None] * PEER_N_KEYS + si[:, :, 1, None, :]).reshape(t, PEER_HEADS, PEER_TOPK * PEER_TOPK)
        top_s, pos = lax.top_k(cand, PEER_TOPK)
        eidx = jnp.take_along_axis(cidx, pos, axis=-1)
        gate = jax.nn.softmax(top_s, axis=-1).astype(ht.dtype)
        u = peer_u[eidx]
        act = jax.nn.gelu(jnp.einsum('thkd,td->thk', u, ht), approximate=False)
        return jnp.einsum('thk,thkd->td', gate * act, peer_v[eidx])

    out = lax.map(chunk, hc)
    return out.reshape(b, s, d)


def hybrid_layer(x, mem, w_in, b_in, attn_sinks, ret_gn_g, mem_ln_g, mem_ln_b, w_mem_kv,
                 w_branch_attn, w_branch_ret, w_branch_mem, w_out, ln1_g, ln1_b,
                 w_peer_q, peer_sub_keys, peer_u, peer_v, ln2_g, ln2_b):
    b, s, d = x.shape
    pos = jnp.arange(s, dtype=F32)
    proj = x @ w_in + b_in
    offsets = np.cumsum(IN_SIZES)[:-1].tolist()
    aq, ak, av, rq, rk, rv, rg, mq, gates = jnp.split(proj, offsets, axis=-1)

    br_a = sliding_window_gqa(aq.reshape(b, s, ATT_HEADS, ATT_HEAD_DIM),
                              ak.reshape(b, s, ATT_KV_HEADS, ATT_HEAD_DIM),
                              av.reshape(b, s, ATT_KV_HEADS, ATT_HEAD_DIM), attn_sinks)

    rq = retention_rotate(rq.reshape(b, s, RET_HEADS, RET_QK_DIM).astype(F32), pos)
    rk = retention_rotate(rk.reshape(b, s, RET_HEADS, RET_QK_DIM).astype(F32), pos)
    ret = chunkwise_retention(rq, rk, rv.reshape(b, s, RET_HEADS, RET_V_DIM).astype(F32))
    ret = head_group_norm(ret, ret_gn_g).reshape(b, s, RET_V_WIDTH).astype(x.dtype)
    br_b = ret * jax.nn.silu(rg)

    br_c = memory_cross_attention(mq, mem, mem_ln_g, mem_ln_b, w_mem_kv)

    g = jax.nn.sigmoid(gates).reshape(b, s, N_BRANCHES, d)
    merged = (g[:, :, 0] * (br_a @ w_branch_attn) + g[:, :, 1] * (br_b @ w_branch_ret)
              + g[:, :, 2] * (br_c @ w_branch_mem))
    h = layer_norm(ALPHA * x + merged @ w_out, ln1_g, ln1_b)

    y = layer_norm(ALPHA * h + peer(h, w_peer_q, peer_sub_keys, peer_u, peer_v), ln2_g, ln2_b)
    return y


def setup_inputs(seed: int = 0) -> dict:
    key = jax.random.key(seed)
    ks = jax.random.split(key, 24)

    def nrm(k, shape, scale):
        return jax.random.normal(k, shape, F32) * scale

    L = DEPTH
    return {
        "x": nrm(ks[0], (BATCH, SEQ, D_MODEL), 1.0),
        "mem": nrm(ks[1], (BATCH, MEM_LEN, D_MODEL), 1.0),
        "w_in": nrm(ks[2], (L, D_MODEL, IN_WIDTH), D_MODEL ** -0.5),
        "b_in": nrm(ks[3], (L, IN_WIDTH), 0.02),
        "attn_sinks": nrm(ks[4], (L, ATT_HEADS), 0.5),
        "ret_gn_g": 1.0 + nrm(ks[5], (L, RET_V_WIDTH), 0.02),
        "mem_ln_g": 1.0 + nrm(ks[6], (L, D_MODEL), 0.02),
        "mem_ln_b": nrm(ks[7], (L, D_MODEL), 0.02),
        "w_mem_kv": nrm(ks[8], (L, D_MODEL, 2 * MEM_WIDTH), D_MODEL ** -0.5),
        "w_branch_attn": nrm(ks[9], (L, ATT_Q_WIDTH, D_MODEL), BETA * ATT_Q_WIDTH ** -0.5),
        "w_branch_ret": nrm(ks[10], (L, RET_V_WIDTH, D_MODEL), BETA * RET_V_WIDTH ** -0.5),
        "w_branch_mem": nrm(ks[11], (L, MEM_WIDTH, D_MODEL), BETA * MEM_WIDTH ** -0.5),
        "w_out": nrm(ks[12], (L, D_MODEL, D_MODEL), BETA * D_MODEL ** -0.5),
        "ln1_g": 1.0 + nrm(ks[13], (L, D_MODEL), 0.02),
        "ln1_b": nrm(ks[14], (L, D_MODEL), 0.02),
        "w_peer_q": nrm(ks[15], (L, D_MODEL, PEER_HEADS * PEER_QUERY_DIM), D_MODEL ** -0.5),
        "peer_sub_keys": nrm(ks[16], (L, PEER_HEADS, 2, PEER_N_KEYS, PEER_HALF), PEER_HALF ** -0.5),
        "peer_u": nrm(ks[17], (L, PEER_N_EXPERTS, D_MODEL), D_MODEL ** -0.5),
        "peer_v": nrm(ks[18], (L, PEER_N_EXPERTS, D_MODEL), BETA * PEER_HEADS ** -0.5),
        "ln2_g": 1.0 + nrm(ks[19], (L, D_MODEL), 0.02),
        "ln2_b": nrm(ks[20], (L, D_MODEL), 0.02),
    }


def reference(x, mem, w_in, b_in, attn_sinks, ret_gn_g, mem_ln_g, mem_ln_b, w_mem_kv,
              w_branch_attn, w_branch_ret, w_branch_mem, w_out, ln1_g, ln1_b,
              w_peer_q, peer_sub_keys, peer_u, peer_v, ln2_g, ln2_b):
    for l in range(DEPTH):
        x = hybrid_layer(x, mem, w_in[l], b_in[l], attn_sinks[l], ret_gn_g[l], mem_ln_g[l], mem_ln_b[l],
                         w_mem_kv[l], w_branch_attn[l], w_branch_ret[l], w_branch_mem[l], w_out[l],
                         ln1_g[l], ln1_b[l], w_peer_q[l], peer_sub_keys[l], peer_u[l], peer_v[l],
                         ln2_g[l], ln2_b[l])
    return x
```

```cpp
#include <hip/hip_runtime.h>
#include <cstdio>
#include <cstdint>
#include <cmath>
namespace pg8 {
#define PG8_LAS __attribute__((address_space(3)))
typedef unsigned short bf16_t;
typedef short bf16x8 __attribute__((ext_vector_type(8)));
typedef float f32x4 __attribute__((ext_vector_type(4)));
typedef unsigned u32x4 __attribute__((ext_vector_type(4)));
constexpr int BM = 256, BK = 64, HALF = 128, HTB = HALF * BK * 2  , STAGE_BYTES = 8 * HTB, NXCD = 8, WGM = 8;

__host__ __device__ __forceinline__ int lds_byte(int r, int c) { const int st = (r >> 4) * 2 + (c >> 5), rr = r & 15, cc = c & 31, ob = rr * 64 + cc * 2; return st * 1024 + (ob ^ (((ob >> 9) & 1) << 5)); }
__host__ __device__ __forceinline__ void stage_rc(int b, int& R, int& C) { const int st = b / 1024, sb = b % 1024, swz = sb ^ (((sb >> 9) & 1) << 5); R = (st >> 1) * 16 + swz / 64; C = (st & 1) * 32 + (swz % 64) / 2; }
__host__ __device__ __forceinline__ int perm32(int rho) { const int n = rho >> 4, i = rho & 15; return 8 * (i >> 2) + 4 * n + (i & 3); }

struct Unit { int pm, pn; };
struct Gemm { const bf16_t* A; const bf16_t* Bt; int M, N, K; };

struct StaticOrder {
    int nM, nN, nwg, G, c;
    __host__ __device__ void init(int M, int N, int G_, int c_) { nM = M / BM; nN = N / BM; nwg = nM * nN; G = G_; c = c_; }
    __host__ __device__ bool next(int i, Unit& u) const {
        const long L = (long)i * G + c; if (L >= nwg) return false;
        int wgid = (int)L; { const int q = nwg / NXCD, r = nwg % NXCD, xcd = wgid % NXCD, off = wgid / NXCD; wgid = (xcd < r ? xcd * (q + 1) : r * (q + 1) + (xcd - r) * q) + off; }
        const int nig = WGM * nN, gid = wgid / nig, fm = gid * WGM, gsz = (nM - fm) < WGM ? (nM - fm) : WGM;
        u.pm = fm + ((wgid % nig) % gsz); u.pn = (wgid % nig) / gsz; return true;
    }
    __device__ __forceinline__ void a_ready(const Unit&) const {}
    __device__ __forceinline__ void done(const Unit&) const {}
};

__device__ __forceinline__ unsigned cvt_pk_bf16(float lo, float hi) { unsigned r; asm volatile("v_cvt_pk_bf16_f32 %0, %1, %2" : "=v"(r) : "v"(lo), "v"(hi)); return r; }
typedef float f32x2 __attribute__((ext_vector_type(2)));
__device__ __forceinline__ f32x2 gelu_pk(f32x2 v) {
    const f32x2 av = __builtin_elementwise_abs(v), d = av * 0.2316418882f + 1.0f;
    f32x2 t; t.x = __builtin_amdgcn_rcpf(d.x); t.y = __builtin_amdgcn_rcpf(d.y);
    f32x2 q = t * 0.5307027145f + (-0.7265760135f); q = q * t + 0.7107068705f; q = q * t + (-0.142248368f); q = q * t + 0.127414796f; q = q * t;
    const f32x2 s = (v * v) * (-0.72134752044f);
    f32x2 e; e.x = __builtin_amdgcn_exp2f(s.x); e.y = __builtin_amdgcn_exp2f(s.y);
    const f32x2 m = v * (q * e), r = v - m;
    f32x2 o; o.x = v.x < 0.f ? m.x : r.x; o.y = v.y < 0.f ? m.y : r.y; return o;
}

template <int ACT  > struct EpiBf16 {
    static constexpr bool PERM = true, AFTER_DRAIN = false; static_assert(ACT == 0 || ACT == 1, "EpiBf16: ACT is 0 (none) or 1 (gelu_pk)");
    bf16_t* O; int ldc; const float* bias; int split_cols; size_t split_stride; float scale0;
    __device__ __forceinline__ void operator()(const f32x4 (&acc)[2][2][4][2], const Unit& u, int wr, int wc, int fr, int fq) const {
        const int row0 = u.pm * BM + wr * 64 + fr; int colt = u.pn * BM; bf16_t* base = O;
        float sc = 1.f; if (split_cols) { const int t = colt / split_cols; base += (size_t)t * split_stride; colt -= t * split_cols; if (t == 0) sc = scale0; }
        const int col0 = colt + wc * 32 + 8 * fq, bcol0 = u.pn * BM + wc * 32 + 8 * fq;
        f32x4 bv[2][2];
#pragma unroll
        for (int bj = 0; bj < 2; ++bj)
#pragma unroll
            for (int n = 0; n < 2; ++n) bv[bj][n] = bias ? *(const f32x4*)(bias + bcol0 + bj * HALF + 4 * n) : (f32x4){0.f, 0.f, 0.f, 0.f};
#pragma unroll
        for (int ai = 0; ai < 2; ++ai)
#pragma unroll
            for (int m = 0; m < 4; ++m) { bf16_t* rowp = base + (size_t)(row0 + ai * HALF + m * 16) * ldc + col0;
#pragma unroll
                for (int bj = 0; bj < 2; ++bj) { f32x4 v0 = acc[ai][bj][m][0] + bv[bj][0], v1 = acc[ai][bj][m][1] + bv[bj][1];
                    if (ACT == 1) { f32x2 a = gelu_pk((f32x2){v0[0], v0[1]}), b = gelu_pk((f32x2){v0[2], v0[3]}), c = gelu_pk((f32x2){v1[0], v1[1]}), d = gelu_pk((f32x2){v1[2], v1[3]});
                        v0 = (f32x4){a.x, a.y, b.x, b.y}; v1 = (f32x4){c.x, c.y, d.x, d.y}; }
                    v0 = v0 * sc; v1 = v1 * sc; u32x4 w; w.x = cvt_pk_bf16(v0[0], v0[1]); w.y = cvt_pk_bf16(v0[2], v0[3]); w.z = cvt_pk_bf16(v1[0], v1[1]); w.w = cvt_pk_bf16(v1[2], v1[3]);
                    *(u32x4*)(rowp + bj * HALF) = w; } }
    }
};
template <class Epi, class Sched, bool ALIGN_EPI = false, bool SP2 = false>
__device__ __forceinline__ void gemm_phase(PG8_LAS unsigned char* lds, const Gemm g, const Sched& S, const Epi& E) {
    const int tid = threadIdx.x, wid = __builtin_amdgcn_readfirstlane(tid >> 6), lane = tid & 63, wr = wid >> 2, wc = wid & 3, fr = lane & 15, fq = lane >> 4;
    const int K = g.K, nt = K / BK;
    unsigned voffA[2], voffB[2];
#pragma unroll
    for (int i = 0; i < 2; ++i) { int R, C; stage_rc(tid * 16 + i * 8192, R, C); const int Rb = Epi::PERM ? ((R & ~31) + perm32(R & 31)) : R;
        voffA[i] = (unsigned)(R * K + C) * 2u; voffB[i] = (unsigned)(Rb * K + C) * 2u; }
    const size_t kstep = (size_t)(BK * 2);
    const size_t hstep = (size_t)HALF * K * 2;
    const size_t tstep = 2 * hstep;
    const unsigned ldsw = (unsigned)wid * 1024u;
    const int aoff = lds_byte(wr * 64 + fr, fq * 8), boff = lds_byte(wc * 32 + fr, fq * 8);
#define PG8_SA(b, h) (((b) * 2 + (h)) * HTB)
#define PG8_SB(b, h) ((4 + (b) * 2 + (h)) * HTB)
#define PG8_STAGE(bufoff, gbase, voff) do { _Pragma("unroll") for (int _i = 0; _i < 2; ++_i) \
        __builtin_amdgcn_global_load_lds((const unsigned*)((const char*)(gbase) + (voff)[_i]), (PG8_LAS unsigned*)(lds + (bufoff) + ldsw + _i * 8192), 16, 0, 0); } while (0)
#define PG8_LDA(dst, b, h) do { _Pragma("unroll") for (int m = 0; m < 4; ++m) _Pragma("unroll") for (int k = 0; k < 2; ++k) dst[m][k] = *(const PG8_LAS bf16x8*)(lds + PG8_SA(b, h) + aoff + m * 2048 + k * 1024); } while (0)
#define PG8_LDB(dst, b, h) do { _Pragma("unroll") for (int n = 0; n < 2; ++n) _Pragma("unroll") for (int k = 0; k < 2; ++k) dst[n][k] = *(const PG8_LAS bf16x8*)(lds + PG8_SB(b, h) + boff + n * 2048 + k * 1024); } while (0)
#define PG8_MMA(ai, bj, At, Bt) do { __builtin_amdgcn_s_setprio(1); _Pragma("unroll") for (int m = 0; m < 4; ++m) _Pragma("unroll") for (int n = 0; n < 2; ++n) _Pragma("unroll") for (int k = 0; k < 2; ++k) \
        acc[ai][bj][m][n] = __builtin_amdgcn_mfma_f32_16x16x32_bf16(Bt[n][k], At[m][k], acc[ai][bj][m][n], 0, 0, 0); __builtin_amdgcn_s_setprio(0); } while (0)
#define PG8_WAIT_V(n) asm volatile("s_waitcnt vmcnt(" #n ")" ::: "memory")
#define PG8_WAIT_L(n) asm volatile("s_waitcnt lgkmcnt(" #n ")" ::: "memory")
#define PG8_BAR __builtin_amdgcn_s_barrier()
#define PG8_SCHED __builtin_amdgcn_sched_barrier(0)
    Unit cur, nxt; int ui = 0;
    if (!S.next(0, cur)) return;
    f32x4 acc[2][2][4][2];
#pragma unroll
    for (int a = 0; a < 2; ++a)
#pragma unroll
        for (int b = 0; b < 2; ++b)
#pragma unroll
            for (int m = 0; m < 4; ++m)
#pragma unroll
                for (int n = 0; n < 2; ++n) acc[a][b][m][n] = (f32x4){0.f, 0.f, 0.f, 0.f};
    bf16x8 At[4][2], B0[2][2], B1[2][2];
    const char* cA = (const char*)g.A + (size_t)cur.pm * tstep; const char* cB = (const char*)g.Bt + (size_t)cur.pn * tstep;
    S.a_ready(cur);
    if constexpr (SP2) {
        PG8_STAGE(PG8_SB(0, 0), cB, voffB); PG8_STAGE(PG8_SB(0, 1), cB + hstep, voffB); PG8_STAGE(PG8_SA(0, 0), cA, voffA); PG8_STAGE(PG8_SA(0, 1), cA + hstep, voffA);
        if (wr == 1) PG8_BAR;
        PG8_WAIT_V(2); PG8_BAR;
        PG8_STAGE(PG8_SB(1, 0), cB + kstep, voffB); PG8_STAGE(PG8_SA(1, 0), cA + kstep, voffA); PG8_STAGE(PG8_SB(1, 1), cB + hstep + kstep, voffB);
        PG8_WAIT_V(6); PG8_BAR;
    } else {
        PG8_STAGE(PG8_SB(0, 0), cB, voffB); PG8_STAGE(PG8_SA(0, 0), cA, voffA); PG8_STAGE(PG8_SB(0, 1), cB + hstep, voffB); PG8_STAGE(PG8_SA(0, 1), cA + hstep, voffA);
        if (wr == 1) PG8_BAR;
        PG8_WAIT_V(4); PG8_BAR;
        PG8_STAGE(PG8_SB(1, 0), cB + kstep, voffB); PG8_STAGE(PG8_SA(1, 0), cA + kstep, voffA); PG8_STAGE(PG8_SB(1, 1), cB + hstep + kstep, voffB);
        PG8_WAIT_V(6); PG8_BAR;
    }
    for (;;) {
        const bool has_next = S.next(ui + 1, nxt);
        const char* nA = has_next ? (const char*)g.A + (size_t)nxt.pm * tstep : cA; const char* nB = has_next ? (const char*)g.Bt + (size_t)nxt.pn * tstep : cB;
        for (int t = 0; t < nt; t += 2) {
            const bool last = (t == nt - 2);
            const char* a1 = cA + (size_t)(t + 1) * kstep;
            const char* a2 = last ? nA : cA + (size_t)(t + 2) * kstep; const char* b2 = last ? nB : cB + (size_t)(t + 2) * kstep;
            const char* a3 = a2 + kstep; const char* b3 = b2 + kstep;
            if (last && has_next) S.a_ready(nxt);
            if constexpr (SP2) {
            PG8_LDB(B0, 0, 0); PG8_LDB(B1, 0, 1); PG8_SCHED; PG8_LDA(At, 0, 0); PG8_STAGE(PG8_SA(1, 1), a1 + hstep, voffA);
            PG8_WAIT_V(8); PG8_WAIT_L(0); PG8_BAR; PG8_MMA(0, 0, At, B0); PG8_MMA(0, 1, At, B1); PG8_BAR; PG8_SCHED;
            PG8_LDA(At, 0, 1); PG8_STAGE(PG8_SB(0, 0), b2, voffB); PG8_STAGE(PG8_SB(0, 1), b2 + hstep, voffB); PG8_STAGE(PG8_SA(0, 0), a2, voffA);
            PG8_WAIT_V(8); PG8_WAIT_L(0); PG8_BAR; PG8_MMA(1, 0, At, B0); PG8_MMA(1, 1, At, B1); PG8_BAR; PG8_SCHED;
            PG8_LDB(B0, 1, 0); PG8_LDB(B1, 1, 1); PG8_SCHED; PG8_LDA(At, 1, 0); PG8_STAGE(PG8_SA(0, 1), a2 + hstep, voffA);
            PG8_WAIT_V(8); PG8_WAIT_L(0); PG8_BAR; PG8_MMA(0, 0, At, B0); PG8_MMA(0, 1, At, B1); PG8_BAR; PG8_SCHED;
            PG8_LDA(At, 1, 1); PG8_STAGE(PG8_SB(1, 0), b3, voffB); PG8_STAGE(PG8_SB(1, 1), b3 + hstep, voffB); PG8_STAGE(PG8_SA(1, 0), a3, voffA);
            PG8_WAIT_V(8); PG8_WAIT_L(0); PG8_BAR; PG8_MMA(1, 0, At, B0); PG8_MMA(1, 1, At, B1); PG8_BAR; PG8_SCHED;
            } else {
            PG8_LDB(B0, 0, 0); PG8_SCHED; PG8_LDA(At, 0, 0); PG8_STAGE(PG8_SA(1, 1), a1 + hstep, voffA);
            PG8_WAIT_L(8); PG8_BAR; PG8_WAIT_L(0); PG8_MMA(0, 0, At, B0); PG8_BAR; PG8_SCHED;
            PG8_LDB(B1, 0, 1); PG8_STAGE(PG8_SB(0, 0), b2, voffB);
            PG8_BAR; PG8_WAIT_L(0); PG8_MMA(0, 1, At, B1); PG8_BAR;
            PG8_LDA(At, 0, 1); PG8_STAGE(PG8_SA(0, 0), a2, voffA);
            PG8_BAR; PG8_WAIT_L(0); PG8_MMA(1, 0, At, B0); PG8_BAR; PG8_SCHED;
            PG8_STAGE(PG8_SB(0, 1), b2 + hstep, voffB);
            PG8_WAIT_V(6); PG8_BAR; PG8_MMA(1, 1, At, B1); PG8_BAR;
            PG8_LDB(B0, 1, 0); PG8_SCHED; PG8_LDA(At, 1, 0); PG8_STAGE(PG8_SA(0, 1), a2 + hstep, voffA);
            PG8_WAIT_L(8); PG8_BAR; PG8_WAIT_L(0); PG8_MMA(0, 0, At, B0); PG8_BAR; PG8_SCHED;
            PG8_LDB(B1, 1, 1); PG8_STAGE(PG8_SB(1, 0), b3, voffB);
            PG8_BAR; PG8_WAIT_L(0); PG8_MMA(0, 1, At, B1); PG8_BAR;
            PG8_LDA(At, 1, 1); PG8_STAGE(PG8_SA(1, 0), a3, voffA);
            PG8_BAR; PG8_WAIT_L(0); PG8_MMA(1, 0, At, B0); PG8_BAR; PG8_SCHED;
            PG8_STAGE(PG8_SB(1, 1), b3 + hstep, voffB);
            PG8_WAIT_V(6); PG8_BAR; PG8_MMA(1, 1, At, B1); PG8_BAR;
            }
        }
        if constexpr (ALIGN_EPI) { if (wr == 0) PG8_BAR; }
        if constexpr (!Epi::AFTER_DRAIN) { E(acc, cur, wr, wc, fr, fq); S.done(cur); }
        if (!has_next) break;
#pragma unroll
        for (int a = 0; a < 2; ++a)
#pragma unroll
            for (int b = 0; b < 2; ++b)
#pragma unroll
                for (int m = 0; m < 4; ++m)
#pragma unroll
                    for (int n = 0; n < 2; ++n) acc[a][b][m][n] = (f32x4){0.f, 0.f, 0.f, 0.f};
        cur = nxt; cA = nA; cB = nB; ++ui;
        if constexpr (ALIGN_EPI) { if (wr == 1) PG8_BAR; }
    }
    PG8_WAIT_V(0);
    if constexpr (!ALIGN_EPI) { if (wr == 0) PG8_BAR; }
    PG8_BAR;
    if constexpr (Epi::AFTER_DRAIN) { E.fused(acc, cur, wr, wc, fr, fq, lds, wid, lane); S.done(cur); }
#undef PG8_SA
#undef PG8_SB
#undef PG8_STAGE
#undef PG8_LDA
#undef PG8_LDB
#undef PG8_MMA
#undef PG8_WAIT_V
#undef PG8_WAIT_L
#undef PG8_BAR
#undef PG8_SCHED
}
}
namespace pg8 {
__device__ __forceinline__ float bf_lo(unsigned u) { return __uint_as_float(u << 16); }
__device__ __forceinline__ float bf_hi(unsigned u) { return __uint_as_float(u & 0xffff0000u); }
__device__ __forceinline__ float sigmoidf_(float x) { return 1.0f / (1.0f + __expf(-x)); }
__device__ const float ROTC[32] = {1.591549431e-01f, 1.182463853e-01f, 8.785280159e-02f, 6.527146455e-02f, 4.849434518e-02f, 3.602955028e-02f, 2.676865702e-02f, 1.988814718e-02f, 1.477617640e-02f, 1.097816640e-02f, 8.156381877e-03f, 6.059897703e-03f, 4.502285539e-03f, 3.345035851e-03f, 2.485241052e-03f, 1.846444510e-03f, 1.371841708e-03f, 1.019228935e-03f, 7.572503565e-04f, 5.626097166e-04f, 4.179987378e-04f, 3.105579936e-04f, 2.307333939e-04f, 1.714265939e-04f, 1.273637795e-04f, 9.462669678e-05f, 7.030422448e-05f, 5.223350438e-05f, 3.880761077e-05f, 2.883265582e-05f, 2.142162388e-05f, 1.591549431e-05f};

struct EpiInProj {
    static constexpr bool PERM = true, AFTER_DRAIN = false;
    bf16_t *AQ, *AK, *AV, *RQ, *RK, *RV, *RG, *MQ, *G; const float* biasp;
    __device__ __forceinline__ void operator()(const f32x4 (&acc)[2][2][4][2], const Unit& u, int wr, int wc, int fr, int fq) const {
        const int pn = u.pn, row0 = u.pm * BM + wr * 64 + fr, cw = wc * 32 + 8 * fq;
#pragma unroll
        for (int bj = 0; bj < 2; ++bj) {
            const int ct = bj * HALF + cw;
            bf16_t* base; int ld, col, mode;
            if (pn < 2)       { base = AQ; ld = 512; col = pn * 256 + ct; mode = 0; }
            else if (pn == 2) { base = bj == 0 ? AK : AV; ld = 128; col = cw; mode = 0; }
            else if (pn == 3) { base = RQ; ld = 256; col = ct; mode = 1; }
            else if (pn == 4) { base = RK; ld = 256; col = ct; mode = 2; }
            else if (pn < 7)  { base = RV; ld = 512; col = (pn - 5) * 256 + ct; mode = 0; }
            else if (pn < 9)  { base = RG; ld = 512; col = (pn - 7) * 256 + ct; mode = 3; }
            else if (pn < 11) { base = MQ; ld = 512; col = (pn - 9) * 256 + ct; mode = 0; }
            else              { base = G; ld = 3072; col = (pn - 11) * 256 + ct; mode = 4; }
            const f32x4 b0 = *(const f32x4*)(biasp + pn * 256 + ct), b1 = *(const f32x4*)(biasp + pn * 256 + ct + 4);
            f32x4 rc = (f32x4){0.f, 0.f, 0.f, 0.f};
            if (mode == 1 || mode == 2) rc = *(const f32x4*)(ROTC + 4 * (4 * (wc & 1) + fq));
#pragma unroll
            for (int ai = 0; ai < 2; ++ai)
#pragma unroll
                for (int m = 0; m < 4; ++m) {
                    const int row = row0 + ai * HALF + m * 16;
                    f32x4 v0 = acc[ai][bj][m][0] + b0, v1 = acc[ai][bj][m][1] + b1;
                    if (mode == 1 || mode == 2) {
                        const float pos = (float)(row & 8191), sc = (mode == 2) ? 0.125f : 1.0f;
                        f32x4 o0, o1;
#pragma unroll
                        for (int e = 0; e < 4; ++e) {
                            float rev = pos * rc[e]; rev = rev - floorf(rev);
                            const float sn = __builtin_amdgcn_sinf(rev) * sc, cs = __builtin_amdgcn_cosf(rev) * sc;
                            o0[e] = v0[e] * cs - v1[e] * sn; o1[e] = v0[e] * sn + v1[e] * cs;
                        }
                        v0 = o0; v1 = o1;
                    } else if (mode == 3) {
#pragma unroll
                        for (int e = 0; e < 4; ++e) { v0[e] = v0[e] * sigmoidf_(v0[e]); v1[e] = v1[e] * sigmoidf_(v1[e]); }
                    } else if (mode == 4) {
#pragma unroll
                        for (int e = 0; e < 4; ++e) { v0[e] = sigmoidf_(v0[e]); v1[e] = sigmoidf_(v1[e]); }
                    }
                    u32x4 w; w.x = cvt_pk_bf16(v0[0], v0[1]); w.y = cvt_pk_bf16(v0[2], v0[3]); w.z = cvt_pk_bf16(v1[0], v1[1]); w.w = cvt_pk_bf16(v1[2], v1[3]);
                    *(u32x4*)(base + (size_t)row * ld + col) = w;
                }
        }
    }
};

struct EpiMkv {
    static constexpr bool PERM = true, AFTER_DRAIN = false;
    bf16_t *MK, *MVT;
    __device__ __forceinline__ void operator()(const f32x4 (&acc)[2][2][4][2], const Unit& u, int wr, int wc, int fr, int fq) const {
        const int row0 = u.pm * BM + wr * 64 + fr;
#pragma unroll
        for (int bj = 0; bj < 2; ++bj) {
            const int c0 = u.pn * 256 + bj * HALF + wc * 32 + 8 * fq;
#pragma unroll
            for (int ai = 0; ai < 2; ++ai)
#pragma unroll
                for (int m = 0; m < 4; ++m) {
                    const int row = row0 + ai * HALF + m * 16;
                    const f32x4 v0 = acc[ai][bj][m][0], v1 = acc[ai][bj][m][1];
                    if (u.pn < 2) {
                        u32x4 w; w.x = cvt_pk_bf16(v0[0], v0[1]); w.y = cvt_pk_bf16(v0[2], v0[3]); w.z = cvt_pk_bf16(v1[0], v1[1]); w.w = cvt_pk_bf16(v1[2], v1[3]);
                        *(u32x4*)(MK + (size_t)row * 512 + c0) = w;
                    } else {
                        const int c = c0 - 512, h = c >> 7, d = c & 127, b = row >> 8, mm = row & 255;
                        bf16_t* p = MVT + ((size_t)((b * 4 + h) * 128 + d)) * 256 + mm;
#pragma unroll
                        for (int e = 0; e < 4; ++e) { p[(size_t)e * 256] = (bf16_t)(cvt_pk_bf16(v0[e], 0.f) & 0xffffu); p[(size_t)(e + 4) * 256] = (bf16_t)(cvt_pk_bf16(v1[e], 0.f) & 0xffffu); }
                    }
                }
        }
    }
};

struct EpiGate {
    static constexpr bool PERM = true, AFTER_DRAIN = false;
    bf16_t* Mg; const bf16_t* G; int goff; int first;
    __device__ __forceinline__ void operator()(const f32x4 (&acc)[2][2][4][2], const Unit& u, int wr, int wc, int fr, int fq) const {
        const int row0 = u.pm * BM + wr * 64 + fr, col0 = u.pn * BM + wc * 32 + 8 * fq;
#pragma unroll
        for (int ai = 0; ai < 2; ++ai)
#pragma unroll
            for (int m = 0; m < 4; ++m) {
                const int row = row0 + ai * HALF + m * 16;
#pragma unroll
                for (int bj = 0; bj < 2; ++bj) {
                    const int col = col0 + bj * HALF;
                    const u32x4 g = *(const u32x4*)(G + (size_t)row * 3072 + goff + col);
                    u32x4 pv = (u32x4){0u, 0u, 0u, 0u};
                    if (!first) pv = *(const u32x4*)(Mg + (size_t)row * 1024 + col);
                    const f32x4 v0 = acc[ai][bj][m][0], v1 = acc[ai][bj][m][1];
                    u32x4 w;
                    w.x = cvt_pk_bf16(bf_lo(pv.x) + bf_lo(g.x) * v0[0], bf_hi(pv.x) + bf_hi(g.x) * v0[1]);
                    w.y = cvt_pk_bf16(bf_lo(pv.y) + bf_lo(g.y) * v0[2], bf_hi(pv.y) + bf_hi(g.y) * v0[3]);
                    w.z = cvt_pk_bf16(bf_lo(pv.z) + bf_lo(g.z) * v1[0], bf_hi(pv.z) + bf_hi(g.z) * v1[1]);
                    w.w = cvt_pk_bf16(bf_lo(pv.w) + bf_lo(g.w) * v1[2], bf_hi(pv.w) + bf_hi(g.w) * v1[3]);
                    *(u32x4*)(Mg + (size_t)row * 1024 + col) = w;
                }
            }
    }
};

struct EpiResid {
    static constexpr bool PERM = false, AFTER_DRAIN = false;
    const float* X; float* out; float alpha;
    __device__ __forceinline__ void operator()(const f32x4 (&acc)[2][2][4][2], const Unit& u, int wr, int wc, int fr, int fq) const {
        const int row0 = u.pm * BM + wr * 64 + fr, col0 = u.pn * BM + wc * 32 + 4 * fq;
#pragma unroll
        for (int ai = 0; ai < 2; ++ai)
#pragma unroll
            for (int m = 0; m < 4; ++m) {
                const size_t off = (size_t)(row0 + ai * HALF + m * 16) * 1024 + col0;
#pragma unroll
                for (int bj = 0; bj < 2; ++bj)
#pragma unroll
                    for (int n = 0; n < 2; ++n) { const f32x4 xv = *(const f32x4*)(X + off + bj * HALF + n * 16); *(f32x4*)(out + off + bj * HALF + n * 16) = xv * alpha + acc[ai][bj][m][n]; }
            }
    }
};
}
#define GAS __attribute__((address_space(1)))
#define LAS __attribute__((address_space(3)))
typedef unsigned short bf16;
typedef unsigned v4u __attribute__((ext_vector_type(4)));
typedef float f32x4 __attribute__((ext_vector_type(4)));
typedef short bf16x8 __attribute__((ext_vector_type(8)));
typedef GAS unsigned gu32;
typedef GAS unsigned long long gu64;
#define RLX_AGENT __ATOMIC_RELAXED, __HIP_MEMORY_SCOPE_AGENT
#define LDS_WAIT() asm volatile("s_waitcnt lgkmcnt(0)" ::: "memory")
#define VM_WAIT() asm volatile("s_waitcnt vmcnt(0)" ::: "memory")
__device__ __forceinline__ unsigned long long rt() { return __builtin_amdgcn_s_memrealtime(); }
__device__ __forceinline__ unsigned f2bf(float f) { unsigned u = __builtin_bit_cast(unsigned, f); return (u + 0x7fffu + ((u >> 16) & 1u)) >> 16; }
__device__ __forceinline__ unsigned pk2(float lo, float hi) { return f2bf(lo) | (f2bf(hi) << 16); }
#define XB_TMO      128
#define XB_XCNT(j)  (256  + 64 * (j))
#define XB_XSUB(j)  (1280 + 64 * (j))
#define XB_XGEN(j)  (2304 + 64 * (j))
#define XB_TOP      3328
#define XB_TOPGEN   3392
#define XCD_BAR_WORDS 3456
#define XB_SPIN_CAP (1u << 18)

__device__ __forceinline__ unsigned xb_ld(unsigned* p)              { return __hip_atomic_load(p, __ATOMIC_RELAXED, __HIP_MEMORY_SCOPE_AGENT); }
__device__ __forceinline__ unsigned xb_add(unsigned* p, unsigned v) { return __hip_atomic_fetch_add(p, v, __ATOMIC_RELAXED, __HIP_MEMORY_SCOPE_AGENT); }
__device__ __forceinline__ unsigned xb_xcc_id() { return (unsigned)__builtin_amdgcn_s_getreg((3 << 11) | 20) & 0xFu; }
#define XB_SPIN(cond, bar) do { unsigned _sp = 0; while (cond) { __builtin_amdgcn_s_sleep(1); \
    if ((++_sp & 255u) == 0u) { if (xb_ld(&(bar)[XB_TMO])) break; if (_sp > XB_SPIN_CAP) { atomicAdd(&(bar)[XB_TMO], 1u); break; } } } } while (0)

struct XcdBarrier {
    unsigned* bar; unsigned x;
    volatile LAS unsigned* st;
};

__device__ __forceinline__ XcdBarrier xcd_barrier_post(unsigned* bar, volatile LAS unsigned* st) {
    XcdBarrier b; b.bar = bar; b.x = xb_xcc_id(); b.st = st;
    if (threadIdx.x == 0) (void)xb_add(&bar[XB_XCNT(b.x)], 1u);
    return b;
}
__device__ __forceinline__ void xcd_barrier_complete(unsigned* bar, unsigned x, unsigned& nloc, unsigned& nx) {
    const unsigned G = gridDim.x * gridDim.y * gridDim.z;
    unsigned sum, cnt, mine, sp = 0u;
    for (;;) {
        sum = 0u; cnt = 0u; mine = 0u;
#pragma unroll
        for (unsigned j = 0; j < 16; ++j) { const unsigned c = xb_ld(&bar[XB_XCNT(j)]); sum += c; cnt += (c > 0u) ? 1u : 0u; mine = (j == x) ? c : mine; }
        if (sum == G) break;
        __builtin_amdgcn_s_sleep(1);
        if ((++sp & 255u) == 0u) { if (xb_ld(&bar[XB_TMO])) break; if (sp > XB_SPIN_CAP) { atomicAdd(&bar[XB_TMO], 1u); break; } }
    }
    nloc = mine > 0u ? mine : 1u; nx = cnt > 0u ? cnt : 1u;
}

__device__ __forceinline__ void xcd_barrier(const XcdBarrier& b) {
    asm volatile("s_waitcnt vmcnt(0)" ::: "memory");
    __syncthreads();
    if (threadIdx.x == 0) {
        unsigned* bar = b.bar;
        __builtin_amdgcn_s_waitcnt(0);
        unsigned nloc = b.st[0], nx = b.st[1];
        if (nloc == 0u) { xcd_barrier_complete(bar, b.x, nloc, nx); b.st[0] = nloc; b.st[1] = nx; }
        const unsigned old = xb_add(&bar[XB_XSUB(b.x)], 1u);
        const unsigned gen = old / nloc;
        if (old + 1u == (gen + 1u) * nloc) {
            __builtin_amdgcn_fence(__ATOMIC_RELEASE, "agent");
            asm volatile("s_waitcnt vmcnt(0)" ::: "memory");
            const unsigned og = xb_add(&bar[XB_TOP], 1u);
            const unsigned tg = og / nx;
            if (og + 1u == (tg + 1u) * nx) xb_add(&bar[XB_TOPGEN], 1u);
            else XB_SPIN(xb_ld(&bar[XB_TOPGEN]) == tg, bar);
            __builtin_amdgcn_fence(__ATOMIC_ACQUIRE, "agent");
            xb_add(&bar[XB_XGEN(b.x)], 1u);
            asm volatile("s_waitcnt vmcnt(0)" ::: "memory");
        } else {
            XB_SPIN(xb_ld(&bar[XB_XGEN(b.x)]) == gen, bar);
            __builtin_amdgcn_fence(__ATOMIC_ACQUIRE, "agent");
            asm volatile("s_waitcnt vmcnt(0)" ::: "memory");
        }
    }
    __syncthreads();
}
constexpr int NWAVES = 8, NTHR = 512;
constexpr int T = 65536, D = 1024, SEQ = 8192, NBATCH = 8, NCHUNK = 64, INW = 5888;
constexpr float LN_EPS = 1e-5f, ALPHA = 1.189207115002721f;
#ifndef MK_N_LAUNCHES
#define MK_N_LAUNCHES 1
#endif
constexpr int N_PHASES = 10;
constexpr int N_LAUNCHES = MK_N_LAUNCHES;

constexpr size_t MiB = 1u << 20;
constexpr size_t WS_CTL = 0, CTL_ZERO_BYTES = 1 * MiB;
constexpr size_t WS_WIN = 2 * MiB;
constexpr size_t WS_WBA = 14 * MiB, WS_WBR = 15 * MiB, WS_WBM = 16 * MiB;
constexpr size_t WS_WOUT = 17 * MiB;
constexpr size_t WS_WPQ = 19 * MiB;
constexpr size_t WS_WMKV = 23 * MiB;
constexpr size_t WS_SUBK = 25 * MiB;
constexpr size_t WS_BIASP = 25 * MiB + 512 * 1024;
constexpr size_t WS_MEMN = 26 * MiB;
constexpr size_t WS_MK = 30 * MiB;
constexpr size_t WS_MVT = 32 * MiB;
constexpr size_t WS_PU = 34 * MiB, WS_PV = 66 * MiB;
constexpr size_t WS_KV = 98 * MiB;
constexpr size_t WS_ST = 162 * MiB;
constexpr size_t WS_AQ = 194 * MiB, WS_RV = 258 * MiB, WS_MQ = 322 * MiB;
constexpr size_t WS_AK = 386 * MiB, WS_AV = 402 * MiB, WS_RQ = 418 * MiB, WS_RK = 450 * MiB, WS_RG = 482 * MiB;
constexpr size_t WS_MERGED = 386 * MiB;
constexpr size_t WS_G = 546 * MiB;
constexpr size_t WS_PQ = 546 * MiB;
constexpr size_t WS_HB = 194 * MiB;
constexpr size_t WS_END = 930 * MiB;
constexpr int CW_BAR = 4096;

constexpr int LDS_BYTES = 163840, LDSCTL_OFF = 163840 - 512, MISC_OFF = LDSCTL_OFF + 320;

typedef unsigned long long u64;
typedef unsigned short u16;
typedef __bf16 bf16x2_t __attribute__((ext_vector_type(2)));

struct Frame {
    LAS unsigned char* lds;
    int tid, lane, wave, fr, fq;
    int G;
    const float* in[21];
    float* out; unsigned char* ws;
};

__device__ __forceinline__ f32x4 mma16(bf16x8 arow, bf16x8 bcol, f32x4 acc) { return __builtin_amdgcn_mfma_f32_16x16x32_bf16(bcol, arow, acc, 0, 0, 0); }
__device__ __forceinline__ float bflo(unsigned u) { return __uint_as_float(u << 16); }
__device__ __forceinline__ float bfhi(unsigned u) { return __uint_as_float(u & 0xffff0000u); }
__device__ __forceinline__ float wave_sum(float v) {
#pragma unroll
    for (int o = 1; o < 64; o <<= 1) v += __shfl_xor(v, o);
    return v;
}
__device__ __forceinline__ float quad_sum(float v) { v += __shfl_xor(v, 16); v += __shfl_xor(v, 32); return v; }
__device__ __forceinline__ float quad_max(float v) { v = fmaxf(v, __shfl_xor(v, 16)); v = fmaxf(v, __shfl_xor(v, 32)); return v; }

__device__ __forceinline__ int win_src_col(int c) {
    if (c < 768 || c >= 1280) return c;
    const int p = c & 63, base = c - p, i = p >> 3, e = p & 7;
    return base + (e < 4 ? 4 * i + e : 32 + 4 * i + (e - 4));
}
template <bool WIN>
__device__ __forceinline__ void p0_transpose_item(const float* W, int K, int N, bf16* WT, LAS float* scr, int item, int lane) {
    const int nblk = N / 32, kb = item / nblk, nb = item % nblk, k0 = 64 * kb, n0 = 32 * nb;
    const int nsrc = WIN ? win_src_col(n0 + (lane & 31)) : n0 + (lane & 31);
#pragma unroll 8
    for (int i = 0; i < 32; ++i) { const int kk = 2 * i + (lane >> 5); scr[kk * 33 + (lane & 31)] = W[(size_t)(k0 + kk) * N + nsrc]; }
    LDS_WAIT(); asm volatile("" ::: "memory");
    const int c = lane & 7;
#pragma unroll
    for (int j = 0; j < 4; ++j) { const int n = (lane >> 3) + 8 * j; const LAS float* s = scr + (8 * c) * 33 + n;
        v4u o; o.x = pk2(s[0 * 33], s[1 * 33]); o.y = pk2(s[2 * 33], s[3 * 33]); o.z = pk2(s[4 * 33], s[5 * 33]); o.w = pk2(s[6 * 33], s[7 * 33]);
        *(v4u*)(WT + (size_t)(n0 + n) * K + k0 + 8 * c) = o; }
    LDS_WAIT(); asm volatile("" ::: "memory");
}
__device__ __forceinline__ void cvt_row_1024(const float* src, bf16* dst, int lane) {
    f32x4 v[4];
#pragma unroll
    for (int j = 0; j < 4; ++j) v[j] = ((const f32x4*)src)[lane + 64 * j];
#pragma unroll
    for (int j = 0; j < 4; ++j) ((u64*)dst)[lane + 64 * j] = (u64)pk2(v[j].x, v[j].y) | ((u64)pk2(v[j].z, v[j].w) << 32);
}
__device__ __forceinline__ void ln_row_1024(const float* src, const float* g, const float* bta, float* of32, bf16* obf, int lane) {
    f32x4 v[4]; float s = 0.f;
#pragma unroll
    for (int j = 0; j < 4; ++j) { v[j] = ((const f32x4*)src)[lane + 64 * j]; s += (v[j].x + v[j].y) + (v[j].z + v[j].w); }
    const float mean = wave_sum(s) * (1.f / 1024.f); float s2 = 0.f;
#pragma unroll
    for (int j = 0; j < 4; ++j) { v[j] = v[j] - mean; s2 += (v[j].x * v[j].x + v[j].y * v[j].y) + (v[j].z * v[j].z + v[j].w * v[j].w); }
    const float rstd = 1.f / sqrtf(wave_sum(s2) * (1.f / 1024.f) + LN_EPS);
#pragma unroll
    for (int j = 0; j < 4; ++j) {
        const f32x4 gg = ((const f32x4*)g)[lane + 64 * j], bb = ((const f32x4*)bta)[lane + 64 * j];
        const f32x4 o = v[j] * rstd * gg + bb;
        if (of32) ((f32x4*)of32)[lane + 64 * j] = o;
        if (obf) ((u64*)obf)[lane + 64 * j] = (u64)pk2(o.x, o.y) | ((u64)pk2(o.z, o.w) << 32);
    }
}

__device__ __forceinline__ void p0_prologue(Frame& F) {
    LAS float* scr = (LAS float*)(F.lds + F.wave * 16384);
    const int gw = blockIdx.x * NWAVES + F.wave, NGW = F.G * NWAVES;
    unsigned char* ws = F.ws;
    constexpr int I_IN = 16 * (INW / 32), I_BR = 8 * 32, I_OUT = 16 * 32, I_PQ = 16 * 64, I_MKV = 16 * 32;
    constexpr int NITEMS = I_IN + 3 * I_BR + I_OUT + I_PQ + I_MKV;
    for (int it = gw; it < NITEMS; it += NGW) {
        int r = it;
        if (r < I_IN) { p0_transpose_item<true>(F.in[2], 1024, INW, (bf16*)(ws + WS_WIN), scr, r, F.lane); continue; } r -= I_IN;
        if (r < I_BR) { p0_transpose_item<false>(F.in[9], 512, 1024, (bf16*)(ws + WS_WBA), scr, r, F.lane); continue; } r -= I_BR;
        if (r < I_BR) { p0_transpose_item<false>(F.in[10], 512, 1024, (bf16*)(ws + WS_WBR), scr, r, F.lane); continue; } r -= I_BR;
        if (r < I_BR) { p0_transpose_item<false>(F.in[11], 512, 1024, (bf16*)(ws + WS_WBM), scr, r, F.lane); continue; } r -= I_BR;
        if (r < I_OUT) { p0_transpose_item<false>(F.in[12], 1024, 1024, (bf16*)(ws + WS_WOUT), scr, r, F.lane); continue; } r -= I_OUT;
        if (r < I_PQ) { p0_transpose_item<false>(F.in[15], 1024, 2048, (bf16*)(ws + WS_WPQ), scr, r, F.lane); continue; } r -= I_PQ;
        p0_transpose_item<false>(F.in[8], 1024, 1024, (bf16*)(ws + WS_WMKV), scr, r, F.lane);
    }
    bf16* XB = (bf16*)F.out;
    for (int m = gw; m < T; m += NGW) cvt_row_1024(F.in[0] + (size_t)m * 1024, XB + (size_t)m * 1024, F.lane);
    for (int m = gw; m < 16384; m += NGW) cvt_row_1024(F.in[17] + (size_t)m * 1024, (bf16*)(ws + WS_PU) + (size_t)m * 1024, F.lane);
    for (int m = gw; m < 16384; m += NGW) cvt_row_1024(F.in[18] + (size_t)m * 1024, (bf16*)(ws + WS_PV) + (size_t)m * 1024, F.lane);
    for (int m = gw; m < 256; m += NGW) cvt_row_1024(F.in[16] + (size_t)m * 1024, (bf16*)(ws + WS_SUBK) + (size_t)m * 1024, F.lane);
    for (int m = gw; m < 2048; m += NGW) ln_row_1024(F.in[1] + (size_t)m * 1024, F.in[6], F.in[7], nullptr, (bf16*)(ws + WS_MEMN) + (size_t)m * 1024, F.lane);
    float* biasp = (float*)(ws + WS_BIASP);
    for (int c = blockIdx.x * NTHR + F.tid; c < INW; c += F.G * NTHR) biasp[c] = F.in[3][win_src_col(c)];
}

__device__ __forceinline__ float ret_log2gamma(int h) { return log2f(1.0f - exp2f(-5.0f - (float)h)); }
__device__ __forceinline__ void kvinc_unit(Frame& F, int b, int n, int h) {
    LAS bf16* Vt = (LAS bf16*)(F.lds);
    LAS bf16* Kt = (LAS bf16*)(F.lds + 34816);
    const bf16* RK = (const bf16*)(F.ws + WS_RK); const bf16* RV = (const bf16*)(F.ws + WS_RV);
    const size_t tok0 = (size_t)b * SEQ + (size_t)n * 128;
    const float lg = ret_log2gamma(h);
    for (int idx = F.tid; idx < 128 * 16; idx += NTHR) {
        const int r = idx & 127, c = idx >> 7;
        const v4u v = *(const v4u*)(RV + (tok0 + r) * 512 + h * 128 + 8 * c);
        LAS bf16* d = Vt + (8 * c) * 136 + r;
        d[0 * 136] = (bf16)(v.x & 0xffffu); d[1 * 136] = (bf16)(v.x >> 16); d[2 * 136] = (bf16)(v.y & 0xffffu); d[3 * 136] = (bf16)(v.y >> 16);
        d[4 * 136] = (bf16)(v.z & 0xffffu); d[5 * 136] = (bf16)(v.z >> 16); d[6 * 136] = (bf16)(v.w & 0xffffu); d[7 * 136] = (bf16)(v.w >> 16);
    }
    for (int idx = F.tid; idx < 128 * 8; idx += NTHR) {
        const int r = idx & 127, c = idx >> 7;
        const v4u v = *(const v4u*)(RK + (tok0 + r) * 256 + h * 64 + 8 * c);
        const float wk = exp2f(lg * (float)(127 - r));
        LAS bf16* d = Kt + (8 * c) * 136 + r;
        d[0 * 136] = (bf16)f2bf(bflo(v.x) * wk); d[1 * 136] = (bf16)f2bf(bfhi(v.x) * wk); d[2 * 136] = (bf16)f2bf(bflo(v.y) * wk); d[3 * 136] = (bf16)f2bf(bfhi(v.y) * wk);
        d[4 * 136] = (bf16)f2bf(bflo(v.z) * wk); d[5 * 136] = (bf16)f2bf(bfhi(v.z) * wk); d[6 * 136] = (bf16)f2bf(bflo(v.w) * wk); d[7 * 136] = (bf16)f2bf(bfhi(v.w) * wk);
    }
    __syncthreads();
    const int w = F.wave, fr = F.fr, fq = F.fq;
    f32x4 acc[4];
#pragma unroll
    for (int dt = 0; dt < 4; ++dt) acc[dt] = (f32x4){0.f, 0.f, 0.f, 0.f};
#pragma unroll
    for (int ks = 0; ks < 4; ++ks) {
        const bf16x8 a = *(const LAS bf16x8*)(Vt + (16 * w + fr) * 136 + 32 * ks + 8 * fq);
#pragma unroll
        for (int dt = 0; dt < 4; ++dt) acc[dt] = mma16(a, *(const LAS bf16x8*)(Kt + (16 * dt + fr) * 136 + 32 * ks + 8 * fq), acc[dt]);
    }
    float* KV = (float*)(F.ws + WS_KV) + ((size_t)((b * NCHUNK + n) * 4 + h)) * 8192 + (16 * w + fr) * 64 + 4 * fq;
#pragma unroll
    for (int dt = 0; dt < 4; ++dt) *(f32x4*)(KV + 16 * dt) = acc[dt];
    __syncthreads();
}

__device__ __forceinline__ void scan_phase(Frame& F) {
    const float* KV = (const float*)(F.ws + WS_KV); bf16* ST = (bf16*)(F.ws + WS_ST);
    for (int q = blockIdx.x * NTHR + F.tid; q < NBATCH * 32768; q += F.G * NTHR) {
        const int b = q >> 15, r = q & 32767, h = r >> 13;
        const float decay = exp2f(ret_log2gamma(h) * 128.0f);
        float st = 0.f;
        size_t off = (size_t)b * NCHUNK * 32768 + r;
        for (int n = 0; n < NCHUNK; ++n) { ST[off] = (bf16)f2bf(st); st = decay * st + KV[off]; off += 32768; }
    }
}

__device__ __forceinline__ void swa_unit(Frame& F, int b, int n, int g) {
    LAS bf16* Ks = (LAS bf16*)(F.lds);
    LAS bf16* Vt = (LAS bf16*)(F.lds + 36864);
    LAS bf16* Pw = (LAS bf16*)(F.lds + 36864 + 33792 + F.wave * 8448);
    bf16* AQ = (bf16*)(F.ws + WS_AQ); const bf16* AK = (const bf16*)(F.ws + WS_AK); const bf16* AV = (const bf16*)(F.ws + WS_AV);
    const size_t tok0 = (size_t)b * SEQ + (size_t)n * 128;
    for (int idx = F.tid; idx < 256 * 8; idx += NTHR) {
        const int r = idx >> 3, c = idx & 7;
        v4u v = (v4u){0u, 0u, 0u, 0u};
        if (n > 0 || r >= 128) v = *(const v4u*)(AK + (tok0 - 128 + r) * 128 + g * 64 + 8 * c);
        *(LAS v4u*)(Ks + r * 72 + 8 * c) = v;
    }
    for (int idx = F.tid; idx < 256 * 8; idx += NTHR) {
        const int r = idx & 255, c = idx >> 8;
        v4u v = (v4u){0u, 0u, 0u, 0u};
        if (n > 0 || r >= 128) v = *(const v4u*)(AV + (tok0 - 128 + r) * 128 + g * 64 + 8 * c);
        LAS bf16* d = Vt + (8 * c) * 264 + r;
        d[0 * 264] = (bf16)(v.x & 0xffffu); d[1 * 264] = (bf16)(v.x >> 16); d[2 * 264] = (bf16)(v.y & 0xffffu); d[3 * 264] = (bf16)(v.y >> 16);
        d[4 * 264] = (bf16)(v.z & 0xffffu); d[5 * 264] = (bf16)(v.z >> 16); d[6 * 264] = (bf16)(v.w & 0xffffu); d[7 * 264] = (bf16)(v.w >> 16);
    }
    __syncthreads();
    const int w = F.wave, fr = F.fr, fq = F.fq;
    const int hq = 4 * g + (w >> 1);
    const float sink = F.in[4][hq];
    for (int rg = 0; rg < 4; ++rg) {
        LDS_WAIT();
        const int qi0 = (w & 1) * 64 + 16 * rg, qi = qi0 + fr;
        bf16* qrow = AQ + (tok0 + qi) * 512 + hq * 64;
        bf16x8 qf[2];
#pragma unroll
        for (int ks = 0; ks < 2; ++ks) qf[ks] = *(const bf16x8*)(qrow + 32 * ks + 8 * fq);
        f32x4 s[16];
#pragma unroll
        for (int t = 0; t < 16; ++t) {
            s[t] = (f32x4){0.f, 0.f, 0.f, 0.f};
#pragma unroll
            for (int ks = 0; ks < 2; ++ks) s[t] = mma16(qf[ks], *(const LAS bf16x8*)(Ks + (16 * t + fr) * 72 + 32 * ks + 8 * fq), s[t]);
        }
        float mx = -INFINITY;
#pragma unroll
        for (int t = 0; t < 16; ++t)
#pragma unroll
            for (int i = 0; i < 4; ++i) {
                const int kj = 16 * t + 4 * fq + i, dist = qi + 128 - kj;
                const bool valid = (dist >= 0) && (dist < 128) && (n > 0 || kj >= 128);
                const float l = valid ? s[t][i] * 0.125f : -INFINITY;
                s[t][i] = l; mx = fmaxf(mx, l);
            }
        mx = quad_max(mx);
        const float m = fmaxf(mx, sink);
        float sum = 0.f;
#pragma unroll
        for (int t = 0; t < 16; ++t) {
            float p[4];
#pragma unroll
            for (int i = 0; i < 4; ++i) { p[i] = __expf(s[t][i] - m); sum += p[i]; }
            *(LAS u64*)(Pw + fr * 264 + 16 * t + 4 * fq) = (u64)pk2(p[0], p[1]) | ((u64)pk2(p[2], p[3]) << 32);
        }
        LDS_WAIT();
        sum = quad_sum(sum);
        const float inv = 1.0f / (sum + __expf(sink - m));
        f32x4 o[4];
#pragma unroll
        for (int dt = 0; dt < 4; ++dt) o[dt] = (f32x4){0.f, 0.f, 0.f, 0.f};
#pragma unroll
        for (int ks = 0; ks < 8; ++ks) {
            const bf16x8 pa = *(const LAS bf16x8*)(Pw + fr * 264 + 32 * ks + 8 * fq);
#pragma unroll
            for (int dt = 0; dt < 4; ++dt) o[dt] = mma16(pa, *(const LAS bf16x8*)(Vt + (16 * dt + fr) * 264 + 32 * ks + 8 * fq), o[dt]);
        }
#pragma unroll
        for (int dt = 0; dt < 4; ++dt)
            *(u64*)(qrow + 16 * dt + 4 * fq) = (u64)pk2(o[dt][0] * inv, o[dt][1] * inv) | ((u64)pk2(o[dt][2] * inv, o[dt][3] * inv) << 32);
    }
    __syncthreads();
}

__device__ __forceinline__ void ret_unit(Frame& F, int b, int n, int h) {
    LAS bf16* Ks = (LAS bf16*)(F.lds);
    LAS bf16* Vt = (LAS bf16*)(F.lds + 18432);
    LAS bf16* St = (LAS bf16*)(F.lds + 18432 + 34816);
    LAS bf16* Pw = (LAS bf16*)(F.lds + 18432 + 34816 + 18432 + F.wave * 4352);
    const bf16* RQ = (const bf16*)(F.ws + WS_RQ); const bf16* RK = (const bf16*)(F.ws + WS_RK); bf16* RV = (bf16*)(F.ws + WS_RV);
    const bf16* RG = (const bf16*)(F.ws + WS_RG); const bf16* ST = (const bf16*)(F.ws + WS_ST) + ((size_t)((b * NCHUNK + n) * 4 + h)) * 8192;
    const size_t tok0 = (size_t)b * SEQ + (size_t)n * 128;
    for (int idx = F.tid; idx < 128 * 8; idx += NTHR) {
        const int r = idx >> 3, c = idx & 7;
        *(LAS v4u*)(Ks + r * 72 + 8 * c) = *(const v4u*)(RK + (tok0 + r) * 256 + h * 64 + 8 * c);
        *(LAS v4u*)(St + r * 72 + 8 * c) = *(const v4u*)(ST + r * 64 + 8 * c);
    }
    for (int idx = F.tid; idx < 128 * 16; idx += NTHR) {
        const int r = idx & 127, c = idx >> 7;
        const v4u v = *(const v4u*)(RV + (tok0 + r) * 512 + h * 128 + 8 * c);
        LAS bf16* d = Vt + (8 * c) * 136 + r;
        d[0 * 136] = (bf16)(v.x & 0xffffu); d[1 * 136] = (bf16)(v.x >> 16); d[2 * 136] = (bf16)(v.y & 0xffffu); d[3 * 136] = (bf16)(v.y >> 16);
        d[4 * 136] = (bf16)(v.z & 0xffffu); d[5 * 136] = (bf16)(v.z >> 16); d[6 * 136] = (bf16)(v.w & 0xffffu); d[7 * 136] = (bf16)(v.w >> 16);
    }
    __syncthreads();
    const int w = F.wave, fr = F.fr, fq = F.fq;
    const float lg = ret_log2gamma(h);
    const int i = 16 * w + fr;
    const size_t tok = tok0 + i;
    bf16x8 qf[2];
#pragma unroll
    for (int ks = 0; ks < 2; ++ks) qf[ks] = *(const bf16x8*)(RQ + tok * 256 + h * 64 + 32 * ks + 8 * fq);
#pragma unroll
    for (int t = 0; t < 8; ++t) {
        f32x4 s = (f32x4){0.f, 0.f, 0.f, 0.f};
        if (t <= w) {
#pragma unroll
            for (int ks = 0; ks < 2; ++ks) s = mma16(qf[ks], *(const LAS bf16x8*)(Ks + (16 * t + fr) * 72 + 32 * ks + 8 * fq), s);
        }
        float p[4];
#pragma unroll
        for (int ii = 0; ii < 4; ++ii) { const int j = 16 * t + 4 * fq + ii; p[ii] = (i >= j) ? s[ii] * exp2f(lg * (float)(i - j)) : 0.f; }
        *(LAS u64*)(Pw + fr * 136 + 16 * t + 4 * fq) = (u64)pk2(p[0], p[1]) | ((u64)pk2(p[2], p[3]) << 32);
    }
    LDS_WAIT();
    f32x4 o1[8], o2[8];
#pragma unroll
    for (int et = 0; et < 8; ++et) { o1[et] = (f32x4){0.f, 0.f, 0.f, 0.f}; o2[et] = (f32x4){0.f, 0.f, 0.f, 0.f}; }
#pragma unroll
    for (int ks = 0; ks < 4; ++ks) {
        if (2 * ks <= w) {
            const bf16x8 pa = *(const LAS bf16x8*)(Pw + fr * 136 + 32 * ks + 8 * fq);
#pragma unroll
            for (int et = 0; et < 8; ++et) o1[et] = mma16(pa, *(const LAS bf16x8*)(Vt + (16 * et + fr) * 136 + 32 * ks + 8 * fq), o1[et]);
        }
    }
#pragma unroll
    for (int ks = 0; ks < 2; ++ks)
#pragma unroll
        for (int et = 0; et < 8; ++et) o2[et] = mma16(qf[ks], *(const LAS bf16x8*)(St + (16 * et + fr) * 72 + 32 * ks + 8 * fq), o2[et]);
    const float wq = exp2f(lg * (float)(i + 1));
    float sum = 0.f;
#pragma unroll
    for (int et = 0; et < 8; ++et) { o1[et] = o1[et] + o2[et] * wq; sum += (o1[et][0] + o1[et][1]) + (o1[et][2] + o1[et][3]); }
    const float mean = quad_sum(sum) * (1.f / 128.f);
    float s2 = 0.f;
#pragma unroll
    for (int et = 0; et < 8; ++et) { o1[et] = o1[et] - mean; s2 += (o1[et][0] * o1[et][0] + o1[et][1] * o1[et][1]) + (o1[et][2] * o1[et][2] + o1[et][3] * o1[et][3]); }
    const float rstd = 1.f / sqrtf(quad_sum(s2) * (1.f / 128.f) + LN_EPS);
    const float* gng = F.in[5] + h * 128;
#pragma unroll
    for (int et = 0; et < 8; ++et) {
        const int e = 16 * et + 4 * fq;
        const f32x4 gg = *(const f32x4*)(gng + e);
        const unsigned long long rgp = *(const u64*)(RG + tok * 512 + h * 128 + e);
        const unsigned r0 = (unsigned)rgp, r1 = (unsigned)(rgp >> 32);
        const float a0 = o1[et][0] * rstd * gg[0] * bflo(r0), a1 = o1[et][1] * rstd * gg[1] * bfhi(r0);
        const float a2 = o1[et][2] * rstd * gg[2] * bflo(r1), a3 = o1[et][3] * rstd * gg[3] * bfhi(r1);
        *(u64*)(RV + tok * 512 + h * 128 + e) = (u64)pk2(a0, a1) | ((u64)pk2(a2, a3) << 32);
    }
    __syncthreads();
}

__device__ __forceinline__ void xattn_unit(Frame& F, int b, int h, int sq) {
    LAS bf16* Ks = (LAS bf16*)(F.lds);
    LAS bf16* Pw = (LAS bf16*)(F.lds + 69632 + F.wave * 8448);
    bf16* MQ = (bf16*)(F.ws + WS_MQ); const bf16* MK = (const bf16*)(F.ws + WS_MK);
    const bf16* MVT = (const bf16*)(F.ws + WS_MVT) + (size_t)(b * 4 + h) * 128 * 256;
    for (int idx = F.tid; idx < 256 * 16; idx += NTHR) { const int r = idx >> 4, c = idx & 15; *(LAS v4u*)(Ks + r * 136 + 8 * c) = *(const v4u*)(MK + (size_t)(b * 256 + r) * 512 + h * 128 + 8 * c); }
    __syncthreads();
    const int w = F.wave, fr = F.fr, fq = F.fq;
    const float scale = 0.08838834764831845f;
    for (int sub = 0; sub < 8; ++sub) {
        LDS_WAIT();
        const size_t tok = (size_t)b * SEQ + (size_t)sq * 1024 + sub * 128 + 16 * w + fr;
        bf16* qrow = MQ + tok * 512 + h * 128;
        bf16x8 qf[4];
#pragma unroll
        for (int ks = 0; ks < 4; ++ks) qf[ks] = *(const bf16x8*)(qrow + 32 * ks + 8 * fq);
        f32x4 s[16];
#pragma unroll
        for (int t = 0; t < 16; ++t) {
            s[t] = (f32x4){0.f, 0.f, 0.f, 0.f};
#pragma unroll
            for (int ks = 0; ks < 4; ++ks) s[t] = mma16(qf[ks], *(const LAS bf16x8*)(Ks + (16 * t + fr) * 136 + 32 * ks + 8 * fq), s[t]);
        }
        float mx = -INFINITY;
#pragma unroll
        for (int t = 0; t < 16; ++t)
#pragma unroll
            for (int i = 0; i < 4; ++i) { s[t][i] *= scale; mx = fmaxf(mx, s[t][i]); }
        mx = quad_max(mx);
        float sum = 0.f;
#pragma unroll
        for (int t = 0; t < 16; ++t) {
            float p[4];
#pragma unroll
            for (int i = 0; i < 4; ++i) { p[i] = __expf(s[t][i] - mx); sum += p[i]; }
            *(LAS u64*)(Pw + fr * 264 + 16 * t + 4 * fq) = (u64)pk2(p[0], p[1]) | ((u64)pk2(p[2], p[3]) << 32);
        }
        LDS_WAIT();
        const float inv = 1.0f / quad_sum(sum);
        f32x4 o[8];
#pragma unroll
        for (int dt = 0; dt < 8; ++dt) o[dt] = (f32x4){0.f, 0.f, 0.f, 0.f};
#pragma unroll
        for (int ks = 0; ks < 8; ++ks) {
            const bf16x8 pa = *(const LAS bf16x8*)(Pw + fr * 264 + 32 * ks + 8 * fq);
#pragma unroll
            for (int dt = 0; dt < 8; ++dt) o[dt] = mma16(pa, *(const bf16x8*)(MVT + (size_t)(16 * dt + fr) * 256 + 32 * ks + 8 * fq), o[dt]);
            asm volatile("" ::: "memory");
        }
#pragma unroll
        for (int dt = 0; dt < 8; ++dt)
            *(u64*)(qrow + 16 * dt + 4 * fq) = (u64)pk2(o[dt][0] * inv, o[dt][1] * inv) | ((u64)pk2(o[dt][2] * inv, o[dt][3] * inv) << 32);
    }
    __syncthreads();
}

__device__ __forceinline__ unsigned f2ord(float f) { const unsigned u = __float_as_uint(f); return (u & 0x80000000u) ? ~u : (u | 0x80000000u); }
__device__ __forceinline__ float ord2f(unsigned o) { const unsigned u = (o & 0x80000000u) ? (o & 0x7fffffffu) : ~o; return __uint_as_float(u); }
template <int N> __device__ __forceinline__ void bitonic_sort_desc(unsigned (&a)[N]) {
#pragma unroll
    for (int k = 2; k <= N; k <<= 1)
#pragma unroll
        for (int j = k >> 1; j > 0; j >>= 1)
#pragma unroll
            for (int i = 0; i < N; ++i) { const int l = i ^ j; if (l > i) { const bool desc = ((i & k) == 0); const unsigned hi = max(a[i], a[l]), lo = min(a[i], a[l]); a[i] = desc ? hi : lo; a[l] = desc ? lo : hi; } }
}
template <int N> __device__ __forceinline__ void bitonic_merge_desc(unsigned (&a)[N]) {
#pragma unroll
    for (int j = N >> 1; j > 0; j >>= 1)
#pragma unroll
        for (int i = 0; i < N; ++i) { const int l = i ^ j; if (l > i) { const unsigned hi = max(a[i], a[l]), lo = min(a[i], a[l]); a[i] = hi; a[l] = lo; } }
}
__device__ __forceinline__ void merge_top16(unsigned (&L)[16], const unsigned (&R)[16]) {
#pragma unroll
    for (int i = 0; i < 16; ++i) L[i] = max(L[i], R[15 - i]);
    bitonic_merge_desc<16>(L);
}
__device__ __forceinline__ unsigned tab_lookup(u64 tlo, u64 thi, unsigned i) {
    const u64 v = (i & 8u) ? thi : tlo;
    return (unsigned)(v >> ((i & 7u) * 8u)) & 0xffu;
}
__device__ __forceinline__ float dot2_bf16(unsigned w, unsigned x, float acc) { return __builtin_amdgcn_fdot2_f32_bf16(__builtin_bit_cast(bf16x2_t, w), __builtin_bit_cast(bf16x2_t, x), acc, false); }
__device__ __forceinline__ float gelu_erf(float x) { return 0.5f * x * (1.0f + erff(x * 0.70710678118654752f)); }

__device__ __forceinline__ void peer_unit(Frame& F, int tile) {
    LAS u16* EI = (LAS u16*)(F.lds);
    LAS float* GW = (LAS float*)(F.lds + 16384);
    const bf16* PQ = (const bf16*)(F.ws + WS_PQ); const bf16* SUBK = (const bf16*)(F.ws + WS_SUBK);
    const int w = F.wave, fr = F.fr, fq = F.fq, lane = F.lane;
    {
        const int rg = w & 3, hh0 = (w >> 2) * 4;
        const size_t row = (size_t)tile * 64 + 16 * rg + fr;
        for (int hh = hh0; hh < hh0 + 4; ++hh) {
            unsigned top[2][16];
#pragma unroll
            for (int p = 0; p < 2; ++p) {
                bf16x8 qf[4];
#pragma unroll
                for (int ks = 0; ks < 4; ++ks) qf[ks] = *(const bf16x8*)(PQ + row * 2048 + hh * 256 + p * 128 + 32 * ks + 8 * fq);
                unsigned lo[16], hi[16];
#pragma unroll
                for (int t = 0; t < 8; ++t) {
                    f32x4 s = (f32x4){0.f, 0.f, 0.f, 0.f};
                    const bf16* krow = SUBK + (size_t)((hh * 2 + p) * 128 + 16 * t + fr) * 128 + 8 * fq;
#pragma unroll
                    for (int ks = 0; ks < 4; ++ks) s = mma16(qf[ks], *(const bf16x8*)(krow + 32 * ks), s);
#pragma unroll
                    for (int i = 0; i < 4; ++i) {
                        const unsigned key = (f2ord(s[i]) & ~0x7fu) | (unsigned)(127 - (16 * t + 4 * fq + i));
                        if (t < 4) lo[4 * t + i] = key; else hi[4 * (t - 4) + i] = key;
                    }
                }
                bitonic_sort_desc<16>(lo); bitonic_sort_desc<16>(hi);
                merge_top16(lo, hi);
#pragma unroll
                for (int mask = 16; mask <= 32; mask <<= 1) {
                    unsigned r[16];
#pragma unroll
                    for (int i = 0; i < 16; ++i) r[i] = __shfl_xor(lo[i], mask);
                    merge_top16(lo, r);
                }
#pragma unroll
                for (int i = 0; i < 16; ++i) top[p][i] = lo[i];
            }
            float sv0[16], sv1[16]; u64 t0lo = 0ull, t0hi = 0ull, t1lo = 0ull, t1hi = 0ull;
#pragma unroll
            for (int i = 0; i < 16; ++i) {
                sv0[i] = ord2f(top[0][i] & ~0x7fu); sv1[i] = ord2f(top[1][i] & ~0x7fu);
                const u64 n0 = (u64)(127u - (top[0][i] & 0x7fu)) << ((i & 7) * 8), n1 = (u64)(127u - (top[1][i] & 0x7fu)) << ((i & 7) * 8);
                if (i < 8) { t0lo |= n0; t1lo |= n1; } else { t0hi |= n0; t1hi |= n1; }
            }
#define CKEY(i, j) ((f2ord(sv0[i] + sv1[j]) & ~0xffu) | (unsigned)(255 - (16 * (i) + (j))))
            unsigned L[16], R[16];
#pragma unroll
            for (int j = 0; j < 16; ++j) L[j] = CKEY(0, j);
#pragma unroll
            for (int j = 0; j < 16; ++j) R[j] = (j < 8) ? CKEY(1, j) : 0u;
            merge_top16(L, R);
            R[0] = CKEY(2, 0); R[1] = CKEY(2, 1); R[2] = CKEY(2, 2); R[3] = CKEY(2, 3); R[4] = CKEY(2, 4);
            R[5] = CKEY(3, 0); R[6] = CKEY(3, 1); R[7] = CKEY(3, 2); R[8] = CKEY(3, 3);
            R[9] = CKEY(4, 0); R[10] = CKEY(4, 1); R[11] = CKEY(4, 2);
            R[12] = CKEY(5, 0); R[13] = CKEY(5, 1); R[14] = CKEY(6, 0); R[15] = CKEY(6, 1);
            bitonic_sort_desc<16>(R); merge_top16(L, R);
            R[0] = CKEY(7, 0); R[1] = CKEY(7, 1);
            R[2] = CKEY(8, 0); R[3] = CKEY(9, 0); R[4] = CKEY(10, 0); R[5] = CKEY(11, 0); R[6] = CKEY(12, 0); R[7] = CKEY(13, 0); R[8] = CKEY(14, 0); R[9] = CKEY(15, 0);
            R[10] = 0u; R[11] = 0u; R[12] = 0u; R[13] = 0u; R[14] = 0u; R[15] = 0u;
            bitonic_sort_desc<16>(R); merge_top16(L, R);
#undef CKEY
            float ts[16], sum = 0.f; unsigned ei[16];
#pragma unroll
            for (int k = 0; k < 16; ++k) {
                ts[k] = ord2f(L[k] & ~0xffu);
                const unsigned ij = 255u - (L[k] & 0xffu);
                ei[k] = tab_lookup(t0lo, t0hi, ij >> 4) * 128u + tab_lookup(t1lo, t1hi, ij & 15u);
            }
            const float tmax = ts[0];
#pragma unroll
            for (int k = 0; k < 16; ++k) { ts[k] = __expf(ts[k] - tmax); sum += ts[k]; }
            const float inv = 1.0f / sum;
            if (fq == 0) {
                const int tl = 16 * rg + fr;
#pragma unroll
                for (int k = 0; k < 16; ++k) { EI[tl * 128 + hh * 16 + k] = (u16)ei[k]; GW[tl * 128 + hh * 16 + k] = ts[k] * inv; }
            }
        }
    }
    __syncthreads();
    {
        const bf16* HB = (const bf16*)(F.ws + WS_HB); const bf16* PU = (const bf16*)(F.ws + WS_PU); const bf16* PV = (const bf16*)(F.ws + WS_PV);
        for (int tt = 0; tt < 8; ++tt) {
            const int tl = 8 * w + tt; const size_t tok = (size_t)tile * 64 + tl;
            const v4u ha = *(const v4u*)(HB + tok * 1024 + 8 * lane), hb = *(const v4u*)(HB + tok * 1024 + 512 + 8 * lane);
            float out[16];
#pragma unroll
            for (int i = 0; i < 16; ++i) out[i] = 0.f;
#ifdef EXP_NAIVE_GATHER
            {
                for (int k = 0; k < 128; ++k) {
                    const unsigned e = EI[tl * 128 + k];
                    float d = 0.f;
                    for (int i = 0; i < 16; ++i) { const int c = lane + 64 * i; d += __uint_as_float((unsigned)PU[(size_t)e * 1024 + c] << 16) * __uint_as_float((unsigned)HB[tok * 1024 + c] << 16); }
                    d = wave_sum(d);
                    const float coef = GW[tl * 128 + k] * gelu_erf(d);
#pragma unroll
                    for (int i = 0; i < 16; ++i) { const int c = (i >> 3) * 512 + 8 * lane + (i & 7); out[i] += coef * __uint_as_float((unsigned)PV[(size_t)e * 1024 + c] << 16); }
                }
            }
            for (int g = 0; g < 0; ++g) {
#else
            for (int g = 0; g < 16; ++g) {
#endif
                v4u ua[8], ub[8], va[8], vb[8];
#pragma unroll
                for (int j = 0; j < 8; ++j) {
                    const unsigned e = EI[tl * 128 + 8 * g + j];
                    const bf16* ur = PU + (size_t)e * 1024 + 8 * lane; const bf16* vr = PV + (size_t)e * 1024 + 8 * lane;
                    ua[j] = *(const v4u*)ur; ub[j] = *(const v4u*)(ur + 512); va[j] = *(const v4u*)vr; vb[j] = *(const v4u*)(vr + 512);
                }
#pragma unroll
                for (int j = 0; j < 8; ++j) {
                    float d = 0.f;
                    d = dot2_bf16(ua[j].x, ha.x, d); d = dot2_bf16(ua[j].y, ha.y, d); d = dot2_bf16(ua[j].z, ha.z, d); d = dot2_bf16(ua[j].w, ha.w, d);
                    d = dot2_bf16(ub[j].x, hb.x, d); d = dot2_bf16(ub[j].y, hb.y, d); d = dot2_bf16(ub[j].z, hb.z, d); d = dot2_bf16(ub[j].w, hb.w, d);
                    d = wave_sum(d);
#ifdef EXP_NO_PEER
                    const float coef = 0.f * d;
#else
                    const float coef = GW[tl * 128 + 8 * g + j] * gelu_erf(d);
#endif
                    out[0] += coef * bflo(va[j].x); out[1] += coef * bfhi(va[j].x); out[2] += coef * bflo(va[j].y); out[3] += coef * bfhi(va[j].y);
                    out[4] += coef * bflo(va[j].z); out[5] += coef * bfhi(va[j].z); out[6] += coef * bflo(va[j].w); out[7] += coef * bfhi(va[j].w);
                    out[8] += coef * bflo(vb[j].x); out[9] += coef * bfhi(vb[j].x); out[10] += coef * bflo(vb[j].y); out[11] += coef * bfhi(vb[j].y);
                    out[12] += coef * bflo(vb[j].z); out[13] += coef * bfhi(vb[j].z); out[14] += coef * bflo(vb[j].w); out[15] += coef * bfhi(vb[j].w);
                }
            }
            float* yrow = F.out + tok * 1024;
            f32x4 hv[4];
            hv[0] = *(const f32x4*)(yrow + 8 * lane); hv[1] = *(const f32x4*)(yrow + 8 * lane + 4); hv[2] = *(const f32x4*)(yrow + 512 + 8 * lane); hv[3] = *(const f32x4*)(yrow + 512 + 8 * lane + 4);
            float s = 0.f;
#pragma unroll
            for (int q = 0; q < 4; ++q)
#pragma unroll
                for (int i = 0; i < 4; ++i) { hv[q][i] = ALPHA * hv[q][i] + out[4 * q + i]; s += hv[q][i]; }
            const float mean = wave_sum(s) * (1.f / 1024.f); float s2 = 0.f;
#pragma unroll
            for (int q = 0; q < 4; ++q)
#pragma unroll
                for (int i = 0; i < 4; ++i) { hv[q][i] -= mean; s2 += hv[q][i] * hv[q][i]; }
            const float rstd = 1.f / sqrtf(wave_sum(s2) * (1.f / 1024.f) + LN_EPS);
            const float* g2 = F.in[19]; const float* b2 = F.in[20];
#pragma unroll
            for (int q = 0; q < 4; ++q) {
                const int c = (q >> 1) * 512 + 8 * lane + (q & 1) * 4;
                const f32x4 gg = *(const f32x4*)(g2 + c), bb = *(const f32x4*)(b2 + c);
                *(f32x4*)(yrow + c) = hv[q] * rstd * gg + bb;
            }
        }
    }
    __syncthreads();
}

struct Args { const float* in[21]; float* out; unsigned char* ws; int ph_lo, ph_hi, li, pad; };

__global__ void __launch_bounds__(NTHR, 2) mega_fwd(Args args) {
    extern __shared__ __attribute__((aligned(16))) unsigned char lds_raw[];
    Frame F;
    F.lds = (LAS unsigned char*)lds_raw;
    F.tid = threadIdx.x; F.lane = F.tid & 63; F.wave = __builtin_amdgcn_readfirstlane(F.tid >> 6); F.fr = F.lane & 15; F.fq = F.lane >> 4;
    F.G = gridDim.x;
#pragma unroll
    for (int i = 0; i < 21; ++i) F.in[i] = args.in[i];
    F.out = args.out; F.ws = args.ws;
    unsigned char* ws = args.ws;
    gu32* ctl = (gu32*)(ws + WS_CTL);
    volatile LAS unsigned* MISC = (volatile LAS unsigned*)(F.lds + MISC_OFF);
    for (int u = F.tid; u < (LDS_BYTES - LDSCTL_OFF) / 4; u += NTHR) ((LAS unsigned*)(F.lds + LDSCTL_OFF))[u] = 0u;
    __syncthreads();
    XcdBarrier bar; bar.bar = (unsigned*)(ctl + CW_BAR) + args.li * XCD_BAR_WORDS; bar.x = 0; bar.st = nullptr;
    if (N_LAUNCHES != N_PHASES) bar = xcd_barrier_post((unsigned*)(ctl + CW_BAR) + args.li * XCD_BAR_WORDS, MISC + 8);
#define GRID_BAR() do { if (N_LAUNCHES != N_PHASES) xcd_barrier(bar); } while (0)
    const int lo = args.ph_lo, hi = args.ph_hi;
#define IN(k) (lo <= (k) && (k) < hi)
#define BOTH(k) (IN(k) && IN((k) + 1))

    bf16* XB = (bf16*)args.out;
    if (IN(0)) { p0_prologue(F); if (BOTH(0)) GRID_BAR(); }
    if (IN(1)) {
        { pg8::Gemm g{XB, (const bf16*)(ws + WS_WIN), T, INW, 1024}; pg8::StaticOrder S; S.init(T, INW, F.G, (int)blockIdx.x);
          pg8::EpiInProj E{(bf16*)(ws + WS_AQ), (bf16*)(ws + WS_AK), (bf16*)(ws + WS_AV), (bf16*)(ws + WS_RQ), (bf16*)(ws + WS_RK), (bf16*)(ws + WS_RV), (bf16*)(ws + WS_RG), (bf16*)(ws + WS_MQ), (bf16*)(ws + WS_G), (const float*)(ws + WS_BIASP)};
          pg8::gemm_phase<pg8::EpiInProj, pg8::StaticOrder, true, true>(F.lds, g, S, E); }
        { pg8::Gemm g{(const bf16*)(ws + WS_MEMN), (const bf16*)(ws + WS_WMKV), 2048, 1024, 1024}; pg8::StaticOrder S; S.init(2048, 1024, F.G, (int)blockIdx.x);
          pg8::EpiMkv E{(bf16*)(ws + WS_MK), (bf16*)(ws + WS_MVT)};
          pg8::gemm_phase<pg8::EpiMkv, pg8::StaticOrder, true, true>(F.lds, g, S, E); }
        if (BOTH(1)) GRID_BAR();
    }
    if (IN(2)) {
        for (int u = blockIdx.x; u < NBATCH * NCHUNK * 4; u += F.G) kvinc_unit(F, u >> 8, (u >> 2) & 63, u & 3);
        if (BOTH(2)) GRID_BAR();
    }
    if (IN(3)) { scan_phase(F); if (BOTH(3)) GRID_BAR(); }
    if (IN(4)) {
        for (int u = blockIdx.x; u < NBATCH * NCHUNK * 2; u += F.G) swa_unit(F, u >> 7, (u >> 1) & 63, u & 1);
        for (int u = blockIdx.x; u < NBATCH * NCHUNK * 4; u += F.G) ret_unit(F, u >> 8, (u >> 2) & 63, u & 3);
        for (int u = blockIdx.x; u < NBATCH * 4 * 8; u += F.G) xattn_unit(F, u >> 5, (u >> 3) & 3, u & 7);
        if (BOTH(4)) GRID_BAR();
    }
    if (IN(5)) {
        pg8::StaticOrder S; S.init(T, 1024, F.G, (int)blockIdx.x);
        { pg8::Gemm g{(const bf16*)(ws + WS_AQ), (const bf16*)(ws + WS_WBA), T, 1024, 512}; pg8::EpiGate E{(bf16*)(ws + WS_MERGED), (const bf16*)(ws + WS_G), 0, 1};
          pg8::gemm_phase<pg8::EpiGate, pg8::StaticOrder, true, true>(F.lds, g, S, E); }
        { pg8::Gemm g{(const bf16*)(ws + WS_RV), (const bf16*)(ws + WS_WBR), T, 1024, 512}; pg8::EpiGate E{(bf16*)(ws + WS_MERGED), (const bf16*)(ws + WS_G), 1024, 0};
          pg8::gemm_phase<pg8::EpiGate, pg8::StaticOrder, true, true>(F.lds, g, S, E); }
        { pg8::Gemm g{(const bf16*)(ws + WS_MQ), (const bf16*)(ws + WS_WBM), T, 1024, 512}; pg8::EpiGate E{(bf16*)(ws + WS_MERGED), (const bf16*)(ws + WS_G), 2048, 0};
          pg8::gemm_phase<pg8::EpiGate, pg8::StaticOrder, true, true>(F.lds, g, S, E); }
        if (BOTH(5)) GRID_BAR();
    }
    if (IN(6)) {
        pg8::Gemm g{(const bf16*)(ws + WS_MERGED), (const bf16*)(ws + WS_WOUT), T, 1024, 1024}; pg8::StaticOrder S; S.init(T, 1024, F.G, (int)blockIdx.x);
        pg8::EpiResid E{F.in[0], F.out, ALPHA};
        pg8::gemm_phase<pg8::EpiResid, pg8::StaticOrder, true, true>(F.lds, g, S, E);
        if (BOTH(6)) GRID_BAR();
    }
    if (IN(7)) {
        const int gw = blockIdx.x * NWAVES + F.wave, NGW = F.G * NWAVES;
        for (int m = gw; m < T; m += NGW) ln_row_1024(F.out + (size_t)m * 1024, F.in[13], F.in[14], F.out + (size_t)m * 1024, (bf16*)(ws + WS_HB) + (size_t)m * 1024, F.lane);
        if (BOTH(7)) GRID_BAR();
    }
    if (IN(8)) {
        pg8::Gemm g{(const bf16*)(ws + WS_HB), (const bf16*)(ws + WS_WPQ), T, 2048, 1024}; pg8::StaticOrder S; S.init(T, 2048, F.G, (int)blockIdx.x);
        pg8::EpiBf16<0> E{(bf16*)(ws + WS_PQ), 2048, nullptr, 0, 0, 1.f};
        pg8::gemm_phase<pg8::EpiBf16<0>, pg8::StaticOrder, true, true>(F.lds, g, S, E);
        if (BOTH(8)) GRID_BAR();
    }
    if (IN(9)) {
        for (int u = blockIdx.x; u < T / 64; u += F.G) peer_unit(F, u);
    }
#undef IN
#undef BOTH
#undef GRID_BAR
}

extern "C" void kernel_launch(void* const* d_in, const int* in_sizes, int n_in, void* d_out, int out_size, void* d_ws, size_t ws_size, hipStream_t stream) {
    static int grid = 0;
    if (grid == 0) {
        if (n_in != 21 || out_size != T * D || ws_size < WS_END) { fprintf(stderr, "kernel_launch: unexpected problem (n_in %d, out %d, ws %zu); nothing launched\n", n_in, out_size, ws_size); grid = -1; return; }
        int dev = 0, cus = 0, per_cu = 0;
        if (hipGetDevice(&dev) != hipSuccess || hipDeviceGetAttribute(&cus, hipDeviceAttributeMultiprocessorCount, dev) != hipSuccess) { grid = -1; return; }
        if (hipFuncSetAttribute((const void*)mega_fwd, hipFuncAttributeMaxDynamicSharedMemorySize, LDS_BYTES) != hipSuccess) { fprintf(stderr, "kernel_launch: hipFuncSetAttribute failed\n"); grid = -1; return; }
        if (hipOccupancyMaxActiveBlocksPerMultiprocessor(&per_cu, (const void*)mega_fwd, NTHR, LDS_BYTES) != hipSuccess || per_cu < 1) { fprintf(stderr, "kernel_launch: occupancy query says %d blocks per CU\n", per_cu); per_cu = 1; }
        (void)hipGetLastError();
        grid = cus;
    }
    if (grid < 0) return;
    (void)hipMemsetAsync((char*)d_ws + WS_CTL, 0, CTL_ZERO_BYTES, stream);
    Args a{};
    for (int i = 0; i < 21; ++i) a.in[i] = (const float*)d_in[i];
    a.out = (float*)d_out; a.ws = (unsigned char*)d_ws;
    if (N_LAUNCHES == 1) {
        a.ph_lo = 0; a.ph_hi = N_PHASES; a.li = 0;
        hipLaunchKernelGGL(mega_fwd, dim3(grid), dim3(NTHR), LDS_BYTES, stream, a);
    } else {
        for (int li = 0; li < N_PHASES; ++li) { a.ph_lo = li; a.ph_hi = li + 1; a.li = 0; hipLaunchKernelGGL(mega_fwd, dim3(grid), dim3(NTHR), LDS_BYTES, stream, a); }
    }
}
```

```cpp
#include <hip/hip_runtime.h>
#include <cstdio>
#include <cstdint>
#include <cmath>
#ifndef PG8_WGM
#define PG8_WGM 8
#endif
namespace pg8 {
#define PG8_LAS __attribute__((address_space(3)))
typedef unsigned short bf16_t;
typedef short bf16x8 __attribute__((ext_vector_type(8)));
typedef float f32x4 __attribute__((ext_vector_type(4)));
typedef unsigned u32x4 __attribute__((ext_vector_type(4)));
constexpr int BM = 256, BK = 64, HALF = 128, HTB = HALF * BK * 2  , STAGE_BYTES = 8 * HTB, NXCD = 8, WGM = PG8_WGM;

__host__ __device__ __forceinline__ int lds_byte(int r, int c) { const int st = (r >> 4) * 2 + (c >> 5), rr = r & 15, cc = c & 31, ob = rr * 64 + cc * 2; return st * 1024 + (ob ^ (((ob >> 9) & 1) << 5)); }
__host__ __device__ __forceinline__ void stage_rc(int b, int& R, int& C) { const int st = b / 1024, sb = b % 1024, swz = sb ^ (((sb >> 9) & 1) << 5); R = (st >> 1) * 16 + swz / 64; C = (st & 1) * 32 + (swz % 64) / 2; }
__host__ __device__ __forceinline__ int perm32(int rho) { const int n = rho >> 4, i = rho & 15; return 8 * (i >> 2) + 4 * n + (i & 3); }

struct Unit { int pm, pn, seg; };
struct Gemm { const bf16_t* A; const bf16_t* Bt; int M, N, K; };

struct StaticOrder {
    int nM, nN, nwg, G, c;
    __host__ __device__ void init(int M, int N, int G_, int c_) { nM = M / BM; nN = N / BM; nwg = nM * nN; G = G_; c = c_; }
    __host__ __device__ bool next(int i, Unit& u) const {
        const long L = (long)i * G + c; if (L >= nwg) return false;
        int wgid = (int)L; { const int q = nwg / NXCD, r = nwg % NXCD, xcd = wgid % NXCD, off = wgid / NXCD; wgid = (xcd < r ? xcd * (q + 1) : r * (q + 1) + (xcd - r) * q) + off; }
        const int nig = WGM * nN, gid = wgid / nig, fm = gid * WGM, gsz = (nM - fm) < WGM ? (nM - fm) : WGM;
        u.pm = fm + ((wgid % nig) % gsz); u.pn = (wgid % nig) / gsz; return true;
    }
    __device__ __forceinline__ void a_ready(const Unit&) const {}
    __device__ __forceinline__ void done(const Unit&) const {}
};

__device__ __forceinline__ unsigned cvt_pk_bf16(float lo, float hi) { unsigned r; asm volatile("v_cvt_pk_bf16_f32 %0, %1, %2" : "=v"(r) : "v"(lo), "v"(hi)); return r; }
typedef float f32x2 __attribute__((ext_vector_type(2)));
__device__ __forceinline__ f32x2 gelu_pk(f32x2 v) {
    const f32x2 av = __builtin_elementwise_abs(v), d = av * 0.2316418882f + 1.0f;
    f32x2 t; t.x = __builtin_amdgcn_rcpf(d.x); t.y = __builtin_amdgcn_rcpf(d.y);
    f32x2 q = t * 0.5307027145f + (-0.7265760135f); q = q * t + 0.7107068705f; q = q * t + (-0.142248368f); q = q * t + 0.127414796f; q = q * t;
    const f32x2 s = (v * v) * (-0.72134752044f);
    f32x2 e; e.x = __builtin_amdgcn_exp2f(s.x); e.y = __builtin_amdgcn_exp2f(s.y);
    const f32x2 m = v * (q * e), r = v - m;
    f32x2 o; o.x = v.x < 0.f ? m.x : r.x; o.y = v.y < 0.f ? m.y : r.y; return o;
}

template <int ACT  > struct EpiBf16 {
    static constexpr bool PERM = true, AFTER_DRAIN = false; static_assert(ACT == 0 || ACT == 1, "EpiBf16: ACT is 0 (none) or 1 (gelu_pk)");
    bf16_t* O; int ldc; const float* bias; int split_cols; size_t split_stride; float scale0;
    __device__ __forceinline__ void operator()(const f32x4 (&acc)[2][2][4][2], const Unit& u, int wr, int wc, int fr, int fq) const {
        const int row0 = u.pm * BM + wr * 64 + fr; int colt = u.pn * BM; bf16_t* base = O;
        float sc = 1.f; if (split_cols) { const int t = colt / split_cols; base += (size_t)t * split_stride; colt -= t * split_cols; if (t == 0) sc = scale0; }
        const int col0 = colt + wc * 32 + 8 * fq, bcol0 = u.pn * BM + wc * 32 + 8 * fq;
        f32x4 bv[2][2];
#pragma unroll
        for (int bj = 0; bj < 2; ++bj)
#pragma unroll
            for (int n = 0; n < 2; ++n) bv[bj][n] = bias ? *(const f32x4*)(bias + bcol0 + bj * HALF + 4 * n) : (f32x4){0.f, 0.f, 0.f, 0.f};
#pragma unroll
        for (int ai = 0; ai < 2; ++ai)
#pragma unroll
            for (int m = 0; m < 4; ++m) { bf16_t* rowp = base + (size_t)(row0 + ai * HALF + m * 16) * ldc + col0;
#pragma unroll
                for (int bj = 0; bj < 2; ++bj) { f32x4 v0 = acc[ai][bj][m][0] + bv[bj][0], v1 = acc[ai][bj][m][1] + bv[bj][1];
                    if (ACT == 1) { f32x2 a = gelu_pk((f32x2){v0[0], v0[1]}), b = gelu_pk((f32x2){v0[2], v0[3]}), c = gelu_pk((f32x2){v1[0], v1[1]}), d = gelu_pk((f32x2){v1[2], v1[3]});
                        v0 = (f32x4){a.x, a.y, b.x, b.y}; v1 = (f32x4){c.x, c.y, d.x, d.y}; }
                    v0 = v0 * sc; v1 = v1 * sc; u32x4 w; w.x = cvt_pk_bf16(v0[0], v0[1]); w.y = cvt_pk_bf16(v0[2], v0[3]); w.z = cvt_pk_bf16(v1[0], v1[1]); w.w = cvt_pk_bf16(v1[2], v1[3]);
                    *(u32x4*)(rowp + bj * HALF) = w; } }
    }
};
typedef int v8i_t __attribute__((ext_vector_type(8))); typedef int v4i_t __attribute__((ext_vector_type(4)));
__device__ __forceinline__ f32x4 mfma_f8_128(bf16x8 a0, bf16x8 a1, bf16x8 b0, bf16x8 b1, f32x4 c) {
    const v4i_t a0i = __builtin_bit_cast(v4i_t, a0), a1i = __builtin_bit_cast(v4i_t, a1), b0i = __builtin_bit_cast(v4i_t, b0), b1i = __builtin_bit_cast(v4i_t, b1);
    const v8i_t a = __builtin_shufflevector(a0i, a1i, 0, 1, 2, 3, 4, 5, 6, 7), b = __builtin_shufflevector(b0i, b1i, 0, 1, 2, 3, 4, 5, 6, 7);
    return __builtin_amdgcn_mfma_scale_f32_16x16x128_f8f6f4(a, b, c, 0, 0, 0, 0x7f7f7f7f, 0, 0x7f7f7f7f);
}
template <class Epi, class Sched, bool ALIGN_EPI = false, bool SP2 = false, bool F8 = false>
__device__ __forceinline__ void gemm_phase(PG8_LAS unsigned char* lds, const Gemm g, const Sched& S, const Epi& E) {
    int tid_ = threadIdx.x; asm volatile("" : "+v"(tid_));
    const int tid = tid_, wid = __builtin_amdgcn_readfirstlane(tid >> 6), lane = tid & 63, wr = wid >> 2, wc = wid & 3, fr = lane & 15, fq = lane >> 4;
    const int Kb = F8 ? g.K : 2 * g.K, nt = Kb / 128;
    unsigned voffA[2], voffB[2];
#pragma unroll
    for (int i = 0; i < 2; ++i) { int R, C; stage_rc(tid * 16 + i * 8192, R, C); const int Rb = Epi::PERM ? ((R & ~31) + perm32(R & 31)) : R;
        voffA[i] = (unsigned)(R * Kb + C * 2); voffB[i] = (unsigned)(Rb * Kb + C * 2); }
    const size_t kstep = (size_t)(BK * 2);
    const size_t hstep = (size_t)HALF * Kb;
    const size_t tstep = 2 * hstep;
    const unsigned ldsw = (unsigned)wid * 1024u;
    const int aoff = lds_byte(wr * 64 + fr, F8 ? fq * 16 : fq * 8), boff = lds_byte(wc * 32 + fr, F8 ? fq * 16 : fq * 8);
    constexpr int KINC = F8 ? 16 : 1024;
#define PG8_SA(b, h) (((b) * 2 + (h)) * HTB)
#define PG8_SB(b, h) ((4 + (b) * 2 + (h)) * HTB)
#define PG8_STAGE(bufoff, gbase, voff) do { _Pragma("unroll") for (int _i = 0; _i < 2; ++_i) \
        __builtin_amdgcn_global_load_lds((const unsigned*)((const char*)(gbase) + (size_t)_i * (size_t)(64 * Kb) + (voff)[0]), (PG8_LAS unsigned*)(lds + (bufoff) + ldsw + _i * 8192), 16, 0, 0); } while (0)
#define PG8_LDA(dst, b, h) do { if constexpr (F8) { _Pragma("unroll") for (int m = 0; m < 4; ++m) dst##8[m] = *(const PG8_LAS v8i_t*)(lds + PG8_SA(b, h) + aoff + m * 2048); } \
        else { _Pragma("unroll") for (int m = 0; m < 4; ++m) _Pragma("unroll") for (int k = 0; k < 2; ++k) dst[m][k] = *(const PG8_LAS bf16x8*)(lds + PG8_SA(b, h) + aoff + m * 2048 + k * KINC); } } while (0)
#define PG8_LDB(dst, b, h) do { if constexpr (F8) { _Pragma("unroll") for (int n = 0; n < 2; ++n) dst##8[n] = *(const PG8_LAS v8i_t*)(lds + PG8_SB(b, h) + boff + n * 2048); } \
        else { _Pragma("unroll") for (int n = 0; n < 2; ++n) _Pragma("unroll") for (int k = 0; k < 2; ++k) dst[n][k] = *(const PG8_LAS bf16x8*)(lds + PG8_SB(b, h) + boff + n * 2048 + k * KINC); } } while (0)
#define PG8_MMA(ai, bj, At, Bt) do { __builtin_amdgcn_s_setprio(1); _Pragma("unroll") for (int m = 0; m < 4; ++m) _Pragma("unroll") for (int n = 0; n < 2; ++n) { \
        if constexpr (F8) acc[ai][bj][m][n] = __builtin_amdgcn_mfma_scale_f32_16x16x128_f8f6f4(Bt##8[n], At##8[m], acc[ai][bj][m][n], 0, 0, 0, 0x7f7f7f7f, 0, 0x7f7f7f7f); \
        else { _Pragma("unroll") for (int k = 0; k < 2; ++k) acc[ai][bj][m][n] = __builtin_amdgcn_mfma_f32_16x16x32_bf16(Bt[n][k], At[m][k], acc[ai][bj][m][n], 0, 0, 0); } } \
        __builtin_amdgcn_s_setprio(0); } while (0)
#define PG8_WAIT_V(n) asm volatile("s_waitcnt vmcnt(" #n ")" ::: "memory")
#define PG8_WAIT_L(n) asm volatile("s_waitcnt lgkmcnt(" #n ")" ::: "memory")
#define PG8_BAR __builtin_amdgcn_s_barrier()
#define PG8_SCHED __builtin_amdgcn_sched_barrier(0)
    Unit cur, nxt; int ui = 0;
    if (!S.next(0, cur)) return;
    f32x4 acc[2][2][4][2];
#pragma unroll
    for (int a = 0; a < 2; ++a)
#pragma unroll
        for (int b = 0; b < 2; ++b)
#pragma unroll
            for (int m = 0; m < 4; ++m)
#pragma unroll
                for (int n = 0; n < 2; ++n) acc[a][b][m][n] = (f32x4){0.f, 0.f, 0.f, 0.f};
    bf16x8 At[4][2], B0[2][2], B1[2][2];
    v8i_t At8[4], B08[2], B18[2];
    const char* cA = (const char*)g.A + (size_t)cur.pm * tstep; const char* cB = (const char*)g.Bt + (size_t)cur.pn * tstep;
    S.a_ready(cur);
    if constexpr (SP2) {
        PG8_STAGE(PG8_SB(0, 0), cB, voffB); PG8_STAGE(PG8_SB(0, 1), cB + hstep, voffB); PG8_STAGE(PG8_SA(0, 0), cA, voffA); PG8_STAGE(PG8_SA(0, 1), cA + hstep, voffA);
        if (wr == 1) PG8_BAR;
        PG8_WAIT_V(2); PG8_BAR;
        PG8_STAGE(PG8_SB(1, 0), cB + kstep, voffB); PG8_STAGE(PG8_SA(1, 0), cA + kstep, voffA); PG8_STAGE(PG8_SB(1, 1), cB + hstep + kstep, voffB);
        PG8_WAIT_V(6); PG8_BAR;
    } else {
        PG8_STAGE(PG8_SB(0, 0), cB, voffB); PG8_STAGE(PG8_SA(0, 0), cA, voffA); PG8_STAGE(PG8_SB(0, 1), cB + hstep, voffB); PG8_STAGE(PG8_SA(0, 1), cA + hstep, voffA);
        if (wr == 1) PG8_BAR;
        PG8_WAIT_V(4); PG8_BAR;
        PG8_STAGE(PG8_SB(1, 0), cB + kstep, voffB); PG8_STAGE(PG8_SA(1, 0), cA + kstep, voffA); PG8_STAGE(PG8_SB(1, 1), cB + hstep + kstep, voffB);
        PG8_WAIT_V(6); PG8_BAR;
    }
    for (;;) {
        const bool has_next = S.next(ui + 1, nxt);
        const char* nA = has_next ? (const char*)g.A + (size_t)nxt.pm * tstep : cA; const char* nB = has_next ? (const char*)g.Bt + (size_t)nxt.pn * tstep : cB;
#pragma unroll 1
        for (int t = 0; t < nt; t += 2) {
            const bool last = (t == nt - 2);
            const char* a1 = cA + (size_t)(t + 1) * kstep;
            const char* a2 = last ? nA : cA + (size_t)(t + 2) * kstep; const char* b2 = last ? nB : cB + (size_t)(t + 2) * kstep;
            const char* a3 = a2 + kstep; const char* b3 = b2 + kstep;
            if (last && has_next) S.a_ready(nxt);
            if constexpr (SP2) {
            PG8_LDB(B0, 0, 0); PG8_LDB(B1, 0, 1); PG8_SCHED; PG8_LDA(At, 0, 0); PG8_STAGE(PG8_SA(1, 1), a1 + hstep, voffA);
            PG8_WAIT_V(8); PG8_WAIT_L(0); PG8_BAR; PG8_MMA(0, 0, At, B0); PG8_MMA(0, 1, At, B1); PG8_BAR; PG8_SCHED;
            PG8_LDA(At, 0, 1); PG8_STAGE(PG8_SB(0, 0), b2, voffB); PG8_STAGE(PG8_SB(0, 1), b2 + hstep, voffB); PG8_STAGE(PG8_SA(0, 0), a2, voffA);
            PG8_WAIT_V(8); PG8_WAIT_L(0); PG8_BAR; PG8_MMA(1, 0, At, B0); PG8_MMA(1, 1, At, B1); PG8_BAR; PG8_SCHED;
            PG8_LDB(B0, 1, 0); PG8_LDB(B1, 1, 1); PG8_SCHED; PG8_LDA(At, 1, 0); PG8_STAGE(PG8_SA(0, 1), a2 + hstep, voffA);
            PG8_WAIT_V(8); PG8_WAIT_L(0); PG8_BAR; PG8_MMA(0, 0, At, B0); PG8_MMA(0, 1, At, B1); PG8_BAR; PG8_SCHED;
            PG8_LDA(At, 1, 1); PG8_STAGE(PG8_SB(1, 0), b3, voffB); PG8_STAGE(PG8_SB(1, 1), b3 + hstep, voffB); PG8_STAGE(PG8_SA(1, 0), a3, voffA);
            PG8_WAIT_V(8); PG8_WAIT_L(0); PG8_BAR; PG8_MMA(1, 0, At, B0); PG8_MMA(1, 1, At, B1); PG8_BAR; PG8_SCHED;
            } else {
            PG8_LDB(B0, 0, 0); PG8_SCHED; PG8_LDA(At, 0, 0); PG8_STAGE(PG8_SA(1, 1), a1 + hstep, voffA);
            PG8_WAIT_L(8); PG8_BAR; PG8_WAIT_L(0); PG8_MMA(0, 0, At, B0); PG8_BAR; PG8_SCHED;
            PG8_LDB(B1, 0, 1); PG8_STAGE(PG8_SB(0, 0), b2, voffB);
            PG8_BAR; PG8_WAIT_L(0); PG8_MMA(0, 1, At, B1); PG8_BAR;
            PG8_LDA(At, 0, 1); PG8_STAGE(PG8_SA(0, 0), a2, voffA);
            PG8_BAR; PG8_WAIT_L(0); PG8_MMA(1, 0, At, B0); PG8_BAR; PG8_SCHED;
            PG8_STAGE(PG8_SB(0, 1), b2 + hstep, voffB);
            PG8_WAIT_V(6); PG8_BAR; PG8_MMA(1, 1, At, B1); PG8_BAR;
            PG8_LDB(B0, 1, 0); PG8_SCHED; PG8_LDA(At, 1, 0); PG8_STAGE(PG8_SA(0, 1), a2 + hstep, voffA);
            PG8_WAIT_L(8); PG8_BAR; PG8_WAIT_L(0); PG8_MMA(0, 0, At, B0); PG8_BAR; PG8_SCHED;
            PG8_LDB(B1, 1, 1); PG8_STAGE(PG8_SB(1, 0), b3, voffB);
            PG8_BAR; PG8_WAIT_L(0); PG8_MMA(0, 1, At, B1); PG8_BAR;
            PG8_LDA(At, 1, 1); PG8_STAGE(PG8_SA(1, 0), a3, voffA);
            PG8_BAR; PG8_WAIT_L(0); PG8_MMA(1, 0, At, B0); PG8_BAR; PG8_SCHED;
            PG8_STAGE(PG8_SB(1, 1), b3 + hstep, voffB);
            PG8_WAIT_V(6); PG8_BAR; PG8_MMA(1, 1, At, B1); PG8_BAR;
            }
        }
        if constexpr (ALIGN_EPI) { if (wr == 0) PG8_BAR; }
        if constexpr (!Epi::AFTER_DRAIN) { int t2_ = threadIdx.x; asm volatile("" : "+v"(t2_)); const int fr_ = t2_ & 15, fq_ = (t2_ >> 4) & 3;
            E(acc, cur, wr, wc, fr_, fq_); S.done(cur); }
        if (!has_next) break;
#pragma unroll
        for (int a = 0; a < 2; ++a)
#pragma unroll
            for (int b = 0; b < 2; ++b)
#pragma unroll
                for (int m = 0; m < 4; ++m)
#pragma unroll
                    for (int n = 0; n < 2; ++n) acc[a][b][m][n] = (f32x4){0.f, 0.f, 0.f, 0.f};
        cur = nxt; cA = nA; cB = nB; ++ui;
        if constexpr (ALIGN_EPI) { if (wr == 1) PG8_BAR; }
    }
    PG8_WAIT_V(0);
    if constexpr (!ALIGN_EPI) { if (wr == 0) PG8_BAR; }
    PG8_BAR;
    if constexpr (Epi::AFTER_DRAIN) { E.fused(acc, cur, wr, wc, fr, fq, lds, wid, lane); S.done(cur); }
#undef PG8_SA
#undef PG8_SB
#undef PG8_STAGE
#undef PG8_LDA
#undef PG8_LDB
#undef PG8_MMA
#undef PG8_WAIT_V
#undef PG8_WAIT_L
#undef PG8_BAR
#undef PG8_SCHED
}
struct Gemm3 { const bf16_t* A0; const bf16_t* B0; size_t strideA, strideB; int M, N, K;
    __device__ __forceinline__ const bf16_t* selA(int s) const { return A0 + (size_t)s * strideA; }
    __device__ __forceinline__ const bf16_t* selB(int s) const { return B0 + (size_t)s * strideB; } };
struct RowOrder { int nM, nN, G, c;
    __host__ __device__ void init(int M, int N, int G_, int c_) { nM = M / BM; nN = N / BM; G = G_; c = c_; }
#ifndef EXP_ROWREP
#define EXP_ROWREP 1
#endif
    __host__ __device__ bool next(int i0, Unit& u) const { const int i = i0 / EXP_ROWREP; const int pm = c + (i / nN) * G; if (pm >= nM) return false; u.pm = pm; u.pn = i % nN; u.seg = 0; return true; }
    __device__ __forceinline__ void a_ready(const Unit&) const {}
    __device__ __forceinline__ void done(const Unit&) const {} };
struct SubsetOrder { StaticOrder base; unsigned mask;
    __host__ __device__ void init(int M, unsigned mask_, int G_, int c_) { mask = mask_; base.init(M, __builtin_popcount(mask_) * BM, G_, c_); }
    __host__ __device__ bool next(int i, Unit& u) const { if (!base.next(i, u)) return false; unsigned m = mask; for (int j = 0; j < u.pn; ++j) m &= m - 1u; u.pn = __builtin_ctz(m); u.seg = 0; return true; }
    __device__ __forceinline__ void a_ready(const Unit&) const {}
    __device__ __forceinline__ void done(const Unit&) const {} };
struct RowOrderSeg2 { RowOrder base;
    __host__ __device__ void init(int M, int N, int G_, int c_) { base.init(M, N, G_, c_); }
    __host__ __device__ bool next(int i, Unit& u) const { const bool ok = base.next(i, u); u.seg = 2; return ok; } };
struct SameTileOrder { int n;
    __host__ __device__ bool next(int i, Unit& u) const { if (i >= n) return false; u.pm = 0; u.pn = 0; u.seg = 0; return true; }
    __device__ __forceinline__ void a_ready(const Unit&) const {}
    __device__ __forceinline__ void done(const Unit&) const {} };
struct StaticOrder3 { StaticOrder base;
    __host__ __device__ void init(int M, int N, int G_, int c_) { base.init(M, N, G_, c_); }
    __host__ __device__ bool next(int i, Unit& u) const { const bool ok = base.next(i / 3, u); u.seg = i % 3; return ok; } };
template <class Epi, class Sched, bool ALIGN_EPI = false, bool SP2 = false, bool F8 = false>
__device__ __forceinline__ void gemm_phase3(PG8_LAS unsigned char* lds, const Gemm3 g, const Sched& S, const Epi& E) {
    int tid_ = threadIdx.x; asm volatile("" : "+v"(tid_));
    const int tid = tid_, wid = __builtin_amdgcn_readfirstlane(tid >> 6), lane = tid & 63, wr = wid >> 2, wc = wid & 3, fr = lane & 15, fq = lane >> 4;
    const int Kb = F8 ? g.K : 2 * g.K, nt = Kb / 128;
    unsigned voffA[2], voffB[2];
#pragma unroll
    for (int i = 0; i < 2; ++i) { int R, C; stage_rc(tid * 16 + i * 8192, R, C); const int Rb = Epi::PERM ? ((R & ~31) + perm32(R & 31)) : R;
        voffA[i] = (unsigned)(R * Kb + C * 2); voffB[i] = (unsigned)(Rb * Kb + C * 2); }
    const size_t kstep = (size_t)(BK * 2);
    const size_t hstep = (size_t)HALF * Kb;
    const size_t tstep = 2 * hstep;
    const unsigned ldsw = (unsigned)wid * 1024u;
    const int aoff = lds_byte(wr * 64 + fr, F8 ? fq * 16 : fq * 8), boff = lds_byte(wc * 32 + fr, F8 ? fq * 16 : fq * 8);
    constexpr int KINC = F8 ? 16 : 1024;
#define PG8_SA(b, h) (((b) * 2 + (h)) * HTB)
#define PG8_SB(b, h) ((4 + (b) * 2 + (h)) * HTB)
#define PG8_STAGE(bufoff, gbase, voff) do { _Pragma("unroll") for (int _i = 0; _i < 2; ++_i) \
        __builtin_amdgcn_global_load_lds((const unsigned*)((const char*)(gbase) + (size_t)_i * (size_t)(64 * Kb) + (voff)[0]), (PG8_LAS unsigned*)(lds + (bufoff) + ldsw + _i * 8192), 16, 0, 0); } while (0)
#define PG8_LDA(dst, b, h) do { if constexpr (F8) { _Pragma("unroll") for (int m = 0; m < 4; ++m) dst##8[m] = *(const PG8_LAS v8i_t*)(lds + PG8_SA(b, h) + aoff + m * 2048); } \
        else { _Pragma("unroll") for (int m = 0; m < 4; ++m) _Pragma("unroll") for (int k = 0; k < 2; ++k) dst[m][k] = *(const PG8_LAS bf16x8*)(lds + PG8_SA(b, h) + aoff + m * 2048 + k * KINC); } } while (0)
#define PG8_LDB(dst, b, h) do { if constexpr (F8) { _Pragma("unroll") for (int n = 0; n < 2; ++n) dst##8[n] = *(const PG8_LAS v8i_t*)(lds + PG8_SB(b, h) + boff + n * 2048); } \
        else { _Pragma("unroll") for (int n = 0; n < 2; ++n) _Pragma("unroll") for (int k = 0; k < 2; ++k) dst[n][k] = *(const PG8_LAS bf16x8*)(lds + PG8_SB(b, h) + boff + n * 2048 + k * KINC); } } while (0)
#define PG8_MMA(ai, bj, At, Bt) do { __builtin_amdgcn_s_setprio(1); _Pragma("unroll") for (int m = 0; m < 4; ++m) _Pragma("unroll") for (int n = 0; n < 2; ++n) { \
        if constexpr (F8) acc[ai][bj][m][n] = __builtin_amdgcn_mfma_scale_f32_16x16x128_f8f6f4(Bt##8[n], At##8[m], acc[ai][bj][m][n], 0, 0, 0, 0x7f7f7f7f, 0, 0x7f7f7f7f); \
        else { _Pragma("unroll") for (int k = 0; k < 2; ++k) acc[ai][bj][m][n] = __builtin_amdgcn_mfma_f32_16x16x32_bf16(Bt[n][k], At[m][k], acc[ai][bj][m][n], 0, 0, 0); } } \
        __builtin_amdgcn_s_setprio(0); } while (0)
#define PG8_WAIT_V(n) asm volatile("s_waitcnt vmcnt(" #n ")" ::: "memory")
#define PG8_WAIT_L(n) asm volatile("s_waitcnt lgkmcnt(" #n ")" ::: "memory")
#define PG8_BAR __builtin_amdgcn_s_barrier()
#define PG8_SCHED __builtin_amdgcn_sched_barrier(0)
    Unit cur, nxt; int ui = 0;
    if (!S.next(0, cur)) return;
    f32x4 acc[2][2][4][2];
#pragma unroll
    for (int a = 0; a < 2; ++a)
#pragma unroll
        for (int b = 0; b < 2; ++b)
#pragma unroll
            for (int m = 0; m < 4; ++m)
#pragma unroll
                for (int n = 0; n < 2; ++n) acc[a][b][m][n] = (f32x4){0.f, 0.f, 0.f, 0.f};
    bf16x8 At[4][2], B0[2][2], B1[2][2];
    v8i_t At8[4], B08[2], B18[2];
    const char* cA = (const char*)g.selA(cur.seg) + (size_t)cur.pm * tstep; const char* cB = (const char*)g.selB(cur.seg) + (size_t)cur.pn * tstep;
    if constexpr (SP2) {
        PG8_STAGE(PG8_SB(0, 0), cB, voffB); PG8_STAGE(PG8_SB(0, 1), cB + hstep, voffB); PG8_STAGE(PG8_SA(0, 0), cA, voffA); PG8_STAGE(PG8_SA(0, 1), cA + hstep, voffA);
        if (wr == 1) PG8_BAR;
        PG8_WAIT_V(2); PG8_BAR;
        PG8_STAGE(PG8_SB(1, 0), cB + kstep, voffB); PG8_STAGE(PG8_SA(1, 0), cA + kstep, voffA); PG8_STAGE(PG8_SB(1, 1), cB + hstep + kstep, voffB);
        PG8_WAIT_V(6); PG8_BAR;
    } else {
        PG8_STAGE(PG8_SB(0, 0), cB, voffB); PG8_STAGE(PG8_SA(0, 0), cA, voffA); PG8_STAGE(PG8_SB(0, 1), cB + hstep, voffB); PG8_STAGE(PG8_SA(0, 1), cA + hstep, voffA);
        if (wr == 1) PG8_BAR;
        PG8_WAIT_V(4); PG8_BAR;
        PG8_STAGE(PG8_SB(1, 0), cB + kstep, voffB); PG8_STAGE(PG8_SA(1, 0), cA + kstep, voffA); PG8_STAGE(PG8_SB(1, 1), cB + hstep + kstep, voffB);
        PG8_WAIT_V(6); PG8_BAR;
    }
    for (;;) {
        const bool has_next = S.next(ui + 1, nxt);
        const char* nA = has_next ? (const char*)g.selA(nxt.seg) + (size_t)nxt.pm * tstep : cA; const char* nB = has_next ? (const char*)g.selB(nxt.seg) + (size_t)nxt.pn * tstep : cB;
#pragma unroll 1
        for (int t = 0; t < nt; t += 2) {
            const bool last = (t == nt - 2);
            const char* a1 = cA + (size_t)(t + 1) * kstep;
            const char* a2 = last ? nA : cA + (size_t)(t + 2) * kstep; const char* b2 = last ? nB : cB + (size_t)(t + 2) * kstep;
            const char* a3 = a2 + kstep; const char* b3 = b2 + kstep;
            if constexpr (SP2) {
            PG8_LDB(B0, 0, 0); PG8_LDB(B1, 0, 1); PG8_SCHED; PG8_LDA(At, 0, 0); PG8_STAGE(PG8_SA(1, 1), a1 + hstep, voffA);
            PG8_WAIT_V(8); PG8_WAIT_L(0); PG8_BAR; PG8_MMA(0, 0, At, B0); PG8_MMA(0, 1, At, B1); PG8_BAR; PG8_SCHED;
            PG8_LDA(At, 0, 1); PG8_STAGE(PG8_SB(0, 0), b2, voffB); PG8_STAGE(PG8_SB(0, 1), b2 + hstep, voffB); PG8_STAGE(PG8_SA(0, 0), a2, voffA);
            PG8_WAIT_V(8); PG8_WAIT_L(0); PG8_BAR; PG8_MMA(1, 0, At, B0); PG8_MMA(1, 1, At, B1); PG8_BAR; PG8_SCHED;
            PG8_LDB(B0, 1, 0); PG8_LDB(B1, 1, 1); PG8_SCHED; PG8_LDA(At, 1, 0); PG8_STAGE(PG8_SA(0, 1), a2 + hstep, voffA);
            PG8_WAIT_V(8); PG8_WAIT_L(0); PG8_BAR; PG8_MMA(0, 0, At, B0); PG8_MMA(0, 1, At, B1); PG8_BAR; PG8_SCHED;
            PG8_LDA(At, 1, 1); PG8_STAGE(PG8_SB(1, 0), b3, voffB); PG8_STAGE(PG8_SB(1, 1), b3 + hstep, voffB); PG8_STAGE(PG8_SA(1, 0), a3, voffA);
            PG8_WAIT_V(8); PG8_WAIT_L(0); PG8_BAR; PG8_MMA(1, 0, At, B0); PG8_MMA(1, 1, At, B1); PG8_BAR; PG8_SCHED;
            } else {
            PG8_LDB(B0, 0, 0); PG8_SCHED; PG8_LDA(At, 0, 0); PG8_STAGE(PG8_SA(1, 1), a1 + hstep, voffA);
            PG8_WAIT_L(8); PG8_BAR; PG8_WAIT_L(0); PG8_MMA(0, 0, At, B0); PG8_BAR; PG8_SCHED;
            PG8_LDB(B1, 0, 1); PG8_STAGE(PG8_SB(0, 0), b2, voffB);
            PG8_BAR; PG8_WAIT_L(0); PG8_MMA(0, 1, At, B1); PG8_BAR;
            PG8_LDA(At, 0, 1); PG8_STAGE(PG8_SA(0, 0), a2, voffA);
            PG8_BAR; PG8_WAIT_L(0); PG8_MMA(1, 0, At, B0); PG8_BAR; PG8_SCHED;
            PG8_STAGE(PG8_SB(0, 1), b2 + hstep, voffB);
            PG8_WAIT_V(6); PG8_BAR; PG8_MMA(1, 1, At, B1); PG8_BAR;
            PG8_LDB(B0, 1, 0); PG8_SCHED; PG8_LDA(At, 1, 0); PG8_STAGE(PG8_SA(0, 1), a2 + hstep, voffA);
            PG8_WAIT_L(8); PG8_BAR; PG8_WAIT_L(0); PG8_MMA(0, 0, At, B0); PG8_BAR; PG8_SCHED;
            PG8_LDB(B1, 1, 1); PG8_STAGE(PG8_SB(1, 0), b3, voffB);
            PG8_BAR; PG8_WAIT_L(0); PG8_MMA(0, 1, At, B1); PG8_BAR;
            PG8_LDA(At, 1, 1); PG8_STAGE(PG8_SA(1, 0), a3, voffA);
            PG8_BAR; PG8_WAIT_L(0); PG8_MMA(1, 0, At, B0); PG8_BAR; PG8_SCHED;
            PG8_STAGE(PG8_SB(1, 1), b3 + hstep, voffB);
            PG8_WAIT_V(6); PG8_BAR; PG8_MMA(1, 1, At, B1); PG8_BAR;
            }
        }
        if constexpr (ALIGN_EPI) { if (wr == 0) PG8_BAR; }
        { int t2_ = threadIdx.x; asm volatile("" : "+v"(t2_)); const int fr_ = t2_ & 15, fq_ = (t2_ >> 4) & 3;
          if (cur.seg < 2) E.mid(acc, cur, wr, wc, fr_, fq_); else E(acc, cur, wr, wc, fr_, fq_); }
        if (!has_next) break;
        if (cur.seg == 2) {
#pragma unroll
        for (int a = 0; a < 2; ++a)
#pragma unroll
            for (int b = 0; b < 2; ++b)
#pragma unroll
                for (int m = 0; m < 4; ++m)
#pragma unroll
                    for (int n = 0; n < 2; ++n) acc[a][b][m][n] = (f32x4){0.f, 0.f, 0.f, 0.f};
        }
        cur = nxt; cA = nA; cB = nB; ++ui;
        if constexpr (ALIGN_EPI) { if (wr == 1) PG8_BAR; }
    }
    PG8_WAIT_V(0);
    if constexpr (!ALIGN_EPI) { if (wr == 0) PG8_BAR; }
    PG8_BAR;
#undef PG8_SA
#undef PG8_SB
#undef PG8_STAGE
#undef PG8_LDA
#undef PG8_LDB
#undef PG8_MMA
#undef PG8_WAIT_V
#undef PG8_WAIT_L
#undef PG8_BAR
#undef PG8_SCHED
}
}
namespace pg8 {
__device__ __forceinline__ float bf_lo(unsigned u) { return __uint_as_float(u << 16); }
__device__ __forceinline__ float bf_hi(unsigned u) { return __uint_as_float(u & 0xffff0000u); }
__device__ __forceinline__ float sigmoidf_(float x) { return 1.0f / (1.0f + __expf(-x)); }
__device__ const float ROTC[32] = {1.591549431e-01f, 1.182463853e-01f, 8.785280159e-02f, 6.527146455e-02f, 4.849434518e-02f, 3.602955028e-02f, 2.676865702e-02f, 1.988814718e-02f, 1.477617640e-02f, 1.097816640e-02f, 8.156381877e-03f, 6.059897703e-03f, 4.502285539e-03f, 3.345035851e-03f, 2.485241052e-03f, 1.846444510e-03f, 1.371841708e-03f, 1.019228935e-03f, 7.572503565e-04f, 5.626097166e-04f, 4.179987378e-04f, 3.105579936e-04f, 2.307333939e-04f, 1.714265939e-04f, 1.273637795e-04f, 9.462669678e-05f, 7.030422448e-05f, 5.223350438e-05f, 3.880761077e-05f, 2.883265582e-05f, 2.142162388e-05f, 1.591549431e-05f};

struct EpiInProj {
    static constexpr bool PERM = true, AFTER_DRAIN = false;
    bf16_t *AQ, *AK, *AV, *RQ, *RK, *RV, *RG, *MQ, *G; const float* biasp; float ascale;
    __device__ __forceinline__ void operator()(const f32x4 (&acc)[2][2][4][2], const Unit& u, int wr, int wc, int fr, int fq) const {
        const int pn = u.pn, row0 = u.pm * BM + wr * 64 + fr, cw = wc * 32 + 8 * fq;
#pragma unroll
        for (int bj = 0; bj < 2; ++bj) {
            const int ct = bj * HALF + cw;
            bf16_t* base; int ld, col, mode;
            if (pn < 2)       { base = AQ; ld = 512; col = pn * 256 + ct; mode = 0; }
            else if (pn == 2) { base = bj == 0 ? AK : AV; ld = 128; col = cw; mode = 0; }
            else if (pn == 3) { base = RQ; ld = 256; col = ct; mode = 1; }
            else if (pn == 4) { base = RK; ld = 256; col = ct; mode = 2; }
            else if (pn < 7)  { base = RV; ld = 512; col = (pn - 5) * 256 + ct; mode = 0; }
            else if (pn < 9)  { base = RG; ld = 512; col = (pn - 7) * 256 + ct; mode = 3; }
            else if (pn < 11) { base = MQ; ld = 512; col = (pn - 9) * 256 + ct; mode = 0; }
            else              { base = G; ld = 3072; col = (pn - 11) * 256 + ct; mode = 4; }
            const f32x4 b0 = *(const f32x4*)(biasp + pn * 256 + ct), b1 = *(const f32x4*)(biasp + pn * 256 + ct + 4);
            f32x4 rc = (f32x4){0.f, 0.f, 0.f, 0.f};
            if (mode == 1 || mode == 2) rc = *(const f32x4*)(ROTC + 4 * (4 * (wc & 1) + fq));
#pragma unroll
            for (int ai = 0; ai < 2; ++ai)
#pragma unroll
                for (int m = 0; m < 4; ++m) {
                    const int row = row0 + ai * HALF + m * 16;
                    f32x4 v0 = acc[ai][bj][m][0] * ascale + b0, v1 = acc[ai][bj][m][1] * ascale + b1;
                    if (mode == 1 || mode == 2) {
                        const float pos = (float)(row & 8191), sc = (mode == 2) ? 0.125f : 1.0f;
                        f32x4 o0, o1;
#pragma unroll
                        for (int e = 0; e < 4; ++e) {
                            float rev = pos * rc[e]; rev = rev - floorf(rev);
                            const float sn = __builtin_amdgcn_sinf(rev) * sc, cs = __builtin_amdgcn_cosf(rev) * sc;
                            o0[e] = v0[e] * cs - v1[e] * sn; o1[e] = v0[e] * sn + v1[e] * cs;
                        }
                        v0 = o0; v1 = o1;
                    } else if (mode == 3) {
#pragma unroll
                        for (int e = 0; e < 4; ++e) { v0[e] = v0[e] * sigmoidf_(v0[e]); v1[e] = v1[e] * sigmoidf_(v1[e]); }
                    } else if (mode == 4) {
#pragma unroll
                        for (int e = 0; e < 4; ++e) { v0[e] = fmaxf(sigmoidf_(v0[e]), 1e-30f); v1[e] = fmaxf(sigmoidf_(v1[e]), 1e-30f); }
                    }
                    u32x4 w; w.x = cvt_pk_bf16(v0[0], v0[1]); w.y = cvt_pk_bf16(v0[2], v0[3]); w.z = cvt_pk_bf16(v1[0], v1[1]); w.w = cvt_pk_bf16(v1[2], v1[3]);
                    *(u32x4*)(base + (size_t)row * ld + col) = w;
                }
        }
    }
};

struct EpiMkv {
    static constexpr bool PERM = true, AFTER_DRAIN = false;
    bf16_t *MK, *MVT;
    __device__ __forceinline__ void operator()(const f32x4 (&acc)[2][2][4][2], const Unit& u, int wr, int wc, int fr, int fq) const {
        const int row0 = u.pm * BM + wr * 64 + fr;
#pragma unroll
        for (int bj = 0; bj < 2; ++bj) {
            const int c0 = u.pn * 256 + bj * HALF + wc * 32 + 8 * fq;
#pragma unroll
            for (int ai = 0; ai < 2; ++ai)
#pragma unroll
                for (int m = 0; m < 4; ++m) {
                    const int row = row0 + ai * HALF + m * 16;
                    const f32x4 v0 = acc[ai][bj][m][0], v1 = acc[ai][bj][m][1];
                    if (u.pn < 2) {
                        u32x4 w; w.x = cvt_pk_bf16(v0[0], v0[1]); w.y = cvt_pk_bf16(v0[2], v0[3]); w.z = cvt_pk_bf16(v1[0], v1[1]); w.w = cvt_pk_bf16(v1[2], v1[3]);
                        *(u32x4*)(MK + (size_t)row * 512 + c0) = w;
                    } else {
                        const int c = c0 - 512, h = c >> 7, d = c & 127, b = row >> 8, mm = row & 255;
                        bf16_t* p = MVT + ((size_t)((b * 4 + h) * 128 + d)) * 256 + mm;
#pragma unroll
                        for (int e = 0; e < 4; ++e) { p[(size_t)e * 256] = (bf16_t)(cvt_pk_bf16(v0[e], 0.f) & 0xffffu); p[(size_t)(e + 4) * 256] = (bf16_t)(cvt_pk_bf16(v1[e], 0.f) & 0xffffu); }
                    }
                }
        }
    }
};

struct EpiGate {
    static constexpr bool PERM = true, AFTER_DRAIN = false;
    bf16_t* Mg; const bf16_t* G; int goff; int first;
    __device__ __forceinline__ void operator()(const f32x4 (&acc)[2][2][4][2], const Unit& u, int wr, int wc, int fr, int fq) const {
        const int row0 = u.pm * BM + wr * 64 + fr, col0 = u.pn * BM + wc * 32 + 8 * fq;
#pragma unroll
        for (int ai = 0; ai < 2; ++ai)
#pragma unroll
            for (int m = 0; m < 4; ++m) {
                const int row = row0 + ai * HALF + m * 16;
#pragma unroll
                for (int bj = 0; bj < 2; ++bj) {
                    const int col = col0 + bj * HALF;
                    const u32x4 g = *(const u32x4*)(G + (size_t)row * 3072 + goff + col);
                    u32x4 pv = (u32x4){0u, 0u, 0u, 0u};
                    if (!first) pv = *(const u32x4*)(Mg + (size_t)row * 1024 + col);
                    const f32x4 v0 = acc[ai][bj][m][0], v1 = acc[ai][bj][m][1];
                    u32x4 w;
                    w.x = cvt_pk_bf16(bf_lo(pv.x) + bf_lo(g.x) * v0[0], bf_hi(pv.x) + bf_hi(g.x) * v0[1]);
                    w.y = cvt_pk_bf16(bf_lo(pv.y) + bf_lo(g.y) * v0[2], bf_hi(pv.y) + bf_hi(g.y) * v0[3]);
                    w.z = cvt_pk_bf16(bf_lo(pv.z) + bf_lo(g.z) * v1[0], bf_hi(pv.z) + bf_hi(g.z) * v1[1]);
                    w.w = cvt_pk_bf16(bf_lo(pv.w) + bf_lo(g.w) * v1[2], bf_hi(pv.w) + bf_hi(g.w) * v1[3]);
                    *(u32x4*)(Mg + (size_t)row * 1024 + col) = w;
                }
            }
    }
};

struct EpiGate3 {
    static constexpr bool PERM = true, AFTER_DRAIN = false;
    bf16_t* Mg; const bf16_t* G; float f8scale, bscale;
#ifdef EXP_P5MID
    int skipmid = 0;
#endif
    __device__ __forceinline__ void mid(f32x4 (&acc)[2][2][4][2], const Unit& u, int wr, int wc, int fr, int fq) const {
        const int row0 = u.pm * BM + wr * 64 + fr, col0 = u.pn * BM + wc * 32 + 8 * fq, ga_off = u.seg * 1024, gb_off = ga_off + 1024;
#ifdef EXP_P5MID
        if (skipmid) return;
#endif
        const bf16_t* g0 = G + (size_t)row0 * 3072 + col0;
#pragma unroll
        for (int ai = 0; ai < 2; ++ai) {
            u32x4 GA[8], GB[8];
#pragma unroll
            for (int i = 0; i < 8; ++i) { const bf16_t* grow = g0 + (size_t)(ai * HALF + (i >> 1) * 16) * 3072 + (i & 1) * HALF; GA[i] = *(const u32x4*)(grow + ga_off); GB[i] = *(const u32x4*)(grow + gb_off); }
            __builtin_amdgcn_sched_barrier(0);
#pragma unroll
            for (int i = 0; i < 8; ++i) {
                const u32x4 ga = GA[i], gb = GB[i];
                f32x4& v0 = acc[ai][i & 1][i >> 1][0]; f32x4& v1 = acc[ai][i & 1][i >> 1][1];
                v0[0] *= bf_lo(ga.x) * __builtin_amdgcn_rcpf(bf_lo(gb.x)); v0[1] *= bf_hi(ga.x) * __builtin_amdgcn_rcpf(bf_hi(gb.x));
                v0[2] *= bf_lo(ga.y) * __builtin_amdgcn_rcpf(bf_lo(gb.y)); v0[3] *= bf_hi(ga.y) * __builtin_amdgcn_rcpf(bf_hi(gb.y));
                v1[0] *= bf_lo(ga.z) * __builtin_amdgcn_rcpf(bf_lo(gb.z)); v1[1] *= bf_hi(ga.z) * __builtin_amdgcn_rcpf(bf_hi(gb.z));
                v1[2] *= bf_lo(ga.w) * __builtin_amdgcn_rcpf(bf_lo(gb.w)); v1[3] *= bf_hi(ga.w) * __builtin_amdgcn_rcpf(bf_hi(gb.w));
            }
            __builtin_amdgcn_sched_barrier(0);
        }
    }
    __device__ __forceinline__ void operator()(const f32x4 (&acc)[2][2][4][2], const Unit& u, int wr, int wc, int fr, int fq) const {
        const int row0 = u.pm * BM + wr * 64 + fr, col0 = u.pn * BM + wc * 32 + 8 * fq;
        u32x4 GG[16];
#pragma unroll
        for (int i = 0; i < 16; ++i) GG[i] = *(const u32x4*)(G + (size_t)(row0 + (i >> 3) * HALF + ((i >> 1) & 3) * 16) * 3072 + 2048 + col0 + (i & 1) * HALF);
        __builtin_amdgcn_sched_barrier(0);
#pragma unroll
        for (int ai = 0; ai < 2; ++ai)
#pragma unroll
            for (int m = 0; m < 4; ++m) {
                const int row = row0 + ai * HALF + m * 16;
#pragma unroll
                for (int bj = 0; bj < 2; ++bj) {
                    const int col = col0 + bj * HALF;
                    const u32x4 g = GG[ai * 8 + m * 2 + bj];
                    const f32x4 v0 = acc[ai][bj][m][0], v1 = acc[ai][bj][m][1];
                    if (f8scale != 0.f) {
                        const float s = f8scale;
                        int lo = __builtin_amdgcn_cvt_pk_fp8_f32(bf_lo(g.x) * v0[0] * s, bf_hi(g.x) * v0[1] * s, 0, false); lo = __builtin_amdgcn_cvt_pk_fp8_f32(bf_lo(g.y) * v0[2] * s, bf_hi(g.y) * v0[3] * s, lo, true);
                        int hi = __builtin_amdgcn_cvt_pk_fp8_f32(bf_lo(g.z) * v1[0] * s, bf_hi(g.z) * v1[1] * s, 0, false); hi = __builtin_amdgcn_cvt_pk_fp8_f32(bf_lo(g.w) * v1[2] * s, bf_hi(g.w) * v1[3] * s, hi, true);
                        typedef unsigned u32x2_ __attribute__((ext_vector_type(2)));
                        *(u32x2_*)((unsigned char*)Mg + (size_t)row * 1024 + col) = (u32x2_){(unsigned)lo, (unsigned)hi};
                    } else {
                        u32x4 w;
                        const float b = bscale;
                        w.x = cvt_pk_bf16(bf_lo(g.x) * v0[0] * b, bf_hi(g.x) * v0[1] * b); w.y = cvt_pk_bf16(bf_lo(g.y) * v0[2] * b, bf_hi(g.y) * v0[3] * b);
                        w.z = cvt_pk_bf16(bf_lo(g.z) * v1[0] * b, bf_hi(g.z) * v1[1] * b); w.w = cvt_pk_bf16(bf_lo(g.w) * v1[2] * b, bf_hi(g.w) * v1[3] * b);
                        *(u32x4*)(Mg + (size_t)row * 1024 + col) = w;
                    }
                }
            }
    }
};

struct EpiResid {
    static constexpr bool PERM = true, AFTER_DRAIN = false;
    const float* X; bf16_t* out; float alpha, ascale;
    __device__ __forceinline__ void operator()(const f32x4 (&acc)[2][2][4][2], const Unit& u, int wr, int wc, int fr, int fq) const {
        const unsigned row0 = u.pm * BM + wr * 64 + fr, col0 = u.pn * BM + wc * 32 + 8 * fq;
#pragma unroll
        for (int ai = 0; ai < 2; ++ai) {
            f32x4 X0[8], X1[8];
#pragma unroll
            for (int i = 0; i < 8; ++i) { const unsigned off = (row0 + ai * HALF + (i >> 1) * 16) * 1024u + col0 + (i & 1) * HALF; X0[i] = *(const f32x4*)(X + off); X1[i] = *(const f32x4*)(X + (off + 4)); }
            __builtin_amdgcn_sched_barrier(0);
#pragma unroll
            for (int i = 0; i < 8; ++i) {
                const int m = i >> 1, bj = i & 1;
                const unsigned off = (row0 + ai * HALF + m * 16) * 1024u + col0 + bj * HALF;
                const f32x4 v0 = X0[i] * alpha + acc[ai][bj][m][0] * ascale, v1 = X1[i] * alpha + acc[ai][bj][m][1] * ascale;
                u32x4 w; w.x = cvt_pk_bf16(v0[0], v0[1]); w.y = cvt_pk_bf16(v0[2], v0[3]); w.z = cvt_pk_bf16(v1[0], v1[1]); w.w = cvt_pk_bf16(v1[2], v1[3]);
                *(u32x4*)(out + off) = w;
            }
            __builtin_amdgcn_sched_barrier(0);
        }
    }
};
struct EpiResid3 : EpiResid {
    __device__ __forceinline__ void mid(f32x4 (&)[2][2][4][2], const Unit&, int, int, int, int) const {}
};
}
#define GAS __attribute__((address_space(1)))
#define LAS __attribute__((address_space(3)))
typedef unsigned short bf16;
typedef unsigned v4u __attribute__((ext_vector_type(4)));
typedef float f32x4 __attribute__((ext_vector_type(4)));
typedef short bf16x8 __attribute__((ext_vector_type(8)));
typedef GAS unsigned gu32;
typedef GAS unsigned long long gu64;
#define RLX_AGENT __ATOMIC_RELAXED, __HIP_MEMORY_SCOPE_AGENT
#define LDS_WAIT() asm volatile("s_waitcnt lgkmcnt(0)" ::: "memory")
#define VM_WAIT() asm volatile("s_waitcnt vmcnt(0)" ::: "memory")
__device__ __forceinline__ unsigned long long rt() { return __builtin_amdgcn_s_memrealtime(); }
__device__ __forceinline__ unsigned f2bf(float f) { unsigned u = __builtin_bit_cast(unsigned, f); return (u + 0x7fffu + ((u >> 16) & 1u)) >> 16; }
__device__ __forceinline__ unsigned pk2(float lo, float hi) { return f2bf(lo) | (f2bf(hi) << 16); }
#define XB_TMO      128
#define XB_XCNT(j)  (256  + 64 * (j))
#define XB_XSUB(j)  (1280 + 64 * (j))
#define XB_XGEN(j)  (2304 + 64 * (j))
#define XB_TOP      3328
#define XB_TOPGEN   3392
#define XCD_BAR_WORDS 3456
#define XB_SPIN_CAP (1u << 18)

__device__ __forceinline__ unsigned xb_ld(unsigned* p)              { return __hip_atomic_load(p, __ATOMIC_RELAXED, __HIP_MEMORY_SCOPE_AGENT); }
__device__ __forceinline__ unsigned xb_add(unsigned* p, unsigned v) { return __hip_atomic_fetch_add(p, v, __ATOMIC_RELAXED, __HIP_MEMORY_SCOPE_AGENT); }
__device__ __forceinline__ unsigned xb_xcc_id() { return (unsigned)__builtin_amdgcn_s_getreg((3 << 11) | 20) & 0xFu; }
#define XB_SPIN(cond, bar) do { unsigned _sp = 0; while (cond) { __builtin_amdgcn_s_sleep(1); \
    if ((++_sp & 255u) == 0u) { if (xb_ld(&(bar)[XB_TMO])) break; if (_sp > XB_SPIN_CAP) { atomicAdd(&(bar)[XB_TMO], 1u); break; } } } } while (0)

struct XcdBarrier {
    unsigned* bar; unsigned x;
    volatile LAS unsigned* st;
};

__device__ __forceinline__ XcdBarrier xcd_barrier_post(unsigned* bar, volatile LAS unsigned* st) {
    XcdBarrier b; b.bar = bar; b.x = xb_xcc_id(); b.st = st;
    if (threadIdx.x == 0) (void)xb_add(&bar[XB_XCNT(b.x)], 1u);
    return b;
}
__device__ __forceinline__ void xcd_barrier_complete(unsigned* bar, unsigned x, unsigned& nloc, unsigned& nx) {
    const unsigned G = gridDim.x * gridDim.y * gridDim.z;
    unsigned sum, cnt, mine, sp = 0u;
    for (;;) {
        sum = 0u; cnt = 0u; mine = 0u;
#pragma unroll
        for (unsigned j = 0; j < 16; ++j) { const unsigned c = xb_ld(&bar[XB_XCNT(j)]); sum += c; cnt += (c > 0u) ? 1u : 0u; mine = (j == x) ? c : mine; }
        if (sum == G) break;
        __builtin_amdgcn_s_sleep(1);
        if ((++sp & 255u) == 0u) { if (xb_ld(&bar[XB_TMO])) break; if (sp > XB_SPIN_CAP) { atomicAdd(&bar[XB_TMO], 1u); break; } }
    }
    nloc = mine > 0u ? mine : 1u; nx = cnt > 0u ? cnt : 1u;
}

__device__ __forceinline__ void xcd_barrier(const XcdBarrier& b) {
    asm volatile("s_waitcnt vmcnt(0)" ::: "memory");
    __syncthreads();
    if (threadIdx.x == 0) {
        unsigned* bar = b.bar;
        __builtin_amdgcn_s_waitcnt(0);
        unsigned nloc = b.st[0], nx = b.st[1];
        if (nloc == 0u) { xcd_barrier_complete(bar, b.x, nloc, nx); b.st[0] = nloc; b.st[1] = nx; }
        const unsigned old = xb_add(&bar[XB_XSUB(b.x)], 1u);
        const unsigned gen = old / nloc;
        if (old + 1u == (gen + 1u) * nloc) {
            __builtin_amdgcn_fence(__ATOMIC_RELEASE, "agent");
            asm volatile("s_waitcnt vmcnt(0)" ::: "memory");
            const unsigned og = xb_add(&bar[XB_TOP], 1u);
            const unsigned tg = og / nx;
            if (og + 1u == (tg + 1u) * nx) xb_add(&bar[XB_TOPGEN], 1u);
            else XB_SPIN(xb_ld(&bar[XB_TOPGEN]) == tg, bar);
            __builtin_amdgcn_fence(__ATOMIC_ACQUIRE, "agent");
            xb_add(&bar[XB_XGEN(b.x)], 1u);
            asm volatile("s_waitcnt vmcnt(0)" ::: "memory");
        } else {
            XB_SPIN(xb_ld(&bar[XB_XGEN(b.x)]) == gen, bar);
            __builtin_amdgcn_fence(__ATOMIC_ACQUIRE, "agent");
            asm volatile("s_waitcnt vmcnt(0)" ::: "memory");
        }
    }
    __syncthreads();
}
#ifndef PEER_U_INT8
#define PEER_U_INT4 1
#ifndef PEER_U_NO_DOT8
#define PEER_U_DOT8 1
#endif
#endif
#ifndef P1_ALIGN
#define P1_ALIGN true
#endif
#ifndef P1_SP2
#define P1_SP2 true
#endif
#ifndef P6_F8
#define P6_BF16 1
#endif
#if !defined(GEMM_BF16_ONLY) && !defined(P56_BF16)
#define GEMM56_F8 1
#endif
#ifndef GEMM_BF16_ONLY
#define GEMM_F8 1
#endif
#ifndef P5_ALIGN
#define P5_ALIGN true
#endif
#ifndef P6_ALIGN
#define P6_ALIGN true
#endif
#ifndef P1_BF16_TILES
#define P1_BF16_TILES 0x198u
#endif
#ifndef P6_SP2
#define P6_SP2 false
#endif
#ifndef P1F8_SP2
#define P1F8_SP2 true
#endif
#ifndef P5F8_SP2
#define P5F8_SP2 true
#endif
constexpr int NWAVES = 8, NTHR = 512;
constexpr int T = 65536, D = 1024, SEQ = 8192, NBATCH = 8, NCHUNK = 64, INW = 5888;
constexpr float LN_EPS = 1e-5f, ALPHA = 1.189207115002721f;
constexpr float W8_SCALE = 64.f;
constexpr float BR8_SCALE = 8.f, MG8_SCALE = 16.f;
#ifndef MK_N_LAUNCHES
#define MK_N_LAUNCHES 1
#endif
constexpr int N_PHASES = 10;
constexpr int N_LAUNCHES = MK_N_LAUNCHES;

constexpr size_t MiB = 1u << 20;
constexpr size_t WS_CTL = 0, CTL_ZERO_BYTES = 64 * 1024;
constexpr size_t WS_WIN = 2 * MiB;
constexpr size_t WS_WBA = 14 * MiB, WS_WBR = 15 * MiB, WS_WBM = 16 * MiB;
constexpr size_t WS_WOUT = 17 * MiB;
constexpr size_t WS_WPQ = 19 * MiB;
constexpr size_t WS_WMKV = 23 * MiB;
constexpr size_t WS_SUBK = 25 * MiB;
constexpr size_t WS_BIASP = 25 * MiB + 512 * 1024;
constexpr size_t WS_MEMN = 26 * MiB;
constexpr size_t WS_MK = 30 * MiB;
constexpr size_t WS_MVT = 32 * MiB;
constexpr size_t WS_PU = 34 * MiB, WS_PV = 66 * MiB;
constexpr size_t WS_KV = 98 * MiB;
constexpr size_t WS_ST = 162 * MiB;
constexpr size_t WS_AQ = 194 * MiB, WS_RV = 258 * MiB, WS_MQ = 322 * MiB;
constexpr size_t WS_AK = 386 * MiB, WS_AV = 402 * MiB, WS_RQ = 418 * MiB, WS_RK = 450 * MiB, WS_RG = 482 * MiB;
constexpr size_t WS_MERGED = 386 * MiB;
constexpr size_t WS_G = 546 * MiB;
constexpr size_t WS_PQ = 546 * MiB;
constexpr size_t WS_HB = 194 * MiB;
constexpr size_t WS_H8 = 322 * MiB;
constexpr size_t WS_HS = 25 * MiB + 768 * 1024;
constexpr size_t WS_VS = 25 * MiB + 704 * 1024;
constexpr size_t WS_US = 25 * MiB + 640 * 1024;
constexpr size_t WS_PO = 802 * MiB;
constexpr size_t WS_WIN8 = 932 * MiB;
constexpr size_t WS_END = 940 * MiB;
constexpr int CW_BAR = 4096;

constexpr int LDS_BYTES = 163840, LDSCTL_OFF = 163840 - 512, MISC_OFF = LDSCTL_OFF + 320;

typedef unsigned long long u64;
typedef unsigned short u16;
typedef __bf16 bf16x2_t __attribute__((ext_vector_type(2)));

__device__ __forceinline__ const float* karg_in(int k) {
    const __attribute__((address_space(4))) char* kp = (const __attribute__((address_space(4))) char*)__builtin_amdgcn_kernarg_segment_ptr();
    asm volatile("" : "+s"(kp));
    return *(const float* const __attribute__((address_space(4)))*)(kp + 8 * k);
}
struct Frame {
    LAS unsigned char* lds;
    int tid, lane, wave, fr, fq;
    int G;
    float* out; unsigned char* ws;
};

__device__ __forceinline__ f32x4 mma16(bf16x8 arow, bf16x8 bcol, f32x4 acc) { return __builtin_amdgcn_mfma_f32_16x16x32_bf16(bcol, arow, acc, 0, 0, 0); }
__device__ __forceinline__ float bflo(unsigned u) { return __uint_as_float(u << 16); }
__device__ __forceinline__ float bfhi(unsigned u) { return __uint_as_float(u & 0xffff0000u); }
template <int CTRL> __device__ __forceinline__ float dpp(float x) { return __builtin_bit_cast(float, __builtin_amdgcn_mov_dpp(__builtin_bit_cast(int, x), CTRL, 0xf, 0xf, true)); }
constexpr int XOR1 = 0xB1, XOR2 = 0x4E, XOR7 = 0x141, XOR8 = 0x128;
__device__ __forceinline__ float xrow16_sum(float x) {
    auto s = __builtin_amdgcn_permlane16_swap(__float_as_uint(x), __float_as_uint(x), false, false);
    x = __uint_as_float(s[0]) + __uint_as_float(s[1]);
    auto t = __builtin_amdgcn_permlane32_swap(__float_as_uint(x), __float_as_uint(x), false, false);
    return __uint_as_float(t[0]) + __uint_as_float(t[1]);
}
__device__ __forceinline__ float xrow16_max(float x) {
    auto s = __builtin_amdgcn_permlane16_swap(__float_as_uint(x), __float_as_uint(x), false, false);
    x = fmaxf(__uint_as_float(s[0]), __uint_as_float(s[1]));
    auto t = __builtin_amdgcn_permlane32_swap(__float_as_uint(x), __float_as_uint(x), false, false);
    return fmaxf(__uint_as_float(t[0]), __uint_as_float(t[1]));
}
__device__ __forceinline__ float wave_sum(float v) { v += dpp<XOR1>(v); v += dpp<XOR2>(v); v += dpp<XOR7>(v); v += dpp<XOR8>(v); return xrow16_sum(v); }
__device__ __forceinline__ float quad_sum(float v) { v += __shfl_xor(v, 16); v += __shfl_xor(v, 32); return v; }
__device__ __forceinline__ float quad_max(float v) { v = fmaxf(v, __shfl_xor(v, 16)); v = fmaxf(v, __shfl_xor(v, 32)); return v; }

__device__ __forceinline__ int win_src_col(int c) {
    if (c < 768 || c >= 1280) return c;
    const int p = c & 63, base = c - p, i = p >> 3, e = p & 7;
    return base + (e < 4 ? 4 * i + e : 32 + 4 * i + (e - 4));
}
template <bool WIN>
__device__ __forceinline__ void p0_transpose_item(const float* W, int K, int N, bf16* WT, LAS float* scr, int item, int lane) {
    const int nblk = N / 32, kb = item / nblk, nb = item % nblk, k0 = 64 * kb, n0 = 32 * nb;
    const int nsrc = WIN ? win_src_col(n0 + (lane & 31)) : n0 + (lane & 31);
#pragma unroll 8
    for (int i = 0; i < 32; ++i) { const int kk = 2 * i + (lane >> 5); scr[kk * 33 + (lane & 31)] = W[(size_t)(k0 + kk) * N + nsrc]; }
    LDS_WAIT(); asm volatile("" ::: "memory");
    const int c = lane & 7;
#pragma unroll
    for (int j = 0; j < 4; ++j) { const int n = (lane >> 3) + 8 * j; const LAS float* s = scr + (8 * c) * 33 + n;
        v4u o; o.x = pk2(s[0 * 33], s[1 * 33]); o.y = pk2(s[2 * 33], s[3 * 33]); o.z = pk2(s[4 * 33], s[5 * 33]); o.w = pk2(s[6 * 33], s[7 * 33]);
        *(v4u*)(WT + (size_t)(n0 + n) * K + k0 + 8 * c) = o; }
    LDS_WAIT(); asm volatile("" ::: "memory");
}
__device__ __forceinline__ unsigned pk4_fp8(float a, float b, float c, float d) { int r = __builtin_amdgcn_cvt_pk_fp8_f32(a, b, 0, false); r = __builtin_amdgcn_cvt_pk_fp8_f32(c, d, r, true); return (unsigned)r; }
template <bool WIN>
__device__ __forceinline__ void p0_transpose_item_f8(const float* W, int K, int N, unsigned char* WT, float scale, LAS float* scr, int item, int lane) {
    const int nblk = N / 32, kb = item / nblk, nb = item % nblk, k0 = 64 * kb, n0 = 32 * nb;
    const int nsrc = WIN ? win_src_col(n0 + (lane & 31)) : n0 + (lane & 31);
#pragma unroll 8
    for (int i = 0; i < 32; ++i) { const int kk = 2 * i + (lane >> 5); scr[kk * 33 + (lane & 31)] = W[(size_t)(k0 + kk) * N + nsrc] * scale; }
    LDS_WAIT(); asm volatile("" ::: "memory");
    const int n = lane >> 1, hf = lane & 1;
#pragma unroll
    for (int q = 0; q < 2; ++q) { const int ch = 2 * hf + q; const LAS float* sp = scr + (16 * ch) * 33 + n;
        v4u o; o.x = pk4_fp8(sp[0 * 33], sp[1 * 33], sp[2 * 33], sp[3 * 33]); o.y = pk4_fp8(sp[4 * 33], sp[5 * 33], sp[6 * 33], sp[7 * 33]);
        o.z = pk4_fp8(sp[8 * 33], sp[9 * 33], sp[10 * 33], sp[11 * 33]); o.w = pk4_fp8(sp[12 * 33], sp[13 * 33], sp[14 * 33], sp[15 * 33]);
        *(v4u*)(WT + (size_t)(n0 + n) * K + k0 + 16 * ch) = o; }
    LDS_WAIT(); asm volatile("" ::: "memory");
}
__device__ __forceinline__ void cvt_row_1024(const float* src, bf16* dst, int lane) {
    f32x4 v[4];
#pragma unroll
    for (int j = 0; j < 4; ++j) v[j] = ((const f32x4*)src)[lane + 64 * j];
#pragma unroll
    for (int j = 0; j < 4; ++j) ((u64*)dst)[lane + 64 * j] = (u64)pk2(v[j].x, v[j].y) | ((u64)pk2(v[j].z, v[j].w) << 32);
}
constexpr float PU_SCALE = 256.f, PV_SCALE = 32.f;
__device__ __forceinline__ void cvt_row_1024_fp8(const float* src, unsigned char* dst_base, int row, float scale, int lane) {
    f32x4 v[4];
#pragma unroll
    for (int j = 0; j < 4; ++j) v[j] = ((const f32x4*)src)[4 * lane + j] * scale;
    v4u o; o.x = pk4_fp8(v[0].x, v[0].y, v[0].z, v[0].w); o.y = pk4_fp8(v[1].x, v[1].y, v[1].z, v[1].w); o.z = pk4_fp8(v[2].x, v[2].y, v[2].z, v[2].w); o.w = pk4_fp8(v[3].x, v[3].y, v[3].z, v[3].w);
    *(v4u*)(dst_base + (size_t)(lane >> 3) * (16384 * 128) + (size_t)row * 128 + 16 * (lane & 7)) = o;
}
__device__ __forceinline__ float wave_max(float v) { v = fmaxf(v, dpp<XOR1>(v)); v = fmaxf(v, dpp<XOR2>(v)); v = fmaxf(v, dpp<XOR7>(v)); v = fmaxf(v, dpp<XOR8>(v)); return xrow16_max(v); }
__device__ __forceinline__ unsigned pk4_i8(float a, float b, float c, float d) {
    const int q0 = __float2int_rn(a), q1 = __float2int_rn(b), q2 = __float2int_rn(c), q3 = __float2int_rn(d);
    return (unsigned)(q0 & 0xff) | ((unsigned)(q1 & 0xff) << 8) | ((unsigned)(q2 & 0xff) << 16) | ((unsigned)(q3 & 0xff) << 24);
}
__device__ __forceinline__ void cvt_row_regs_i8(f32x4 (&v)[4], unsigned char* dst_base, int row, float* scale_out, int lane) {
    float mx = 0.f;
#pragma unroll
    for (int j = 0; j < 4; ++j) mx = fmaxf(mx, fmaxf(fmaxf(fabsf(v[j].x), fabsf(v[j].y)), fmaxf(fabsf(v[j].z), fabsf(v[j].w))));
    mx = fmaxf(wave_max(mx), 1e-30f);
    const float inv = 127.0f / mx;
    v4u o; o.x = pk4_i8(v[0].x * inv, v[0].y * inv, v[0].z * inv, v[0].w * inv); o.y = pk4_i8(v[1].x * inv, v[1].y * inv, v[1].z * inv, v[1].w * inv);
    o.z = pk4_i8(v[2].x * inv, v[2].y * inv, v[2].z * inv, v[2].w * inv); o.w = pk4_i8(v[3].x * inv, v[3].y * inv, v[3].z * inv, v[3].w * inv);
    *(v4u*)(dst_base + (size_t)(lane >> 3) * (16384 * 128) + (size_t)row * 128 + 16 * (lane & 7)) = o;
    if (lane == 0) *scale_out = mx * (1.0f / 127.0f);
}
__device__ __forceinline__ void ln_row_1024(const float* src, const float* g, const float* bta, float* of32, bf16* obf, int lane, unsigned char* oi8 = nullptr, float* oscale = nullptr) {
    f32x4 v[4]; float s = 0.f;
#pragma unroll
    for (int j = 0; j < 4; ++j) { v[j] = ((const f32x4*)src)[lane + 64 * j]; s += (v[j].x + v[j].y) + (v[j].z + v[j].w); }
    const float mean = wave_sum(s) * (1.f / 1024.f); float s2 = 0.f;
#pragma unroll
    for (int j = 0; j < 4; ++j) { v[j] = v[j] - mean; s2 += (v[j].x * v[j].x + v[j].y * v[j].y) + (v[j].z * v[j].z + v[j].w * v[j].w); }
    const float rstd = 1.f / sqrtf(wave_sum(s2) * (1.f / 1024.f) + LN_EPS);
    float mx = 0.f;
#pragma unroll
    for (int j = 0; j < 4; ++j) {
        const f32x4 gg = ((const f32x4*)g)[lane + 64 * j], bb = ((const f32x4*)bta)[lane + 64 * j];
        const f32x4 o = v[j] * rstd * gg + bb;
        v[j] = o;
        mx = fmaxf(mx, fmaxf(fmaxf(fabsf(o.x), fabsf(o.y)), fmaxf(fabsf(o.z), fabsf(o.w))));
        if (of32) ((f32x4*)of32)[lane + 64 * j] = o;
        if (obf) ((u64*)obf)[lane + 64 * j] = (u64)pk2(o.x, o.y) | ((u64)pk2(o.z, o.w) << 32);
    }
    if (oi8) {
        mx = fmaxf(wave_max(mx), 1e-30f);
        const float inv = 127.0f / mx;
#pragma unroll
        for (int j = 0; j < 4; ++j) ((unsigned*)oi8)[lane + 64 * j] = pk4_i8(v[j].x * inv, v[j].y * inv, v[j].z * inv, v[j].w * inv);
        if (lane == 0) *oscale = mx * (1.0f / 127.0f);
    }
}

__device__ __forceinline__ void cvt_row_regs_i4(f32x4 (&v)[4], unsigned char* dst_base, int row, float* scale_out, int lane) {
    float mx = 0.f;
#pragma unroll
    for (int j = 0; j < 4; ++j) mx = fmaxf(mx, fmaxf(fmaxf(fabsf(v[j].x), fabsf(v[j].y)), fmaxf(fabsf(v[j].z), fabsf(v[j].w))));
    mx = fmaxf(wave_max(mx), 1e-30f);
    float best_err = 3.0e38f, best_f = 1.0f;
#pragma unroll
    for (int k = 0; k < 5; ++k) {
        const float f = 1.0f - 0.1f * (float)k, step = mx * f * (1.0f / 7.0f), inv = 1.0f / step;
        float err = 0.f;
#pragma unroll
        for (int j = 0; j < 4; ++j)
#pragma unroll
            for (int i = 0; i < 4; ++i) { const float x = v[j][i], q = fminf(fmaxf(rintf(x * inv), -7.0f), 7.0f), d = x - q * step; err += d * d; }
        err = wave_sum(err);
        if (err < best_err) { best_err = err; best_f = f; }
    }
    const float step = mx * best_f * (1.0f / 7.0f), inv = 1.0f / step;
    unsigned w0 = 0u, w1 = 0u;
#pragma unroll
    for (int j = 0; j < 4; ++j) {
        unsigned n[4];
#pragma unroll
        for (int i = 0; i < 4; ++i) n[i] = (unsigned)(int)fminf(fmaxf(rintf(v[j][i] * inv), -7.0f), 7.0f) & 0xfu;
        const unsigned h = n[0] | (n[1] << 4) | (n[2] << 8) | (n[3] << 12);
        if (j < 2) w0 |= h << (16 * j); else w1 |= h << (16 * (j - 2));
    }
    *(u64*)(dst_base + (size_t)(lane >> 4) * (16384 * 128) + (size_t)row * 128 + 8 * (lane & 15)) = (u64)w0 | ((u64)w1 << 32);
#ifdef PEER_U_DOT8
    if (lane == 0) *scale_out = step;
#else
    if (lane == 0) *scale_out = step * (1.0f / 16.0f);
#endif
}
__device__ __forceinline__ void ln1_finish(f32x4 (&v)[4], const float* g, const float* bta, bf16* obf, unsigned char* oi8, float* oscale, int lane) {
    float s = 0.f;
#pragma unroll
    for (int j = 0; j < 4; ++j) s += (v[j].x + v[j].y) + (v[j].z + v[j].w);
    const float mean = wave_sum(s) * (1.f / 1024.f); float s2 = 0.f;
#pragma unroll
    for (int j = 0; j < 4; ++j) { v[j] = v[j] - mean; s2 += (v[j].x * v[j].x + v[j].y * v[j].y) + (v[j].z * v[j].z + v[j].w * v[j].w); }
    const float rstd = 1.f / sqrtf(wave_sum(s2) * (1.f / 1024.f) + LN_EPS);
    float mx = 0.f;
#pragma unroll
    for (int j = 0; j < 4; ++j) {
        const f32x4 gg = ((const f32x4*)g)[lane + 64 * j], bb = ((const f32x4*)bta)[lane + 64 * j];
        const f32x4 o = v[j] * rstd * gg + bb;
        v[j] = o;
        mx = fmaxf(mx, fmaxf(fmaxf(fabsf(o.x), fabsf(o.y)), fmaxf(fabsf(o.z), fabsf(o.w))));
        ((u64*)obf)[lane + 64 * j] = (u64)pk2(o.x, o.y) | ((u64)pk2(o.z, o.w) << 32);
    }
    mx = fmaxf(wave_max(mx), 1e-30f);
#ifdef PEER_U_DOT8
    const float inv = 119.0f / mx;
    const int odd = lane & 1;
#pragma unroll
    for (int j = 0; j < 4; ++j) {
        unsigned hi16 = 0u, lo16 = 0u;
#pragma unroll
        for (int i = 0; i < 4; ++i) { const int t = __float2int_rn(v[j][i] * inv) + 8; hi16 |= ((unsigned)(t >> 4) & 15u) << (4 * i); lo16 |= ((unsigned)(t ^ 8) & 15u) << (4 * i); }
        const unsigned recv = (unsigned)__builtin_amdgcn_mov_dpp((int)(odd ? hi16 : lo16), XOR1, 0xf, 0xf, true);
        const unsigned dw = odd ? (recv | (lo16 << 16)) : (hi16 | (recv << 16));
        *(unsigned*)(oi8 + 256 * j + 32 * (lane >> 3) + 16 * odd + 4 * ((lane >> 1) & 3)) = dw;
    }
    if (lane == 0) *oscale = mx * (1.0f / 119.0f);
#else
    const float inv = 127.0f / mx;
#pragma unroll
    for (int j = 0; j < 4; ++j) ((unsigned*)oi8)[lane + 64 * j] = pk4_i8(v[j].x * inv, v[j].y * inv, v[j].z * inv, v[j].w * inv);
    if (lane == 0) *oscale = mx * (1.0f / 127.0f);
#endif
}

__device__ __forceinline__ void p0_prologue(Frame& F) {
    LAS float* scr = (LAS float*)(F.lds + F.wave * 16384);
    const int gw = blockIdx.x * NWAVES + F.wave, NGW = F.G * NWAVES;
    unsigned char* ws = F.ws;
    constexpr int I_IN = 16 * (INW / 32), I_BR = 8 * 32, I_OUT = 16 * 32, I_PQ = 16 * 64, I_MKV = 16 * 32;
    constexpr int NITEMS = I_IN + 3 * I_BR + I_OUT + I_PQ + I_MKV;
    for (int it = gw; it < NITEMS; it += NGW) {
        int r = it;
        if (r < I_IN) { p0_transpose_item<true>(karg_in(2), 1024, INW, (bf16*)(ws + WS_WIN), scr, r, F.lane);
#ifdef GEMM_F8
            p0_transpose_item_f8<true>(karg_in(2), 1024, INW, ws + WS_WIN8, W8_SCALE, scr, r, F.lane);
#endif
            continue; } r -= I_IN;
#ifdef GEMM56_F8
        if (r < I_BR) { p0_transpose_item_f8<false>(karg_in(9), 512, 1024, ws + WS_WBA, W8_SCALE, scr, r, F.lane); continue; } r -= I_BR;
#else
        if (r < I_BR) { p0_transpose_item<false>(karg_in(9), 512, 1024, (bf16*)(ws + WS_WBA), scr, r, F.lane); continue; } r -= I_BR;
#endif
#ifdef GEMM56_F8
        if (r < I_BR) { p0_transpose_item_f8<false>(karg_in(10), 512, 1024, ws + WS_WBR, W8_SCALE, scr, r, F.lane); continue; } r -= I_BR;
#else
        if (r < I_BR) { p0_transpose_item<false>(karg_in(10), 512, 1024, (bf16*)(ws + WS_WBR), scr, r, F.lane); continue; } r -= I_BR;
#endif
#ifdef GEMM56_F8
        if (r < I_BR) { p0_transpose_item_f8<false>(karg_in(11), 512, 1024, ws + WS_WBM, W8_SCALE, scr, r, F.lane); continue; } r -= I_BR;
#else
        if (r < I_BR) { p0_transpose_item<false>(karg_in(11), 512, 1024, (bf16*)(ws + WS_WBM), scr, r, F.lane); continue; } r -= I_BR;
#endif
#if defined(GEMM56_F8) && !defined(P6_BF16)
        if (r < I_OUT) { p0_transpose_item_f8<false>(karg_in(12), 1024, 1024, ws + WS_WOUT, W8_SCALE, scr, r, F.lane); continue; } r -= I_OUT;
#else
        if (r < I_OUT) { p0_transpose_item<false>(karg_in(12), 1024, 1024, (bf16*)(ws + WS_WOUT), scr, r, F.lane); continue; } r -= I_OUT;
#endif
        if (r < I_PQ) { p0_transpose_item<false>(karg_in(15), 1024, 2048, (bf16*)(ws + WS_WPQ), scr, r, F.lane); continue; } r -= I_PQ;
        p0_transpose_item<false>(karg_in(8), 1024, 1024, (bf16*)(ws + WS_WMKV), scr, r, F.lane);
    }
    bf16* XB = (bf16*)F.out;
    for (int m = gw; m < T; m += 4 * NGW) {
        f32x4 v[4][4];
#pragma unroll
        for (int q = 0; q < 4; ++q)
#pragma unroll
            for (int j = 0; j < 4; ++j) v[q][j] = ((const f32x4*)(karg_in(0) + (size_t)(m + q * NGW) * 1024))[F.lane + 64 * j];
#ifdef GEMM_F8
#pragma unroll
        for (int q = 0; q < 4; ++q)
#pragma unroll
            for (int j = 0; j < 4; ++j) ((unsigned*)((unsigned char*)F.out + (size_t)T * 2048 + (size_t)(m + q * NGW) * 1024))[F.lane + 64 * j] = pk4_fp8(v[q][j].x, v[q][j].y, v[q][j].z, v[q][j].w);
#endif
#pragma unroll
        for (int q = 0; q < 4; ++q)
#pragma unroll
            for (int j = 0; j < 4; ++j) ((u64*)(XB + (size_t)(m + q * NGW) * 1024))[F.lane + 64 * j] = (u64)pk2(v[q][j].x, v[q][j].y) | ((u64)pk2(v[q][j].z, v[q][j].w) << 32);
    }
    for (int m = gw; m < 16384; m += NGW) {
        f32x4 a[4], b[4];
#pragma unroll
        for (int j = 0; j < 4; ++j) { a[j] = ((const f32x4*)(karg_in(17) + (size_t)m * 1024))[4 * F.lane + j]; b[j] = ((const f32x4*)(karg_in(18) + (size_t)m * 1024))[4 * F.lane + j]; }
#ifdef PEER_U_INT4
        cvt_row_regs_i4(a, ws + WS_PU, m, (float*)(ws + WS_US) + m, F.lane);
#else
        cvt_row_regs_i8(a, ws + WS_PU, m, (float*)(ws + WS_US) + m, F.lane);
#endif
        cvt_row_regs_i8(b, ws + WS_PV, m, (float*)(ws + WS_VS) + m, F.lane);
    }
    for (int m = gw; m < 256; m += NGW) cvt_row_1024(karg_in(16) + (size_t)m * 1024, (bf16*)(ws + WS_SUBK) + (size_t)m * 1024, F.lane);
    for (int m = gw; m < 2048; m += NGW) ln_row_1024(karg_in(1) + (size_t)m * 1024, karg_in(6), karg_in(7), nullptr, (bf16*)(ws + WS_MEMN) + (size_t)m * 1024, F.lane);
    float* biasp = (float*)(ws + WS_BIASP);
    for (int c = blockIdx.x * NTHR + F.tid; c < INW; c += F.G * NTHR) biasp[c] = karg_in(3)[win_src_col(c)];
}

__device__ __forceinline__ float ret_log2gamma(int h) { return log2f(1.0f - exp2f(-5.0f - (float)h)); }
__device__ __forceinline__ void kvinc_load(Frame& F, int u, v4u (&rv)[4], v4u (&rk)[2]) {
    const int b = u >> 8, n = (u >> 2) & 63, h = u & 3;
    const bf16* RK = (const bf16*)(F.ws + WS_RK); const bf16* RV = (const bf16*)(F.ws + WS_RV);
    const size_t tok0 = (size_t)b * SEQ + (size_t)n * 128;
#pragma unroll
    for (int k = 0; k < 4; ++k) { const int idx = F.tid + NTHR * k, r = idx & 127, c = idx >> 7; rv[k] = *(const v4u*)(RV + (tok0 + r) * 512 + h * 128 + 8 * c); }
#pragma unroll
    for (int k = 0; k < 2; ++k) { const int idx = F.tid + NTHR * k, r = idx & 127, c = idx >> 7; rk[k] = *(const v4u*)(RK + (tok0 + r) * 256 + h * 64 + 8 * c); }
}
__device__ __forceinline__ void kvinc_stage(Frame& F, int u, const v4u (&rv)[4], const v4u (&rk)[2]) {
    LAS bf16* Vt = (LAS bf16*)(F.lds);
    LAS bf16* Kt = (LAS bf16*)(F.lds + 34816);
    const float lg = ret_log2gamma(u & 3);
#pragma unroll
    for (int k = 0; k < 4; ++k) { const int idx = F.tid + NTHR * k, r = idx & 127, c = idx >> 7; const v4u v = rv[k]; LAS bf16* d = Vt + (8 * c) * 136 + r;
        d[0 * 136] = (bf16)(v.x & 0xffffu); d[1 * 136] = (bf16)(v.x >> 16); d[2 * 136] = (bf16)(v.y & 0xffffu); d[3 * 136] = (bf16)(v.y >> 16); d[4 * 136] = (bf16)(v.z & 0xffffu); d[5 * 136] = (bf16)(v.z >> 16); d[6 * 136] = (bf16)(v.w & 0xffffu); d[7 * 136] = (bf16)(v.w >> 16); }
#pragma unroll
    for (int k = 0; k < 2; ++k) { const int idx = F.tid + NTHR * k, r = idx & 127, c = idx >> 7; const v4u v = rk[k]; const float wk = exp2f(lg * (float)(127 - r)); LAS bf16* d = Kt + (8 * c) * 136 + r;
        d[0 * 136] = (bf16)f2bf(bflo(v.x) * wk); d[1 * 136] = (bf16)f2bf(bfhi(v.x) * wk); d[2 * 136] = (bf16)f2bf(bflo(v.y) * wk); d[3 * 136] = (bf16)f2bf(bfhi(v.y) * wk);
        d[4 * 136] = (bf16)f2bf(bflo(v.z) * wk); d[5 * 136] = (bf16)f2bf(bfhi(v.z) * wk); d[6 * 136] = (bf16)f2bf(bflo(v.w) * wk); d[7 * 136] = (bf16)f2bf(bfhi(v.w) * wk); }
}
__device__ __forceinline__ void kvinc_compute(Frame& F, int u) {
    const int b = u >> 8, n = (u >> 2) & 63, h = u & 3;
    LAS bf16* Vt = (LAS bf16*)(F.lds); LAS bf16* Kt = (LAS bf16*)(F.lds + 34816);
    const int w = F.wave, fr = F.fr, fq = F.fq;
    f32x4 acc[4];
#pragma unroll
    for (int dt = 0; dt < 4; ++dt) acc[dt] = (f32x4){0.f, 0.f, 0.f, 0.f};
#pragma unroll
    for (int ks = 0; ks < 4; ++ks) {
        const bf16x8 a = *(const LAS bf16x8*)(Vt + (16 * w + fr) * 136 + 32 * ks + 8 * fq);
#pragma unroll
        for (int dt = 0; dt < 4; ++dt) acc[dt] = mma16(a, *(const LAS bf16x8*)(Kt + (16 * dt + fr) * 136 + 32 * ks + 8 * fq), acc[dt]);
    }
    float* KV = (float*)(F.ws + WS_KV) + ((size_t)((b * NCHUNK + n) * 4 + h)) * 8192 + (16 * w + fr) * 64 + 4 * fq;
#pragma unroll
    for (int dt = 0; dt < 4; ++dt) *(f32x4*)(KV + 16 * dt) = acc[dt];
}
__device__ __forceinline__ void kvinc_phase(Frame& F) {
    constexpr int NU = NBATCH * NCHUNK * 4;
    v4u rv[4], rk[2];
    int u = blockIdx.x;
    if (u < NU) kvinc_load(F, u, rv, rk);
    for (; u < NU; u += F.G) {
        kvinc_stage(F, u, rv, rk);
        __syncthreads();
        if (u + F.G < NU) kvinc_load(F, u + F.G, rv, rk);
        kvinc_compute(F, u);
        __syncthreads();
    }
}

__device__ __forceinline__ void scan_phase(Frame& F) {
    const float* KV = (const float*)(F.ws + WS_KV); bf16* ST = (bf16*)(F.ws + WS_ST);
    for (int q = blockIdx.x * NTHR + F.tid; q < NBATCH * 32768; q += F.G * NTHR) {
        const int b = q >> 15, r = q & 32767, h = r >> 13;
        const float decay = exp2f(ret_log2gamma(h) * 128.0f);
        float st = 0.f;
        size_t off = (size_t)b * NCHUNK * 32768 + r;
        for (int n = 0; n < NCHUNK; ++n) { ST[off] = (bf16)f2bf(st); st = decay * st + KV[off]; off += 32768; }
    }
}

__device__ __forceinline__ bf16x8 pack_p(f32x4 a, f32x4 b) { const v4u w = (v4u){pk2(a[0], a[1]), pk2(a[2], a[3]), pk2(b[0], b[1]), pk2(b[2], b[3])}; return __builtin_bit_cast(bf16x8, w); }
__device__ __forceinline__ bf16x8 frag_kperm(const LAS bf16* p, int fq) {
    const u64 lo = *(const LAS u64*)(p + 4 * fq), hi = *(const LAS u64*)(p + 16 + 4 * fq);
    const v4u w = (v4u){(unsigned)lo, (unsigned)(lo >> 32), (unsigned)hi, (unsigned)(hi >> 32)};
    return __builtin_bit_cast(bf16x8, w);
}

typedef short s16x4 __attribute__((ext_vector_type(4)));
__device__ __forceinline__ bf16x8 frag_kperm_tr(const LAS bf16* v, int pl, int off_lo, int off_hi) {
    const s16x4 lo = __builtin_amdgcn_ds_read_tr16_b64_v4i16((LAS s16x4*)(v + pl + off_lo)), hi = __builtin_amdgcn_ds_read_tr16_b64_v4i16((LAS s16x4*)(v + pl + off_hi));
    return (bf16x8){lo[0], lo[1], lo[2], lo[3], hi[0], hi[1], hi[2], hi[3]};
}
__device__ __forceinline__ bf16x8 frag_kperm_tr_lo(const LAS bf16* v, int pl) {
    const s16x4 lo = __builtin_amdgcn_ds_read_tr16_b64_v4i16((LAS s16x4*)(v + pl));
    return (bf16x8){lo[0], lo[1], lo[2], lo[3], 0, 0, 0, 0};
}
__device__ __forceinline__ bf16x8 frag_kperm_lo(const LAS bf16* p, int fq) {
    const u64 lo = *(const LAS u64*)(p + 4 * fq);
    const v4u w = (v4u){(unsigned)lo, (unsigned)(lo >> 32), 0u, 0u};
    return __builtin_bit_cast(bf16x8, w);
}
__device__ __forceinline__ void swa_load(Frame& F, int u, v4u (&rk)[4], v4u (&rv)[4]) {
    const int b = u >> 7, n = (u >> 1) & 63, g = u & 1;
    const bf16* AK = (const bf16*)(F.ws + WS_AK); const bf16* AV = (const bf16*)(F.ws + WS_AV);
    const size_t tok0 = (size_t)b * SEQ + (size_t)n * 128;
#pragma unroll
    for (int k = 0; k < 4; ++k) { const int idx = F.tid + NTHR * k, r = idx >> 3, c = idx & 7; rk[k] = (v4u){0u, 0u, 0u, 0u};
        if (n > 0 || r >= 128) rk[k] = *(const v4u*)(AK + (tok0 - 128 + r) * 128 + g * 64 + 8 * c); }
#pragma unroll
    for (int k = 0; k < 4; ++k) { const int idx = F.tid + NTHR * k, r = idx >> 3, c = idx & 7; rv[k] = (v4u){0u, 0u, 0u, 0u};
        if (n > 0 || r >= 128) rv[k] = *(const v4u*)(AV + (tok0 - 128 + r) * 128 + g * 64 + 8 * c); }
}
__device__ __forceinline__ void swa_stage(Frame& F, const v4u (&rk)[4], const v4u (&rv)[4]) {
    LAS bf16* Ks = (LAS bf16*)(F.lds);
    LAS bf16* Vs = (LAS bf16*)(F.lds + 36864);
#pragma unroll
    for (int k = 0; k < 4; ++k) { const int idx = F.tid + NTHR * k, r = idx >> 3, c = idx & 7; *(LAS v4u*)(Ks + r * 72 + 8 * c) = rk[k]; *(LAS v4u*)(Vs + r * 80 + 8 * c) = rv[k]; }
}
__device__ __forceinline__ void swa_compute(Frame& F, int u) {
    const int b = u >> 7, n = (u >> 1) & 63, g = u & 1;
    LAS bf16* Ks = (LAS bf16*)(F.lds); LAS bf16* Vs = (LAS bf16*)(F.lds + 36864);
    const bf16* AQ = (const bf16*)(F.ws + WS_AQ);
    const size_t tok0 = (size_t)b * SEQ + (size_t)n * 128;
    const int w = F.wave, fr = F.fr, fq = F.fq;
    const int hq = 4 * g + (w >> 1);
    const float sink = karg_in(4)[hq];
    const int vpl = (4 * fq + (fr >> 2)) * 80 + 4 * (fr & 3);
    bf16x8 qfa[4][2];
#pragma unroll
    for (int rg = 0; rg < 4; ++rg)
#pragma unroll
        for (int ks = 0; ks < 2; ++ks) qfa[rg][ks] = *(const bf16x8*)(AQ + (tok0 + (w & 1) * 64 + 16 * rg + fr) * 512 + hq * 64 + 32 * ks + 8 * fq);
#pragma unroll
    for (int rg = 0; rg < 4; ++rg) {
        const int qi0 = (w & 1) * 64 + 16 * rg, qi = qi0 + fr;
#ifdef GEMM56_F8
        unsigned char* orow8 = (unsigned char*)F.out + (tok0 + qi) * 512 + hq * 64;
#else
        bf16* orow = (bf16*)F.out + (tok0 + qi) * 512 + hq * 64;
#endif
        const bf16x8 (&qf)[2] = qfa[rg];
        const int t0 = qi0 >> 4;
        f32x4 s[10];
#pragma unroll
        for (int tt = 0; tt < 9; ++tt) {
            s[tt] = (f32x4){0.f, 0.f, 0.f, 0.f};
#pragma unroll
            for (int ks = 0; ks < 2; ++ks) s[tt] = mma16(qf[ks], *(const LAS bf16x8*)(Ks + (16 * (t0 + tt) + fr) * 72 + 32 * ks + 8 * fq), s[tt]);
        }
        s[9] = (f32x4){0.f, 0.f, 0.f, 0.f};
        float mx = -INFINITY;
#pragma unroll
        for (int tt = 0; tt < 9; ++tt)
#pragma unroll
            for (int i = 0; i < 4; ++i) {
                const int c = 4 * fq + i;
                bool valid = true;
                if (tt == 0) valid = c > fr;
                if (tt == 8) valid = c <= fr;
                if (n == 0) valid = valid && (t0 + tt >= 8);
                const float l = valid ? s[tt][i] * 0.125f : -INFINITY;
                s[tt][i] = l; mx = fmaxf(mx, l);
            }
        mx = quad_max(mx);
        const float m = fmaxf(mx, sink);
        float sum = 0.f;
#pragma unroll
        for (int tt = 0; tt < 9; ++tt)
#pragma unroll
            for (int i = 0; i < 4; ++i) { s[tt][i] = __expf(s[tt][i] - m); sum += s[tt][i]; }
        sum = quad_sum(sum);
        const float inv = 1.0f / (sum + __expf(sink - m));
        f32x4 o[4];
#pragma unroll
        for (int dt = 0; dt < 4; ++dt) o[dt] = (f32x4){0.f, 0.f, 0.f, 0.f};
#pragma unroll
        for (int kk = 0; kk < 5; ++kk) {
            const bf16x8 pa = pack_p(s[2 * kk], s[2 * kk + 1]);
#pragma unroll
            for (int dt = 0; dt < 4; ++dt) {
                const LAS bf16* vp = Vs + (16 * t0 + 32 * kk) * 80 + 16 * dt;
                o[dt] = mma16(pa, kk < 4 ? frag_kperm_tr(vp, vpl, 0, 16 * 80) : frag_kperm_tr_lo(vp, vpl), o[dt]);
            }
            asm volatile("" ::: "memory");
        }
#pragma unroll
        for (int dt = 0; dt < 4; ++dt)
#ifdef GEMM56_F8
            { const float i8 = inv * BR8_SCALE; *(unsigned*)(orow8 + 16 * dt + 4 * fq) = pk4_fp8(o[dt][0] * i8, o[dt][1] * i8, o[dt][2] * i8, o[dt][3] * i8); }
#else
            *(u64*)(orow + 16 * dt + 4 * fq) = (u64)pk2(o[dt][0] * inv, o[dt][1] * inv) | ((u64)pk2(o[dt][2] * inv, o[dt][3] * inv) << 32);
#endif
    }
}
__device__ __forceinline__ void swa_phase(Frame& F) {
    constexpr int NU = NBATCH * NCHUNK * 2;
    v4u rk[4], rv[4];
    int u = blockIdx.x;
    if (u < NU) swa_load(F, u, rk, rv);
    for (; u < NU; u += F.G) {
        swa_stage(F, rk, rv);
        __syncthreads();
        if (u + F.G < NU) swa_load(F, u + F.G, rk, rv);
        swa_compute(F, u);
        __syncthreads();
    }
}

__device__ __forceinline__ void ret_load(Frame& F, int u, v4u (&rk)[2], v4u (&rs)[2], v4u (&rv)[4], bf16x8 (&qf)[2], u64 (&rgv)[8]) {
    const int b = u >> 8, n = (u >> 2) & 63, h = u & 3;
    const bf16* RK = (const bf16*)(F.ws + WS_RK); const bf16* RV = (const bf16*)(F.ws + WS_RV);
    {
        const bf16* RQ = (const bf16*)(F.ws + WS_RQ); const bf16* RG = (const bf16*)(F.ws + WS_RG);
        const size_t tok = (size_t)b * SEQ + (size_t)n * 128 + 16 * F.wave + F.fr;
#pragma unroll
        for (int ks = 0; ks < 2; ++ks) qf[ks] = *(const bf16x8*)(RQ + tok * 256 + h * 64 + 32 * ks + 8 * F.fq);
#pragma unroll
        for (int et = 0; et < 8; ++et) rgv[et] = *(const u64*)(RG + tok * 512 + h * 128 + 16 * et + 4 * F.fq);
    }
    const bf16* ST = (const bf16*)(F.ws + WS_ST) + ((size_t)((b * NCHUNK + n) * 4 + h)) * 8192;
    const size_t tok0 = (size_t)b * SEQ + (size_t)n * 128;
#pragma unroll
    for (int k = 0; k < 2; ++k) { const int idx = F.tid + NTHR * k, r = idx >> 3, c = idx & 7; rk[k] = *(const v4u*)(RK + (tok0 + r) * 256 + h * 64 + 8 * c); rs[k] = *(const v4u*)(ST + r * 64 + 8 * c); }
#pragma unroll
    for (int k = 0; k < 4; ++k) { const int idx = F.tid + NTHR * k, r = idx >> 4, c = idx & 15; rv[k] = *(const v4u*)(RV + (tok0 + r) * 512 + h * 128 + 8 * c); }
}
__device__ __forceinline__ void ret_stage(Frame& F, const v4u (&rk)[2], const v4u (&rs)[2], const v4u (&rv)[4]) {
    LAS bf16* Ks = (LAS bf16*)(F.lds);
    LAS bf16* Vs = (LAS bf16*)(F.lds + 18432);
    LAS bf16* St = (LAS bf16*)(F.lds + 18432 + 36864);
#pragma unroll
    for (int k = 0; k < 2; ++k) { const int idx = F.tid + NTHR * k, r = idx >> 3, c = idx & 7; *(LAS v4u*)(Ks + r * 72 + 8 * c) = rk[k]; *(LAS v4u*)(St + r * 72 + 8 * c) = rs[k]; }
#pragma unroll
    for (int k = 0; k < 4; ++k) { const int idx = F.tid + NTHR * k, r = idx >> 4, c = idx & 15; *(LAS v4u*)(Vs + r * 144 + 8 * c) = rv[k]; }
#if 0
    for (int k = 0; k < 4; ++k) { const int idx = F.tid + NTHR * k, r = idx & 127, c = idx >> 7; const v4u v = rv[k]; LAS bf16* d = Vt + (8 * c) * 136 + r;
        d[0 * 136] = (bf16)(v.x & 0xffffu); d[1 * 136] = (bf16)(v.x >> 16); d[2 * 136] = (bf16)(v.y & 0xffffu); d[3 * 136] = (bf16)(v.y >> 16); d[4 * 136] = (bf16)(v.z & 0xffffu); d[5 * 136] = (bf16)(v.z >> 16); d[6 * 136] = (bf16)(v.w & 0xffffu); d[7 * 136] = (bf16)(v.w >> 16); }
#endif
}
__device__ __forceinline__ void ret_compute(Frame& F, int u, const bf16x8 (&qf)[2], const u64 (&rgv)[8]) {
    const int b = u >> 8, n = (u >> 2) & 63, h = u & 3;
    LAS bf16* Ks = (LAS bf16*)(F.lds); LAS bf16* Vs = (LAS bf16*)(F.lds + 18432); LAS bf16* St = (LAS bf16*)(F.lds + 18432 + 36864);
    const bf16* RQ = (const bf16*)(F.ws + WS_RQ); const bf16* RG = (const bf16*)(F.ws + WS_RG);
    const size_t tok0 = (size_t)b * SEQ + (size_t)n * 128;
    const int w = F.wave, fr = F.fr, fq = F.fq;
    const float lg = ret_log2gamma(h);
    const int i = 16 * w + fr;
    const size_t tok = tok0 + i;
    f32x4 pt[8];
#pragma unroll
    for (int t = 0; t < 8; ++t) {
        f32x4 s = (f32x4){0.f, 0.f, 0.f, 0.f};
        if (t <= w) {
#pragma unroll
            for (int ks = 0; ks < 2; ++ks) s = mma16(qf[ks], *(const LAS bf16x8*)(Ks + (16 * t + fr) * 72 + 32 * ks + 8 * fq), s);
        }
#pragma unroll
        for (int ii = 0; ii < 4; ++ii) { const int j = 16 * t + 4 * fq + ii; pt[t][ii] = (i >= j) ? s[ii] * exp2f(lg * (float)(i - j)) : 0.f; }
    }
    f32x4 o1[8], o2[8];
    const int vpl = (4 * fq + (fr >> 2)) * 144 + 4 * (fr & 3);
#pragma unroll
    for (int et = 0; et < 8; ++et) { o1[et] = (f32x4){0.f, 0.f, 0.f, 0.f}; o2[et] = (f32x4){0.f, 0.f, 0.f, 0.f}; }
#pragma unroll
    for (int ks = 0; ks < 4; ++ks) {
        if (2 * ks <= w) {
            const bf16x8 pa = pack_p(pt[2 * ks], pt[2 * ks + 1]);
#pragma unroll
            for (int et = 0; et < 8; ++et) o1[et] = mma16(pa, frag_kperm_tr(Vs, vpl, 32 * ks * 144 + 16 * et, (32 * ks + 16) * 144 + 16 * et), o1[et]);
            asm volatile("" ::: "memory");
        }
    }
#pragma unroll
    for (int ks = 0; ks < 2; ++ks)
#pragma unroll
        for (int et = 0; et < 8; ++et) o2[et] = mma16(qf[ks], *(const LAS bf16x8*)(St + (16 * et + fr) * 72 + 32 * ks + 8 * fq), o2[et]);
    const float wq = exp2f(lg * (float)(i + 1));
    float sum = 0.f;
#pragma unroll
    for (int et = 0; et < 8; ++et) { o1[et] = o1[et] + o2[et] * wq; sum += (o1[et][0] + o1[et][1]) + (o1[et][2] + o1[et][3]); }
    const float mean = quad_sum(sum) * (1.f / 128.f);
    float s2 = 0.f;
#pragma unroll
    for (int et = 0; et < 8; ++et) { o1[et] = o1[et] - mean; s2 += (o1[et][0] * o1[et][0] + o1[et][1] * o1[et][1]) + (o1[et][2] * o1[et][2] + o1[et][3] * o1[et][3]); }
    const float rstd = 1.f / sqrtf(quad_sum(s2) * (1.f / 128.f) + LN_EPS);
    const float* gng = karg_in(5) + h * 128;
#pragma unroll
    for (int et = 0; et < 8; ++et) {
        const int e = 16 * et + 4 * fq;
        const f32x4 gg = *(const f32x4*)(gng + e);
        const unsigned long long rgp = rgv[et];
        const unsigned r0 = (unsigned)rgp, r1 = (unsigned)(rgp >> 32);
        const float a0 = o1[et][0] * rstd * gg[0] * bflo(r0), a1 = o1[et][1] * rstd * gg[1] * bfhi(r0);
        const float a2 = o1[et][2] * rstd * gg[2] * bflo(r1), a3 = o1[et][3] * rstd * gg[3] * bfhi(r1);
#ifdef GEMM56_F8
        *(unsigned*)((unsigned char*)F.out + (size_t)T * 512 + tok * 512 + h * 128 + e) = pk4_fp8(a0 * BR8_SCALE, a1 * BR8_SCALE, a2 * BR8_SCALE, a3 * BR8_SCALE);
#else
        *(u64*)((bf16*)F.out + (size_t)T * 512 + tok * 512 + h * 128 + e) = (u64)pk2(a0, a1) | ((u64)pk2(a2, a3) << 32);
#endif
    }
}
__device__ __forceinline__ void ret_phase(Frame& F, int xflags = 0) {
    constexpr int NU = NBATCH * NCHUNK * 4;
    v4u rk[2], rs[2], rv[4]; bf16x8 qn[2]; u64 gn[8];
    int u = blockIdx.x;
    if (u < NU) ret_load(F, u, rk, rs, rv, qn, gn);
    for (; u < NU; u += F.G) {
#ifdef EXP_RET
        if (!(xflags & 8))
#endif
        ret_stage(F, rk, rs, rv);
        bf16x8 qc[2] = {qn[0], qn[1]}; u64 gc[8];
#pragma unroll
        for (int et = 0; et < 8; ++et) gc[et] = gn[et];
        __syncthreads();
        if (u + F.G < NU) ret_load(F, u + F.G, rk, rs, rv, qn, gn);
#ifdef EXP_RET
        if (!(xflags & 16))
#endif
        ret_compute(F, u, qc, gc);
        __syncthreads();
    }
}

__device__ __forceinline__ void xattn_unit(Frame& F, int b, int h, int sq) {
    LAS bf16* Ks = (LAS bf16*)(F.lds);
    LAS bf16* Vt = (LAS bf16*)(F.lds + 69632);
    const bf16* MQ = (const bf16*)(F.ws + WS_MQ); const bf16* MK = (const bf16*)(F.ws + WS_MK);
    const bf16* MVT = (const bf16*)(F.ws + WS_MVT) + (size_t)(b * 4 + h) * 128 * 256;
#pragma unroll 2
    for (int idx = F.tid; idx < 256 * 16; idx += NTHR) { const int r = idx >> 4, c = idx & 15; *(LAS v4u*)(Ks + r * 136 + 8 * c) = *(const v4u*)(MK + (size_t)(b * 256 + r) * 512 + h * 128 + 8 * c); }
#pragma unroll 2
    for (int idx = F.tid; idx < 128 * 32; idx += NTHR) { const int r = idx >> 5, c = idx & 31; *(LAS v4u*)(Vt + r * 264 + 8 * c) = *(const v4u*)(MVT + r * 256 + 8 * c); }
    __syncthreads();
    const int w = F.wave, fr = F.fr, fq = F.fq;
    const float scale = 0.08838834764831845f;
    for (int sub = 0; sub < 4; ++sub) {
        const size_t tok = (size_t)b * SEQ + (size_t)sq * 1024 + sub * 256 + 32 * w + fr;
        const bf16* qrow = MQ + tok * 512 + h * 128;
#ifdef GEMM56_F8
        unsigned char* orow8 = (unsigned char*)F.out + (size_t)T * 1024 + tok * 512 + h * 128;
#else
        bf16* orow = (bf16*)F.out + (size_t)T * 1024 + tok * 512 + h * 128;
#endif
        bf16x8 qa[4], qb[4];
#pragma unroll
        for (int ks = 0; ks < 4; ++ks) { qa[ks] = *(const bf16x8*)(qrow + 32 * ks + 8 * fq); qb[ks] = *(const bf16x8*)(qrow + 16 * 512 + 32 * ks + 8 * fq); }
        f32x4 sa[16], sb[16];
#pragma unroll
        for (int t = 0; t < 16; ++t) {
            sa[t] = (f32x4){0.f, 0.f, 0.f, 0.f}; sb[t] = (f32x4){0.f, 0.f, 0.f, 0.f};
#pragma unroll
            for (int ks = 0; ks < 4; ++ks) { const bf16x8 kf = *(const LAS bf16x8*)(Ks + (16 * t + fr) * 136 + 32 * ks + 8 * fq); sa[t] = mma16(qa[ks], kf, sa[t]); sb[t] = mma16(qb[ks], kf, sb[t]); }
            if (t & 1) asm volatile("" ::: "memory");
        }
        float mxa = -INFINITY, mxb = -INFINITY;
#pragma unroll
        for (int t = 0; t < 16; ++t)
#pragma unroll
            for (int i = 0; i < 4; ++i) { sa[t][i] *= scale; mxa = fmaxf(mxa, sa[t][i]); sb[t][i] *= scale; mxb = fmaxf(mxb, sb[t][i]); }
        mxa = quad_max(mxa); mxb = quad_max(mxb);
        float suma = 0.f, sumb = 0.f;
#pragma unroll
        for (int t = 0; t < 16; ++t)
#pragma unroll
            for (int i = 0; i < 4; ++i) { sa[t][i] = __expf(sa[t][i] - mxa); suma += sa[t][i]; sb[t][i] = __expf(sb[t][i] - mxb); sumb += sb[t][i]; }
        const float inva = 1.0f / quad_sum(suma), invb = 1.0f / quad_sum(sumb);
        bf16x8 pa[8], pb[8];
#pragma unroll
        for (int ks = 0; ks < 8; ++ks) { pa[ks] = pack_p(sa[2 * ks], sa[2 * ks + 1]); pb[ks] = pack_p(sb[2 * ks], sb[2 * ks + 1]); }
        asm volatile("" ::: "memory");
#pragma unroll
        for (int dh = 0; dh < 2; ++dh) {
            f32x4 oa[4], ob[4];
#pragma unroll
            for (int dt = 0; dt < 4; ++dt) { oa[dt] = (f32x4){0.f, 0.f, 0.f, 0.f}; ob[dt] = (f32x4){0.f, 0.f, 0.f, 0.f}; }
#pragma unroll
            for (int ks = 0; ks < 8; ++ks) {
#pragma unroll
                for (int dt = 0; dt < 4; ++dt) { const bf16x8 vf = frag_kperm(Vt + (16 * (4 * dh + dt) + fr) * 264 + 32 * ks, fq); oa[dt] = mma16(pa[ks], vf, oa[dt]); ob[dt] = mma16(pb[ks], vf, ob[dt]); }
                asm volatile("" ::: "memory");
            }
#pragma unroll
            for (int dt = 0; dt < 4; ++dt) {
#ifdef GEMM56_F8
                { const float ia = inva * BR8_SCALE, ib = invb * BR8_SCALE;
                  *(unsigned*)(orow8 + 16 * (4 * dh + dt) + 4 * fq) = pk4_fp8(oa[dt][0] * ia, oa[dt][1] * ia, oa[dt][2] * ia, oa[dt][3] * ia);
                  *(unsigned*)(orow8 + 16 * 512 + 16 * (4 * dh + dt) + 4 * fq) = pk4_fp8(ob[dt][0] * ib, ob[dt][1] * ib, ob[dt][2] * ib, ob[dt][3] * ib); }
#else
                *(u64*)(orow + 16 * (4 * dh + dt) + 4 * fq) = (u64)pk2(oa[dt][0] * inva, oa[dt][1] * inva) | ((u64)pk2(oa[dt][2] * inva, oa[dt][3] * inva) << 32);
                *(u64*)(orow + 16 * 512 + 16 * (4 * dh + dt) + 4 * fq) = (u64)pk2(ob[dt][0] * invb, ob[dt][1] * invb) | ((u64)pk2(ob[dt][2] * invb, ob[dt][3] * invb) << 32);
#endif
            }
        }
    }
    __syncthreads();
}

__device__ __forceinline__ unsigned f2ord(float f) { const unsigned u = __float_as_uint(f); return u ^ ((unsigned)((int)u >> 31) | 0x80000000u); }
__device__ __forceinline__ float ord2f(unsigned o) { return __uint_as_float(o ^ (~(unsigned)((int)o >> 31) | 0x80000000u)); }
template <int N> __device__ __forceinline__ void bitonic_sort_desc(unsigned (&a)[N]) {
#pragma unroll
    for (int k = 2; k <= N; k <<= 1)
#pragma unroll
        for (int j = k >> 1; j > 0; j >>= 1)
#pragma unroll
            for (int i = 0; i < N; ++i) { const int l = i ^ j; if (l > i) { const bool desc = ((i & k) == 0); const unsigned hi = max(a[i], a[l]), lo = min(a[i], a[l]); a[i] = desc ? hi : lo; a[l] = desc ? lo : hi; } }
}
__device__ __forceinline__ void sort16_desc(unsigned (&a)[16]) {
#define CE_(i, j) do { const unsigned hi_ = max(a[i], a[j]), lo_ = min(a[i], a[j]); a[i] = hi_; a[j] = lo_; } while (0)
    CE_(0, 13); CE_(1, 12); CE_(2, 15); CE_(3, 14); CE_(4, 8); CE_(5, 6); CE_(7, 11); CE_(9, 10);
    CE_(0, 5); CE_(1, 7); CE_(2, 9); CE_(3, 4); CE_(6, 13); CE_(8, 14); CE_(10, 15); CE_(11, 12);
    CE_(0, 1); CE_(2, 3); CE_(4, 5); CE_(6, 8); CE_(7, 9); CE_(10, 11); CE_(12, 13); CE_(14, 15);
    CE_(0, 2); CE_(1, 3); CE_(4, 10); CE_(5, 11); CE_(6, 7); CE_(8, 9); CE_(12, 14); CE_(13, 15);
    CE_(1, 2); CE_(3, 12); CE_(4, 6); CE_(5, 7); CE_(8, 10); CE_(9, 11); CE_(13, 14);
    CE_(1, 4); CE_(2, 6); CE_(5, 8); CE_(7, 10); CE_(9, 13); CE_(11, 14);
    CE_(2, 4); CE_(3, 6); CE_(9, 12); CE_(11, 13);
    CE_(3, 5); CE_(6, 8); CE_(7, 9); CE_(10, 12);
    CE_(3, 4); CE_(5, 6); CE_(7, 8); CE_(9, 10); CE_(11, 12);
    CE_(6, 7); CE_(8, 9);
#undef CE_
}
template <int N> __device__ __forceinline__ void bitonic_merge_desc(unsigned (&a)[N]) {
#pragma unroll
    for (int j = N >> 1; j > 0; j >>= 1)
#pragma unroll
        for (int i = 0; i < N; ++i) { const int l = i ^ j; if (l > i) { const unsigned hi = max(a[i], a[l]), lo = min(a[i], a[l]); a[i] = hi; a[l] = lo; } }
}
__device__ __forceinline__ void merge_top16(unsigned (&L)[16], const unsigned (&R)[16]) {
#pragma unroll
    for (int i = 0; i < 16; ++i) L[i] = max(L[i], R[15 - i]);
    bitonic_merge_desc<16>(L);
}
__device__ __forceinline__ unsigned tab_lookup(u64 tlo, u64 thi, unsigned i) {
    const u64 v = (i & 8u) ? thi : tlo;
    return (unsigned)(v >> ((i & 7u) * 8u)) & 0xffu;
}
__device__ __forceinline__ float dot2_bf16(unsigned w, unsigned x, float acc) { return __builtin_amdgcn_fdot2_f32_bf16(__builtin_bit_cast(bf16x2_t, w), __builtin_bit_cast(bf16x2_t, x), acc, false); }
__device__ __forceinline__ float dot4_fp8_bf16(unsigned w, unsigned hlo, unsigned hhi, float acc) {
    const bf16x2_t a = __builtin_amdgcn_cvt_scalef32_pk_bf16_fp8(w, 1.0f / PU_SCALE, false), b = __builtin_amdgcn_cvt_scalef32_pk_bf16_fp8(w, 1.0f / PU_SCALE, true);
    acc = __builtin_amdgcn_fdot2_f32_bf16(a, __builtin_bit_cast(bf16x2_t, hlo), acc, false);
    return __builtin_amdgcn_fdot2_f32_bf16(b, __builtin_bit_cast(bf16x2_t, hhi), acc, false);
}
typedef float f32x2_t __attribute__((ext_vector_type(2)));
__device__ __forceinline__ void axpy4_fp8(unsigned w, float c, float& o0, float& o1, float& o2, float& o3) {
    const f32x2_t lo = __builtin_amdgcn_cvt_pk_f32_fp8(w, false), hi = __builtin_amdgcn_cvt_pk_f32_fp8(w, true);
    o0 += c * lo.x; o1 += c * lo.y; o2 += c * hi.x; o3 += c * hi.y;
}
__device__ __forceinline__ float gelu_erf(float x) { return 0.5f * x * (1.0f + erff(x * 0.70710678118654752f)); }

constexpr int CW_PACE = 8192;
__device__ __forceinline__ void xcd_pace(const XcdBarrier& b, unsigned* pace) {
    __syncthreads();
    if (threadIdx.x == 0 && b.st != nullptr) {
        const unsigned nloc = b.st[0];
        if (nloc > 1u) {
            const unsigned old = xb_add(&pace[64 * b.x], 1u), target = (old / nloc + 1u) * nloc;
            unsigned sp = 0u;
            while (xb_ld(&pace[64 * b.x]) < target) { __builtin_amdgcn_s_sleep(1); if (++sp > (1u << 17)) break; }
        }
    }
    __syncthreads();
}
__device__ __forceinline__ float sum8_lo(float d) { d += dpp<XOR1>(d); d += dpp<XOR2>(d); d += dpp<XOR7>(d); return d; }
__device__ __forceinline__ float sum8_hi(float d) { d += dpp<XOR8>(d); return xrow16_sum(d); }

__device__ __forceinline__ int opaque_v(int x) { asm volatile("" : "+v"(x)); return x; }
__device__ __forceinline__ void peer_route_scores(Frame& F, size_t tokb, int hh, int p, const LAS unsigned char* SKp, unsigned (&topp)[16]) {
    const bf16* PQ = (const bf16*)(F.ws + WS_PQ);
    const int w = F.wave, ln_ = opaque_v(F.lane), fr = ln_ & 15, fq = ln_ >> 4;
    const size_t row = tokb + 16 * w + fr;
                bf16x8 qf[4];
#pragma unroll
                for (int ks = 0; ks < 4; ++ks) qf[ks] = *(const bf16x8*)(PQ + row * 2048 + hh * 256 + p * 128 + 32 * ks + 8 * fq);
                unsigned lo[16], hi[16];
#pragma unroll
                for (int t = 0; t < 8; ++t) {
                    f32x4 s = (f32x4){0.f, 0.f, 0.f, 0.f};
                    const int kr = 16 * t + fr;
#pragma unroll
                    for (int ks = 0; ks < 4; ++ks) s = mma16(qf[ks], *(const LAS bf16x8*)(SKp + kr * 256 + (((4 * ks + fq) ^ (kr & 15)) << 4)), s);
#pragma unroll
                    for (int i = 0; i < 4; ++i) {
                        const unsigned key = (f2ord(s[i]) & ~0x7fu) | (unsigned)(127 - (16 * t + 4 * fq + i));
                        if (t < 4) lo[4 * t + i] = key; else hi[4 * (t - 4) + i] = key;
                    }
                }
                sort16_desc(lo); sort16_desc(hi);
                merge_top16(lo, hi);
#pragma unroll
                for (int mask = 16; mask <= 32; mask <<= 1) {
                    unsigned r[16];
#pragma unroll
                    for (int i = 0; i < 16; ++i) r[i] = __shfl_xor(lo[i], mask);
                    merge_top16(lo, r);
                }
#pragma unroll
                for (int i = 0; i < 16; ++i) topp[i] = lo[i];
}
#ifdef PEER_CANDS_REDUNDANT
__device__ __forceinline__ void peer_route_cands(Frame& F, int hh, const unsigned (&top0)[16], const unsigned (&top1)[16], LAS u16* EI, LAS bf16* GWb) {
    const int w = F.wave, ln_ = opaque_v(F.lane), fr = ln_ & 15, fq = ln_ >> 4;
            float sv0[16], sv1[16]; u64 t0lo = 0ull, t0hi = 0ull, t1lo = 0ull, t1hi = 0ull;
#pragma unroll
            for (int i = 0; i < 16; ++i) {
                sv0[i] = ord2f(top0[i] & ~0x7fu); sv1[i] = ord2f(top1[i] & ~0x7fu);
                const u64 n0 = (u64)(127u - (top0[i] & 0x7fu)) << ((i & 7) * 8), n1 = (u64)(127u - (top1[i] & 0x7fu)) << ((i & 7) * 8);
                if (i < 8) { t0lo |= n0; t1lo |= n1; } else { t0hi |= n0; t1hi |= n1; }
            }
#define CKEY(i, j) ((f2ord(sv0[i] + sv1[j]) & ~0xffu) | (unsigned)(255 - (16 * (i) + (j))))
            unsigned L[16], R[16];
#pragma unroll
            for (int j = 0; j < 16; ++j) L[j] = CKEY(0, j);
#pragma unroll
            for (int j = 0; j < 16; ++j) R[j] = (j < 8) ? CKEY(1, j) : 0u;
            merge_top16(L, R);
            R[0] = CKEY(2, 0); R[1] = CKEY(2, 1); R[2] = CKEY(2, 2); R[3] = CKEY(2, 3); R[4] = CKEY(2, 4);
            R[5] = CKEY(3, 0); R[6] = CKEY(3, 1); R[7] = CKEY(3, 2); R[8] = CKEY(3, 3);
            R[9] = CKEY(4, 0); R[10] = CKEY(4, 1); R[11] = CKEY(4, 2);
            R[12] = CKEY(5, 0); R[13] = CKEY(5, 1); R[14] = CKEY(6, 0); R[15] = CKEY(6, 1);
            bitonic_sort_desc<16>(R); merge_top16(L, R);
            R[0] = CKEY(7, 0); R[1] = CKEY(7, 1);
            R[2] = CKEY(8, 0); R[3] = CKEY(9, 0); R[4] = CKEY(10, 0); R[5] = CKEY(11, 0); R[6] = CKEY(12, 0); R[7] = CKEY(13, 0); R[8] = CKEY(14, 0); R[9] = CKEY(15, 0);
            R[10] = 0u; R[11] = 0u; R[12] = 0u; R[13] = 0u; R[14] = 0u; R[15] = 0u;
            bitonic_sort_desc<16>(R); merge_top16(L, R);
#undef CKEY
            float ts[16], sum = 0.f; unsigned ei[16];
#pragma unroll
            for (int k = 0; k < 16; ++k) {
                ts[k] = ord2f(L[k] & ~0xffu);
                const unsigned ij = 255u - (L[k] & 0xffu);
                ei[k] = tab_lookup(t0lo, t0hi, ij >> 4) * 128u + tab_lookup(t1lo, t1hi, ij & 15u);
            }
            const float tmax = ts[0];
#pragma unroll
            for (int k = 0; k < 16; ++k) { ts[k] = __expf(ts[k] - tmax); sum += ts[k]; }
            const float inv = 1.0f / sum;
            if (fq == 0) {
                const int tl = 16 * w + fr;
#pragma unroll
                for (int k = 0; k < 16; ++k) { EI[tl * 128 + hh * 16 + k] = (u16)ei[k]; GWb[tl * 128 + hh * 16 + k] = (bf16)f2bf(ts[k] * inv); }
            }
}

#else
__device__ __forceinline__ void peer_route_cands(Frame& F, int hh, const unsigned (&top0)[16], const unsigned (&top1)[16], LAS u16* EI, LAS bf16* GWb, LAS unsigned* TS) {
    const int w = F.wave, ln_ = opaque_v(F.lane), fr = ln_ & 15, fq = ln_ >> 4;
    LAS unsigned* ts_ = TS + (w * 16 + fr) * 36;
    if (fq == 0) {
#pragma unroll
        for (int q = 0; q < 4; ++q) { *(LAS v4u*)(ts_ + 4 * q) = (v4u){top0[4 * q], top0[4 * q + 1], top0[4 * q + 2], top0[4 * q + 3]}; *(LAS v4u*)(ts_ + 16 + 4 * q) = (v4u){top1[4 * q], top1[4 * q + 1], top1[4 * q + 2], top1[4 * q + 3]}; }
    }
    const u64 IA = fq == 0 ? 0x0000000000000ull : fq == 1 ? 0x2211111111000ull : fq == 2 ? 0x0554443333222ull : 0x0FEDCBA987766ull;
    const u64 JB = fq == 0 ? 0xCBA9876543210ull : fq == 1 ? 0x1076543210FEDull : fq == 2 ? 0x0102103210432ull : 0x0000000001010ull;
    LDS_WAIT();
    unsigned C[16];
#pragma unroll
    for (int sl = 0; sl < 13; ++sl) {
        const unsigned ia = (unsigned)(IA >> (4 * sl)) & 15u, jb = (unsigned)(JB >> (4 * sl)) & 15u;
        const unsigned ka = ts_[ia], kb = ts_[16 + jb];
        const unsigned key = (f2ord(ord2f(ka & ~0x7fu) + ord2f(kb & ~0x7fu)) & ~0xffu) | (255u - (16u * ia + jb));
        C[sl] = (sl == 12 && fq >= 2) ? 0u : key;
    }
    C[13] = 0u; C[14] = 0u; C[15] = 0u;
    sort16_desc(C);
#pragma unroll
    for (int mask = 16; mask <= 32; mask <<= 1) {
        unsigned r[16];
#pragma unroll
        for (int i = 0; i < 16; ++i) r[i] = __shfl_xor(C[i], mask);
        merge_top16(C, r);
    }
    const float tmax = ord2f(C[0] & ~0xffu);
    float pr[4], sum = 0.f; unsigned ei[4];
    const unsigned m1 = 0u - (unsigned)(fq & 1), m2 = 0u - (unsigned)((fq >> 1) & 1);
#pragma unroll
    for (int q = 0; q < 4; ++q) {
        const unsigned lo_ = (C[4 + q] & m1) | (C[q] & ~m1), hi_ = (C[12 + q] & m1) | (C[8 + q] & ~m1), k = (hi_ & m2) | (lo_ & ~m2);
        const unsigned ij = 255u - (k & 0xffu);
        const unsigned ka = ts_[ij >> 4], kb = ts_[16 + (ij & 15u)];
        ei[q] = (127u - (ka & 0x7fu)) * 128u + (127u - (kb & 0x7fu));
        pr[q] = __expf(ord2f(k & ~0xffu) - tmax); sum += pr[q];
    }
    const float inv = 1.0f / xrow16_sum(sum);
    const int o_ = (16 * w + fr) * 128 + hh * 16 + 4 * fq;
    *(LAS u64*)(EI + o_) = (u64)(ei[0] | (ei[1] << 16)) | ((u64)(ei[2] | (ei[3] << 16)) << 32);
    *(LAS u64*)(GWb + o_) = (u64)(f2bf(pr[0] * inv) | (f2bf(pr[1] * inv) << 16)) | ((u64)(f2bf(pr[2] * inv) | (f2bf(pr[3] * inv) << 16)) << 32);
}
#endif

template <int CTRL> __device__ __forceinline__ int dppi(int x) { return __builtin_amdgcn_mov_dpp(x, CTRL, 0xf, 0xf, true); }
__device__ __forceinline__ int isum8_lo(int d) { d += dppi<XOR1>(d); d += dppi<XOR2>(d); d += dppi<XOR7>(d); return d; }
__device__ __forceinline__ int sdot16(v4u a, v4u b, int acc) {
    acc = __builtin_amdgcn_sdot4((int)a.x, (int)b.x, acc, false); acc = __builtin_amdgcn_sdot4((int)a.y, (int)b.y, acc, false);
    acc = __builtin_amdgcn_sdot4((int)a.z, (int)b.z, acc, false); return __builtin_amdgcn_sdot4((int)a.w, (int)b.w, acc, false);
}
__device__ __forceinline__ int ixrow16_sum(int x) {
    auto s = __builtin_amdgcn_permlane16_swap((unsigned)x, (unsigned)x, false, false);
    x = (int)(s[0] + s[1]);
    auto t = __builtin_amdgcn_permlane32_swap((unsigned)x, (unsigned)x, false, false);
    return (int)(t[0] + t[1]);
}
__device__ __forceinline__ int isum8_hi(int d) { d += dppi<XOR8>(d); return ixrow16_sum(d); }
__device__ __forceinline__ void vred16_hi(int (&a)[16], int& d0, int& d1, int lane) {
#pragma unroll
    for (int i = 0; i < 8; ++i) { auto s = __builtin_amdgcn_permlane32_swap((unsigned)a[i], (unsigned)a[i + 8], false, false); a[i] = (int)(s[0] + s[1]); }
#pragma unroll
    for (int i = 0; i < 4; ++i) { auto s = __builtin_amdgcn_permlane16_swap((unsigned)a[i], (unsigned)a[i + 4], false, false); a[i] = (int)(s[0] + s[1]); }
    const bool b3 = (lane & 8) != 0;
    d0 = (b3 ? a[2] : a[0]) + dppi<XOR8>(b3 ? a[0] : a[2]);
    d1 = (b3 ? a[3] : a[1]) + dppi<XOR8>(b3 ? a[1] : a[3]);
}
__device__ __forceinline__ void tr_dot4_quad(unsigned A, unsigned B, unsigned C, unsigned D, unsigned cq, int& a0, int& a1, int& a2, int& a3) {
    const unsigned t0 = __builtin_amdgcn_perm(B, A, 0x05010400u), t1 = __builtin_amdgcn_perm(B, A, 0x07030602u);
    const unsigned u0 = __builtin_amdgcn_perm(D, C, 0x05010400u), u1 = __builtin_amdgcn_perm(D, C, 0x07030602u);
    a0 = __builtin_amdgcn_sdot4((int)__builtin_amdgcn_perm(u0, t0, 0x05040100u), (int)cq, a0, false);
    a1 = __builtin_amdgcn_sdot4((int)__builtin_amdgcn_perm(u0, t0, 0x07060302u), (int)cq, a1, false);
    a2 = __builtin_amdgcn_sdot4((int)__builtin_amdgcn_perm(u1, t1, 0x05040100u), (int)cq, a2, false);
    a3 = __builtin_amdgcn_sdot4((int)__builtin_amdgcn_perm(u1, t1, 0x07060302u), (int)cq, a3, false);
}
__device__ __forceinline__ int sdot4_z(unsigned a, unsigned b) { int d; asm("v_dot4_i32_i8 %0, %1, %2, 0" : "=v"(d) : "v"(a), "v"(b)); return d; }
__device__ __forceinline__ void tr_dot4_quad_z(unsigned A, unsigned B, unsigned C, unsigned D, unsigned cq, int& a0, int& a1, int& a2, int& a3) {
    const unsigned t0 = __builtin_amdgcn_perm(B, A, 0x05010400u), t1 = __builtin_amdgcn_perm(B, A, 0x07030602u);
    const unsigned u0 = __builtin_amdgcn_perm(D, C, 0x05010400u), u1 = __builtin_amdgcn_perm(D, C, 0x07030602u);
    a0 = sdot4_z(__builtin_amdgcn_perm(u0, t0, 0x05040100u), cq); a1 = sdot4_z(__builtin_amdgcn_perm(u0, t0, 0x07060302u), cq);
    a2 = sdot4_z(__builtin_amdgcn_perm(u1, t1, 0x05040100u), cq); a3 = sdot4_z(__builtin_amdgcn_perm(u1, t1, 0x07060302u), cq);
}
__device__ __forceinline__ void tr_dot4_z(v4u A, v4u B, v4u C, v4u D, unsigned cq, int (&acc)[16]) {
    tr_dot4_quad_z(A.x, B.x, C.x, D.x, cq, acc[0], acc[1], acc[2], acc[3]); tr_dot4_quad_z(A.y, B.y, C.y, D.y, cq, acc[4], acc[5], acc[6], acc[7]);
    tr_dot4_quad_z(A.z, B.z, C.z, D.z, cq, acc[8], acc[9], acc[10], acc[11]); tr_dot4_quad_z(A.w, B.w, C.w, D.w, cq, acc[12], acc[13], acc[14], acc[15]);
}
__device__ __forceinline__ void tr_dot4(v4u A, v4u B, v4u C, v4u D, unsigned cq, int (&acc)[16]) {
    tr_dot4_quad(A.x, B.x, C.x, D.x, cq, acc[0], acc[1], acc[2], acc[3]); tr_dot4_quad(A.y, B.y, C.y, D.y, cq, acc[4], acc[5], acc[6], acc[7]);
    tr_dot4_quad(A.z, B.z, C.z, D.z, cq, acc[8], acc[9], acc[10], acc[11]); tr_dot4_quad(A.w, B.w, C.w, D.w, cq, acc[12], acc[13], acc[14], acc[15]);
}
__device__ __forceinline__ int sdot32_i4(v4u u, const unsigned (&he)[4], const unsigned (&ho)[4]) {
    int acc = 0;
    acc = __builtin_amdgcn_sdot4((int)(u.x & 0xf0f0f0f0u), (int)ho[0], acc, false); acc = __builtin_amdgcn_sdot4((int)((u.x << 4) & 0xf0f0f0f0u), (int)he[0], acc, false);
    acc = __builtin_amdgcn_sdot4((int)(u.y & 0xf0f0f0f0u), (int)ho[1], acc, false); acc = __builtin_amdgcn_sdot4((int)((u.y << 4) & 0xf0f0f0f0u), (int)he[1], acc, false);
    acc = __builtin_amdgcn_sdot4((int)(u.z & 0xf0f0f0f0u), (int)ho[2], acc, false); acc = __builtin_amdgcn_sdot4((int)((u.z << 4) & 0xf0f0f0f0u), (int)he[2], acc, false);
    acc = __builtin_amdgcn_sdot4((int)(u.w & 0xf0f0f0f0u), (int)ho[3], acc, false); return __builtin_amdgcn_sdot4((int)((u.w << 4) & 0xf0f0f0f0u), (int)he[3], acc, false);
}
__device__ __forceinline__ int sdot32_i4_planes(v4u u, v4u hi, v4u lo) {
    int ah, al;
    asm("v_dot8_i32_i4 %0, %1, %2, 0" : "=v"(ah) : "v"(u.x), "v"(hi.x));
    asm("v_dot8_i32_i4 %0, %1, %2, 0" : "=v"(al) : "v"(u.x), "v"(lo.x));
    ah = __builtin_amdgcn_sdot8((int)u.y, (int)hi.y, ah, false); al = __builtin_amdgcn_sdot8((int)u.y, (int)lo.y, al, false);
    ah = __builtin_amdgcn_sdot8((int)u.z, (int)hi.z, ah, false); al = __builtin_amdgcn_sdot8((int)u.z, (int)lo.z, al, false);
    ah = __builtin_amdgcn_sdot8((int)u.w, (int)hi.w, ah, false); al = __builtin_amdgcn_sdot8((int)u.w, (int)lo.w, al, false);
    return (ah << 4) + al;
}
__device__ __forceinline__ void sdot32_i4_planes_init(v4u u, v4u hi, v4u lo, int& ah, int& al) {
    asm("v_dot8_i32_i4 %0, %1, %2, 0" : "=v"(ah) : "v"(u.x), "v"(hi.x));
    asm("v_dot8_i32_i4 %0, %1, %2, 0" : "=v"(al) : "v"(u.x), "v"(lo.x));
    ah = __builtin_amdgcn_sdot8((int)u.y, (int)hi.y, ah, false); al = __builtin_amdgcn_sdot8((int)u.y, (int)lo.y, al, false);
    ah = __builtin_amdgcn_sdot8((int)u.z, (int)hi.z, ah, false); al = __builtin_amdgcn_sdot8((int)u.z, (int)lo.z, al, false);
    ah = __builtin_amdgcn_sdot8((int)u.w, (int)hi.w, ah, false); al = __builtin_amdgcn_sdot8((int)u.w, (int)lo.w, al, false);
}
__device__ __forceinline__ void sdot32_i4_planes_acc(v4u u, v4u hi, v4u lo, int& ah, int& al) {
    ah = __builtin_amdgcn_sdot8((int)u.x, (int)hi.x, ah, false); al = __builtin_amdgcn_sdot8((int)u.x, (int)lo.x, al, false);
    ah = __builtin_amdgcn_sdot8((int)u.y, (int)hi.y, ah, false); al = __builtin_amdgcn_sdot8((int)u.y, (int)lo.y, al, false);
    ah = __builtin_amdgcn_sdot8((int)u.z, (int)hi.z, ah, false); al = __builtin_amdgcn_sdot8((int)u.z, (int)lo.z, al, false);
    ah = __builtin_amdgcn_sdot8((int)u.w, (int)hi.w, ah, false); al = __builtin_amdgcn_sdot8((int)u.w, (int)lo.w, al, false);
}
__device__ __forceinline__ void ured16_lo(const int (&d)[16], int& o0, int& o1, int lane) {
    const bool b2 = (lane & 4) != 0, b0 = (lane & 1) != 0, b1 = (lane & 2) != 0;
    int x[8], y[4];
#pragma unroll
    for (int i = 0; i < 8; ++i) x[i] = (b2 ? d[i + 8] : d[i]) + dppi<XOR7>(b2 ? d[i] : d[i + 8]);
#pragma unroll
    for (int i = 0; i < 4; ++i) y[i] = (b0 ? x[i + 4] : x[i]) + dppi<XOR1>(b0 ? x[i] : x[i + 4]);
    o0 = (b1 ? y[2] : y[0]) + dppi<XOR2>(b1 ? y[0] : y[2]);
    o1 = (b1 ? y[3] : y[1]) + dppi<XOR2>(b1 ? y[1] : y[3]);
}
__device__ __forceinline__ void load_eids(const LAS u16* EI, int tl, int r, unsigned (&e)[16]) {
    const v4u a = *(const LAS v4u*)(EI + tl * 128 + r * 16), b = *(const LAS v4u*)(EI + tl * 128 + r * 16 + 8);
    e[0] = a.x & 0xffffu; e[1] = a.x >> 16; e[2] = a.y & 0xffffu; e[3] = a.y >> 16; e[4] = a.z & 0xffffu; e[5] = a.z >> 16; e[6] = a.w & 0xffffu; e[7] = a.w >> 16;
    e[8] = b.x & 0xffffu; e[9] = b.x >> 16; e[10] = b.y & 0xffffu; e[11] = b.y >> 16; e[12] = b.z & 0xffffu; e[13] = b.z >> 16; e[14] = b.w & 0xffffu; e[15] = b.w >> 16;
}
__device__ __forceinline__ void load_eoffs(const LAS u16* EI, int tl, int r, unsigned c16, unsigned (&e)[16]) {
    const v4u a = *(const LAS v4u*)(EI + tl * 128 + r * 16), b = *(const LAS v4u*)(EI + tl * 128 + r * 16 + 8);
    const unsigned p[8] = {a.x, a.y, a.z, a.w, b.x, b.y, b.z, b.w};
#pragma unroll
    for (int k = 0; k < 8; ++k) { e[2 * k] = ((p[k] & 0xffffu) << 7) | c16; e[2 * k + 1] = ((p[k] >> 9) & 0x7fff80u) | c16; }
}

__device__ __forceinline__ void ln2_store(const u64 (&h)[4], const u64 (&po)[4], float* yrow, const float* g2, const float* b2, int lane) {
    f32x4 hv[4]; float sm = 0.f;
#pragma unroll
    for (int j = 0; j < 4; ++j) {
        const unsigned h0 = (unsigned)h[j], h1 = (unsigned)(h[j] >> 32), p0 = (unsigned)po[j], p1 = (unsigned)(po[j] >> 32);
        hv[j] = (f32x4){bflo(h0), bfhi(h0), bflo(h1), bfhi(h1)} * ALPHA + (f32x4){bflo(p0), bfhi(p0), bflo(p1), bfhi(p1)};
        sm += (hv[j][0] + hv[j][1]) + (hv[j][2] + hv[j][3]);
    }
    const float mean = wave_sum(sm) * (1.f / 1024.f); float s2 = 0.f;
#pragma unroll
    for (int q = 0; q < 4; ++q) { hv[q] = hv[q] - mean; s2 += (hv[q][0] * hv[q][0] + hv[q][1] * hv[q][1]) + (hv[q][2] * hv[q][2] + hv[q][3] * hv[q][3]); }
    const float rstd = 1.f / sqrtf(wave_sum(s2) * (1.f / 1024.f) + LN_EPS);
#pragma unroll
    for (int j = 0; j < 4; ++j) ((f32x4*)yrow)[lane + 64 * j] = hv[j] * rstd * ((const f32x4*)g2)[lane + 64 * j] + ((const f32x4*)b2)[lane + 64 * j];
}

__device__ __forceinline__ void peer_phase(Frame& F, const XcdBarrier& bar, unsigned* pace, const int mode) {
    LAS u16* EI = (LAS u16*)(F.lds);
    LAS bf16* GWb = (LAS bf16*)(F.lds + 32768);
    LAS int* Di = (LAS int*)(F.lds + 65536);
    LAS float* Df = (LAS float*)(F.lds + 65536);
    LAS unsigned char* SK = F.lds + 65536;
    LAS unsigned char* Dq = F.lds + 131072;
    LAS float* CS = (LAS float*)(F.lds + 131072 + 16384);
    const bf16* HB = (const bf16*)(F.ws + WS_HB); const unsigned char* H8 = F.ws + WS_H8; const float* HS = (const float*)(F.ws + WS_HS);
    const unsigned char* PU8 = F.ws + WS_PU; const float* US = (const float*)(F.ws + WS_US); const unsigned char* PV8 = F.ws + WS_PV;
    const bf16* SUBK = (const bf16*)(F.ws + WS_SUBK);
    bf16* PO = (bf16*)(F.ws + WS_PO);
    const int w = F.wave;
    for (int blk = blockIdx.x; blk < T / 256; blk += F.G)
        for (int half = 0; half < 2; ++half) {
            int blk_o = blk; asm volatile("" : "+s"(blk_o));
            const size_t tokb = (size_t)blk_o * 256 + (size_t)half * 128;
            {
#define SK_ISSUE(stage, buf) do { const bf16* src_ = SUBK + (size_t)(stage) * 128 * 128; \
        const int ln_ = opaque_v(F.lane);     \
        _Pragma("unroll") for (int q_ = 0; q_ < 4; ++q_) { const int kr_ = 16 * w + 4 * q_ + (ln_ >> 4), pos_ = ln_ & 15, ch_ = pos_ ^ (kr_ & 15);     \
            __builtin_amdgcn_global_load_lds((const unsigned*)(src_ + (size_t)kr_ * 128 + 8 * ch_), (LAS unsigned*)(SK + (buf) * 32768 + (16 * w + 4 * q_) * 256), 16, 0, 0); } } while (0)
                unsigned top0[16], top1[16];
                SK_ISSUE(0, 0);
                for (int hh = 0; hh < 8; ++hh) {
                    __syncthreads();
                    SK_ISSUE(2 * hh + 1, 1);
                    peer_route_scores(F, tokb, hh, 0, SK, top0);
                    __syncthreads();
                    if (hh < 7) SK_ISSUE(2 * hh + 2, 0);
                    peer_route_scores(F, tokb, hh, 1, SK + 32768, top1);
#ifdef PEER_CANDS_REDUNDANT
                    peer_route_cands(F, hh, top0, top1, EI, GWb);
#else
                    peer_route_cands(F, hh, top0, top1, EI, GWb, (LAS unsigned*)(F.lds + 131072));
#endif
                }
                __syncthreads();
#undef SK_ISSUE
            }
            const int lane = opaque_v(F.lane), r = lane >> 3, c = lane & 7;
#if defined(PEER_U_INT4) && defined(PEER_U_DOT8) && defined(PEER_U_TOKMAJOR)
            if (mode & 1) {
                const unsigned c16 = 16u * (unsigned)c;
                v4u uA[16], uB[16], hA0, hA1, hB0, hB1; unsigned e[16]; int AH[16], AL[16];
#define U_LOAD(UU, H0, H1, t, s) do { const int tl_ = 16 * w + (t); const unsigned char* us_ = PU8 + (size_t)(s) * (16384 * 128); \
        const unsigned char* hrow_ = H8 + (tokb + tl_) * 1024 + 256 * (s);     \
        H0 = *(const v4u*)(hrow_ + 2u * c16); H1 = *(const v4u*)(hrow_ + 2u * c16 + 16u); \
        _Pragma("unroll") for (int g = 0; g < 16; ++g) UU[g] = *(const v4u*)(us_ + e[g]); } while (0)
#define U_ACC0(UU, H0, H1) _Pragma("unroll") for (int g = 0; g < 16; ++g) sdot32_i4_planes_init(UU[g], H0, H1, AH[g], AL[g])
#define U_ACC(UU, H0, H1) _Pragma("unroll") for (int g = 0; g < 16; ++g) sdot32_i4_planes_acc(UU[g], H0, H1, AH[g], AL[g])
#define U_FIN(t) do { const int tl_ = 16 * w + (t); int d_[16]; \
        _Pragma("unroll") for (int g = 0; g < 16; ++g) d_[g] = isum8_lo((AH[g] << 4) + AL[g]); \
        if (c == 0) { LAS int* p_ = Di + tl_ * 128 + r * 16; \
            _Pragma("unroll") for (int q = 0; q < 4; ++q) *(LAS v4u*)(p_ + 4 * q) = (v4u){(unsigned)d_[4 * q], (unsigned)d_[4 * q + 1], (unsigned)d_[4 * q + 2], (unsigned)d_[4 * q + 3]}; } } while (0)
                load_eoffs(EI, 16 * w, r, c16, e);
                U_LOAD(uA, hA0, hA1, 0, 0);
#pragma unroll 1
                for (int t = 0; t < 16; ++t) {
                    U_LOAD(uB, hB0, hB1, t, 1);
                    U_ACC0(uA, hA0, hA1);
                    asm volatile("" ::: "memory");
                    U_LOAD(uA, hA0, hA1, t, 2);
                    U_ACC(uB, hB0, hB1);
                    asm volatile("" ::: "memory");
                    U_LOAD(uB, hB0, hB1, t, 3);
                    U_ACC(uA, hA0, hA1);
                    asm volatile("" ::: "memory");
                    { const int tn = t + 1 < 16 ? t + 1 : 15; load_eoffs(EI, 16 * w + tn, r, c16, e); U_LOAD(uA, hA0, hA1, tn, 0); }
                    U_ACC(uB, hB0, hB1);
                    U_FIN(t);
                    asm volatile("" ::: "memory");
                }
#undef U_LOAD
#undef U_ACC0
#undef U_ACC
#undef U_FIN
            }
#elif defined(PEER_U_INT4)
            if (mode & 1) for (int s = 0; s < 4; ++s) {
                const unsigned char* us = PU8 + (size_t)s * (16384 * 128);
                const unsigned c16 = 16u * (unsigned)c;
                v4u uA[16], uB[16], hA0, hA1, hB0, hB1; unsigned e[16];
#ifdef PEER_U_DOT8
#define U_DOTS(UU, H0, H1) _Pragma("unroll") for (int g = 0; g < 16; ++g) d_[g] = sdot32_i4_planes(UU[g], H0, H1)
#else
#define U_DOTS(UU, H0, H1) unsigned he_[4], ho_[4];     \
        he_[0] = __builtin_amdgcn_perm(H0.y, H0.x, 0x06040200u); ho_[0] = __builtin_amdgcn_perm(H0.y, H0.x, 0x07050301u); \
        he_[1] = __builtin_amdgcn_perm(H0.w, H0.z, 0x06040200u); ho_[1] = __builtin_amdgcn_perm(H0.w, H0.z, 0x07050301u); \
        he_[2] = __builtin_amdgcn_perm(H1.y, H1.x, 0x06040200u); ho_[2] = __builtin_amdgcn_perm(H1.y, H1.x, 0x07050301u); \
        he_[3] = __builtin_amdgcn_perm(H1.w, H1.z, 0x06040200u); ho_[3] = __builtin_amdgcn_perm(H1.w, H1.z, 0x07050301u); \
        _Pragma("unroll") for (int g = 0; g < 16; ++g) d_[g] = sdot32_i4(UU[g], he_, ho_)
#endif
#define U_LOAD(UU, H0, H1, t) do { const int tl_ = 16 * w + (t); load_eoffs(EI, tl_, r, c16, e); \
        H0 = *(const v4u*)(H8 + (tokb + tl_) * 1024 + 256 * s + 32 * c); H1 = *(const v4u*)(H8 + (tokb + tl_) * 1024 + 256 * s + 32 * c + 16); \
        _Pragma("unroll") for (int g = 0; g < 16; ++g) UU[g] = *(const v4u*)(us + e[g]); } while (0)
#ifdef PEER_U_PLAINRED
#define U_COMP(UU, H0, H1, t) do { const int tl_ = 16 * w + (t); int d_[16]; \
        U_DOTS(UU, H0, H1); \
        _Pragma("unroll") for (int g = 0; g < 16; ++g) d_[g] = isum8_lo(d_[g]); \
        if (c == 0) { LAS int* p_ = Di + tl_ * 128 + r * 16; \
            if (s == 0) { _Pragma("unroll") for (int q = 0; q < 4; ++q) *(LAS v4u*)(p_ + 4 * q) = (v4u){(unsigned)d_[4 * q], (unsigned)d_[4 * q + 1], (unsigned)d_[4 * q + 2], (unsigned)d_[4 * q + 3]}; } \
            else { _Pragma("unroll") for (int q = 0; q < 4; ++q) { const v4u o_ = *(const LAS v4u*)(p_ + 4 * q); *(LAS v4u*)(p_ + 4 * q) = (v4u){o_.x + (unsigned)d_[4 * q], o_.y + (unsigned)d_[4 * q + 1], o_.z + (unsigned)d_[4 * q + 2], o_.w + (unsigned)d_[4 * q + 3]}; } } } } while (0)
#else
#define U_COMP(UU, H0, H1, t) do { const int tl_ = 16 * w + (t); int d_[16], o0_, o1_; \
        U_DOTS(UU, H0, H1); \
        ured16_lo(d_, o0_, o1_, lane); \
        LAS u64* p_ = (LAS u64*)(Di + tl_ * 128 + r * 16 + g0); \
        if (s == 0) *p_ = (u64)(unsigned)o0_ | ((u64)(unsigned)o1_ << 32); \
        else { const u64 v_ = *p_; *p_ = (u64)((unsigned)v_ + (unsigned)o0_) | ((u64)((unsigned)(v_ >> 32) + (unsigned)o1_) << 32); } } while (0)
                const int g0 = (lane & 2) + ((lane & 1) << 2) + ((lane & 4) << 1);
#endif
                U_LOAD(uA, hA0, hA1, 0);
                for (int t = 0; t < 16; t += 2) {
                    U_LOAD(uB, hB0, hB1, t + 1);
                    U_COMP(uA, hA0, hA1, t);
                    if (t + 2 < 16) U_LOAD(uA, hA0, hA1, t + 2);
                    U_COMP(uB, hB0, hB1, t + 1);
                }
#undef U_LOAD
#undef U_COMP
#undef U_DOTS
            }
#else
            if (mode & 1) for (int s = 0; s < 8; ++s) {
                if (mode & 8) xcd_pace(bar, pace);
                const unsigned char* us = PU8 + (size_t)s * (16384 * 128) + 16 * c;
                v4u uA[16], uB[16], hA, hB; unsigned e[16];
#define U_LOAD(UU, HH, t) do { const int tl_ = 16 * w + (t); load_eids(EI, tl_, r, e); HH = *(const v4u*)(H8 + (tokb + tl_) * 1024 + 128 * s + 16 * c); \
        _Pragma("unroll") for (int g = 0; g < 16; ++g) UU[g] = *(const v4u*)(us + (size_t)e[g] * 128); } while (0)
#define U_COMP(UU, HH, t) do { const int tl_ = 16 * w + (t); int d_[16]; \
        _Pragma("unroll") for (int g = 0; g < 16; ++g) d_[g] = sdot16(UU[g], HH, 0); \
        _Pragma("unroll") for (int g = 0; g < 16; ++g) d_[g] = isum8_lo(d_[g]); \
        if (c == 0) { LAS int* p_ = Di + tl_ * 128 + r * 16; \
            if (s == 0) { _Pragma("unroll") for (int q = 0; q < 4; ++q) *(LAS v4u*)(p_ + 4 * q) = (v4u){(unsigned)d_[4 * q], (unsigned)d_[4 * q + 1], (unsigned)d_[4 * q + 2], (unsigned)d_[4 * q + 3]}; } \
            else { _Pragma("unroll") for (int q = 0; q < 4; ++q) { const v4u o_ = *(const LAS v4u*)(p_ + 4 * q); *(LAS v4u*)(p_ + 4 * q) = (v4u){o_.x + (unsigned)d_[4 * q], o_.y + (unsigned)d_[4 * q + 1], o_.z + (unsigned)d_[4 * q + 2], o_.w + (unsigned)d_[4 * q + 3]}; } } } } while (0)
                U_LOAD(uA, hA, 0);
                for (int t = 0; t < 16; t += 2) {
                    U_LOAD(uB, hB, t + 1);
                    U_COMP(uA, hA, t);
                    if (t + 2 < 16) U_LOAD(uA, hA, t + 2);
                    U_COMP(uB, hB, t + 1);
                }
#undef U_LOAD
#undef U_COMP
            }
#endif
            LDS_WAIT();
            {
                const float* VS = (const float*)(F.ws + WS_VS);
                for (int t4 = 0; t4 < 16; t4 += 4) {
                    float us0[4], us1[4], vs0[4], vs1[4], hs[4];
#pragma unroll
                    for (int q = 0; q < 4; ++q) { const int tl = 16 * w + t4 + q, i0 = tl * 128 + lane; const unsigned e0 = EI[i0], e1 = EI[i0 + 64];
                        us0[q] = US[e0]; us1[q] = US[e1]; vs0[q] = VS[e0]; vs1[q] = VS[e1]; hs[q] = HS[tokb + tl]; }
#pragma unroll
                    for (int q = 0; q < 4; ++q) {
                        const int tl = 16 * w + t4 + q, i0 = tl * 128 + lane, i1 = i0 + 64;
                        const float c0 = bflo((unsigned)GWb[i0]) * gelu_erf((float)Di[i0] * us0[q] * hs[q]) * vs0[q];
                        const float c1 = bflo((unsigned)GWb[i1]) * gelu_erf((float)Di[i1] * us1[q] * hs[q]) * vs1[q];
                        const float m = fmaxf(wave_max(fmaxf(fabsf(c0), fabsf(c1))), 1e-30f), inv = 127.0f / m;
                        Dq[i0] = (unsigned char)(__float2int_rn(c0 * inv) & 0xff); Dq[i1] = (unsigned char)(__float2int_rn(c1 * inv) & 0xff);
                        if (lane == 0) CS[tl] = m * (1.0f / 127.0f);
                    }
                }
            }
            LDS_WAIT();
            if (mode & 2) for (int s = 0; s < 8; ++s) {
                if (mode & 8) xcd_pace(bar, pace);
                const unsigned char* vs = PV8 + (size_t)s * (16384 * 128);
                const unsigned c16 = 16u * (unsigned)c;
                v4u vA[16], vB[16]; unsigned e[16];
#define V_LOAD(VV, t) do { const int tl_ = 16 * w + (t); load_eoffs(EI, tl_, r, c16, e); \
        _Pragma("unroll") for (int g = 0; g < 16; ++g) VV[g] = *(const v4u*)(vs + e[g]); } while (0)
#define V_COMP(VV, t) do { const int tl_ = 16 * w + (t); int acc[16]; \
        const v4u cq_ = *(const LAS v4u*)(Dq + tl_ * 128 + r * 16); \
        tr_dot4_z(VV[0], VV[1], VV[2], VV[3], cq_.x, acc); tr_dot4(VV[4], VV[5], VV[6], VV[7], cq_.y, acc); \
        tr_dot4(VV[8], VV[9], VV[10], VV[11], cq_.z, acc); tr_dot4(VV[12], VV[13], VV[14], VV[15], cq_.w, acc); \
        int d0_, d1_; vred16_hi(acc, d0_, d1_, lane);     \
        { const float cs_ = CS[tl_]; *(unsigned*)(PO + (tokb + tl_) * 1024 + 128 * s + 16 * c + 2 * r) = pk2((float)d0_ * cs_, (float)d1_ * cs_); } } while (0)
                V_LOAD(vA, 0);
                for (int t = 0; t < 16; t += 2) {
                    V_LOAD(vB, t + 1);
                    V_COMP(vA, t);
                    if (t + 2 < 16) V_LOAD(vA, t + 2);
                    V_COMP(vB, t + 1);
                }
#undef V_LOAD
#undef V_COMP
            }
            VM_WAIT();
            __syncthreads();
            if (mode & 4) for (int t = 0; t < 16; t += 4) {
                u64 hh_[4][4], pp_[4][4];
#pragma unroll
                for (int q = 0; q < 4; ++q)
#pragma unroll
                    for (int j = 0; j < 4; ++j) { const size_t tok = tokb + 16 * w + t + q; hh_[q][j] = ((const u64*)(HB + tok * 1024))[lane + 64 * j]; pp_[q][j] = ((const u64*)(PO + tok * 1024))[lane + 64 * j]; }
#pragma unroll
                for (int q = 0; q < 4; ++q) ln2_store(hh_[q], pp_[q], F.out + (tokb + 16 * w + t + q) * 1024, karg_in(19), karg_in(20), lane);
            }
            __syncthreads();
        }
}

struct Args { const float* in[21]; float* out; unsigned char* ws; int ph_lo, ph_hi, li, pad; };

__global__ void __launch_bounds__(NTHR, 2) mega_fwd(Args args) {
    extern __shared__ __attribute__((aligned(16))) unsigned char lds_raw[];
    Frame F;
    F.lds = (LAS unsigned char*)lds_raw;
    F.tid = threadIdx.x; F.lane = F.tid & 63; F.wave = __builtin_amdgcn_readfirstlane(F.tid >> 6); F.fr = F.lane & 15; F.fq = F.lane >> 4;
    F.G = gridDim.x;
    F.out = args.out; F.ws = args.ws;
    unsigned char* ws = args.ws;
    gu32* ctl = (gu32*)(ws + WS_CTL);
    volatile LAS unsigned* MISC = (volatile LAS unsigned*)(F.lds + MISC_OFF);
    for (int u = F.tid; u < (LDS_BYTES - LDSCTL_OFF) / 4; u += NTHR) ((LAS unsigned*)(F.lds + LDSCTL_OFF))[u] = 0u;
    __syncthreads();
    XcdBarrier bar; bar.bar = (unsigned*)(ctl + CW_BAR) + args.li * XCD_BAR_WORDS; bar.x = 0; bar.st = nullptr;
    if (N_LAUNCHES != N_PHASES) bar = xcd_barrier_post((unsigned*)(ctl + CW_BAR) + args.li * XCD_BAR_WORDS, MISC + 8);
#define GRID_BAR() do { if (N_LAUNCHES != N_PHASES) xcd_barrier(bar); } while (0)
    const int lo = args.ph_lo, hi = args.ph_hi;
#define FRAME_REFRESH() do { int t_ = threadIdx.x; asm volatile("" : "+v"(t_)); F.tid = t_; F.lane = t_ & 63; F.fr = F.lane & 15; F.fq = F.lane >> 4; } while (0)
#define IN(k) (lo <= (k) && (k) < hi)
#define BOTH(k) (IN(k) && IN((k) + 1))

    bf16* XB = (bf16*)args.out;
#ifndef PEER_MODE
#define PEER_MODE 7
#endif
#ifndef REP_MASK
#define REP_MASK 0
#endif
#define NREP(k) ((((REP_MASK) >> (k)) & 1) + 1)
#define SEAM(k, r) do { if (BOTH(k) || (r) + 1 < NREP(k)) GRID_BAR(); } while (0)
    FRAME_REFRESH();
    if (IN(0)) for (int r_ = 0; r_ < NREP(0); ++r_) { p0_prologue(F); SEAM(0, r_); }
    FRAME_REFRESH();
    if (IN(1)) for (int r_ = 0; r_ < NREP(1); ++r_) {
#ifdef GEMM_F8
        { pg8::Gemm g{XB, (const bf16*)(ws + WS_WIN), T, INW, 1024}; pg8::SubsetOrder S; S.init(T, P1_BF16_TILES, F.G, (int)blockIdx.x);
          pg8::EpiInProj E{(bf16*)(ws + WS_AQ), (bf16*)(ws + WS_AK), (bf16*)(ws + WS_AV), (bf16*)(ws + WS_RQ), (bf16*)(ws + WS_RK), (bf16*)(ws + WS_RV), (bf16*)(ws + WS_RG), (bf16*)(ws + WS_MQ), (bf16*)(ws + WS_G), (const float*)(ws + WS_BIASP), 1.0f};
          pg8::gemm_phase<pg8::EpiInProj, pg8::SubsetOrder, true, true, false>(F.lds, g, S, E); }
        { pg8::Gemm g{(const bf16*)((const unsigned char*)args.out + (size_t)T * 2048), (const bf16*)(ws + WS_WIN8), T, INW, 1024}; pg8::SubsetOrder S; S.init(T, 0x7fffffu & ~P1_BF16_TILES, F.G, (int)blockIdx.x);
          pg8::EpiInProj E{(bf16*)(ws + WS_AQ), (bf16*)(ws + WS_AK), (bf16*)(ws + WS_AV), (bf16*)(ws + WS_RQ), (bf16*)(ws + WS_RK), (bf16*)(ws + WS_RV), (bf16*)(ws + WS_RG), (bf16*)(ws + WS_MQ), (bf16*)(ws + WS_G), (const float*)(ws + WS_BIASP), 1.0f / W8_SCALE};
          pg8::gemm_phase<pg8::EpiInProj, pg8::SubsetOrder, true, P1F8_SP2, true>(F.lds, g, S, E); }
#else
        { pg8::Gemm g{XB, (const bf16*)(ws + WS_WIN), T, INW, 1024}; pg8::StaticOrder S; S.init(T, INW, F.G, (int)blockIdx.x);
          pg8::EpiInProj E{(bf16*)(ws + WS_AQ), (bf16*)(ws + WS_AK), (bf16*)(ws + WS_AV), (bf16*)(ws + WS_RQ), (bf16*)(ws + WS_RK), (bf16*)(ws + WS_RV), (bf16*)(ws + WS_RG), (bf16*)(ws + WS_MQ), (bf16*)(ws + WS_G), (const float*)(ws + WS_BIASP), 1.0f};
          pg8::gemm_phase<pg8::EpiInProj, pg8::StaticOrder, P1_ALIGN, P1_SP2, false>(F.lds, g, S, E); }
#endif
        { pg8::Gemm g{(const bf16*)(ws + WS_MEMN), (const bf16*)(ws + WS_WMKV), 2048, 1024, 1024}; pg8::StaticOrder S; S.init(2048, 1024, F.G, (int)blockIdx.x);
          pg8::EpiMkv E{(bf16*)(ws + WS_MK), (bf16*)(ws + WS_MVT)};
          pg8::gemm_phase<pg8::EpiMkv, pg8::StaticOrder, true, true>(F.lds, g, S, E); }
        SEAM(1, r_);
    }
    FRAME_REFRESH();
    if (IN(2)) for (int r_ = 0; r_ < NREP(2); ++r_) {
        kvinc_phase(F);
        SEAM(2, r_);
    }
    FRAME_REFRESH();
    if (IN(3)) for (int r_ = 0; r_ < NREP(3); ++r_) { scan_phase(F); SEAM(3, r_); }
    FRAME_REFRESH();
    if (IN(4)) {
        const int m4 = (args.pad && !IN(9)) ? args.pad : 7;
        if (m4 & 1) swa_phase(F);
#ifdef EXP_RET
        if (m4 & 2) ret_phase(F, m4);
#else
        if (m4 & 2) ret_phase(F);
#endif
        if (m4 & 4) for (int u = blockIdx.x; u < NBATCH * 4 * 8; u += F.G) xattn_unit(F, u >> 5, (u >> 3) & 3, u & 7);
        if (BOTH(4)) GRID_BAR();
    }
    FRAME_REFRESH();
    if (IN(5)) for (int r_ = 0; r_ < NREP(5); ++r_) {
#ifdef P5_STAGGER
#ifdef P5_STAGGER4
        for (int i_ = 0; i_ < (int)((blockIdx.x >> 3) & 3) * P5_STAGGER; ++i_) __builtin_amdgcn_s_sleep(64);
#else
        if ((blockIdx.x >> 3) & 1) for (int i_ = 0; i_ < P5_STAGGER; ++i_) __builtin_amdgcn_s_sleep(127);
#endif
#endif
        pg8::StaticOrder3 S; S.init(T, 1024, F.G, (int)blockIdx.x);
        static_assert(WS_WBR - WS_WBA == WS_WBM - WS_WBR, "the three branch weights are equally spaced in d_ws");
#ifdef GEMM56_F8
        pg8::Gemm3 g{(const bf16*)F.out, (const bf16*)(ws + WS_WBA), (size_t)T * 256, (WS_WBR - WS_WBA) / 2, T, 1024, 512};
#ifdef P6_BF16
        pg8::EpiGate3 E{(bf16*)(ws + WS_MERGED), (const bf16*)(ws + WS_G), 0.f, 1.0f / (BR8_SCALE * W8_SCALE)};
#else
        pg8::EpiGate3 E{(bf16*)(ws + WS_MERGED), (const bf16*)(ws + WS_G), MG8_SCALE / (BR8_SCALE * W8_SCALE), 1.0f};
#endif
#ifdef EXP_P5MID
        E.skipmid = args.pad & 64;
#endif
        pg8::gemm_phase3<pg8::EpiGate3, pg8::StaticOrder3, P5_ALIGN, P5F8_SP2, true>(F.lds, g, S, E);
#else
        pg8::Gemm3 g{(const bf16*)F.out, (const bf16*)(ws + WS_WBA), (size_t)T * 512, (WS_WBR - WS_WBA) / 2, T, 1024, 512};
        pg8::EpiGate3 E{(bf16*)(ws + WS_MERGED), (const bf16*)(ws + WS_G), 0.f, 1.0f};
        pg8::gemm_phase3<pg8::EpiGate3, pg8::StaticOrder3, true, true>(F.lds, g, S, E);
#endif
        SEAM(5, r_);
    }
    FRAME_REFRESH();
    if (IN(6)) for (int r_ = 0; r_ < NREP(6); ++r_) {
        pg8::Gemm g{(const bf16*)(ws + WS_MERGED), (const bf16*)(ws + WS_WOUT), T, 1024, 1024}; pg8::RowOrder S; S.init(T, 1024, F.G, (int)blockIdx.x);
#if defined(GEMM56_F8) && !defined(P6_BF16)
        { pg8::EpiResid3 E3; E3.X = karg_in(0); E3.out = (bf16*)(ws + WS_HB); E3.alpha = ALPHA; E3.ascale = 1.0f / (MG8_SCALE * W8_SCALE);
          pg8::Gemm3 g3{(const bf16*)(ws + WS_MERGED), (const bf16*)(ws + WS_WOUT), 0, 0, T, 1024, 1024}; pg8::RowOrderSeg2 S3; S3.init(T, 1024, F.G, (int)blockIdx.x);
          pg8::gemm_phase3<pg8::EpiResid3, pg8::RowOrderSeg2, P6_ALIGN, P6_SP2, true>(F.lds, g3, S3, E3); }
#else
        pg8::EpiResid E{karg_in(0), (bf16*)(ws + WS_HB), ALPHA, 1.0f};
        pg8::gemm_phase<pg8::EpiResid, pg8::RowOrder, true, true>(F.lds, g, S, E);
#endif
        VM_WAIT(); __syncthreads();
        if (r_ + 1 < NREP(6)) GRID_BAR();
    }
    FRAME_REFRESH();
    if (IN(7)) for (int r_ = 0; r_ < NREP(7); ++r_) {
        for (int blk = blockIdx.x; blk < T / 256; blk += F.G)
            for (int st = 0; st < 8; ++st) {
                const size_t m0 = (size_t)blk * 256 + 32 * F.wave + 4 * st;
                f32x4 v[4][4];
#pragma unroll
                for (int q = 0; q < 4; ++q)
#pragma unroll
                    for (int j = 0; j < 4; ++j) {
                        const u64 a = ((const u64*)((const bf16*)(ws + WS_HB) + (m0 + q) * 1024))[F.lane + 64 * j];
                        v[q][j] = (f32x4){bflo((unsigned)a), bfhi((unsigned)a), bflo((unsigned)(a >> 32)), bfhi((unsigned)(a >> 32))};
                    }
#pragma unroll
                for (int q = 0; q < 4; ++q) { const size_t mm = m0 + q;
                    ln1_finish(v[q], karg_in(13), karg_in(14), (bf16*)(ws + WS_HB) + mm * 1024, ws + WS_H8 + mm * 1024, (float*)(ws + WS_HS) + mm, F.lane); }
            }
        VM_WAIT(); __syncthreads();
        if (r_ + 1 < NREP(7)) GRID_BAR();
    }
    FRAME_REFRESH();
    if (IN(8)) for (int r_ = 0; r_ < NREP(8); ++r_) {
        pg8::Gemm g{(const bf16*)(ws + WS_HB), (const bf16*)(ws + WS_WPQ), T, 2048, 1024}; pg8::RowOrder S; S.init(T, 2048, F.G, (int)blockIdx.x);
        pg8::EpiBf16<0> E{(bf16*)(ws + WS_PQ), 2048, nullptr, 0, 0, 1.f};
        pg8::gemm_phase<pg8::EpiBf16<0>, pg8::RowOrder, true, true>(F.lds, g, S, E);
        VM_WAIT(); __syncthreads();
        if (r_ + 1 < NREP(8)) GRID_BAR();
    }
    FRAME_REFRESH();
    if (IN(9)) for (int r_ = 0; r_ < NREP(9); ++r_) {
        if (!IN(8)) GRID_BAR();
        peer_phase(F, bar, (unsigned*)(ctl + CW_PACE), args.pad ? args.pad : PEER_MODE);
        SEAM(9, r_);
    }
#ifdef EXP_SAMETILE
    if (IN(10)) {
        pg8::Gemm g{(const bf16*)(ws + WS_HB), (const bf16*)(ws + WS_WPQ), T, 2048, 1024}; pg8::SameTileOrder S{8};
        pg8::EpiBf16<0> E{(bf16*)(ws + WS_PQ), 2048, nullptr, 0, 0, 1.f};
        pg8::gemm_phase<pg8::EpiBf16<0>, pg8::SameTileOrder, true, true>(F.lds, g, S, E);
    }
#endif
#undef IN
#undef BOTH
#undef GRID_BAR
}

extern "C" void kernel_launch(void* const* d_in, const int* in_sizes, int n_in, void* d_out, int out_size, void* d_ws, size_t ws_size, hipStream_t stream) {
    static int grid = 0;
    if (grid == 0) {
        if (n_in != 21 || out_size != T * D || ws_size < WS_END) { fprintf(stderr, "kernel_launch: unexpected problem (n_in %d, out %d, ws %zu); nothing launched\n", n_in, out_size, ws_size); grid = -1; return; }
        int dev = 0, cus = 0, per_cu = 0;
        if (hipGetDevice(&dev) != hipSuccess || hipDeviceGetAttribute(&cus, hipDeviceAttributeMultiprocessorCount, dev) != hipSuccess) { grid = -1; return; }
        if (hipFuncSetAttribute((const void*)mega_fwd, hipFuncAttributeMaxDynamicSharedMemorySize, LDS_BYTES) != hipSuccess) { fprintf(stderr, "kernel_launch: hipFuncSetAttribute failed\n"); grid = -1; return; }
        if (hipOccupancyMaxActiveBlocksPerMultiprocessor(&per_cu, (const void*)mega_fwd, NTHR, LDS_BYTES) != hipSuccess || per_cu < 1) { fprintf(stderr, "kernel_launch: occupancy query says %d blocks per CU\n", per_cu); per_cu = 1; }
        (void)hipGetLastError();
        grid = cus;
    }
    if (grid < 0) return;
    (void)hipMemsetAsync((char*)d_ws + WS_CTL, 0, CTL_ZERO_BYTES, stream);
    Args a{};
    for (int i = 0; i < 21; ++i) a.in[i] = (const float*)d_in[i];
    a.out = (float*)d_out; a.ws = (unsigned char*)d_ws;
#ifdef EXTRA_PHASE
    if (N_LAUNCHES == 1) {
#ifdef EXP_SAMETILE
        a.ph_lo = 0; a.ph_hi = N_PHASES; a.li = 0; hipLaunchKernelGGL(mega_fwd, dim3(grid), dim3(NTHR), LDS_BYTES, stream, a);
        a.ph_lo = 10; a.ph_hi = 11; a.li = 1; hipLaunchKernelGGL(mega_fwd, dim3(grid), dim3(NTHR), LDS_BYTES, stream, a);
#else
        a.ph_lo = 0; a.ph_hi = EXTRA_PHASE + 1; a.li = 0;
#ifdef EXTRA_PEER_MODE
        a.pad = EXTRA_PEER_MODE;
#endif
        hipLaunchKernelGGL(mega_fwd, dim3(grid), dim3(NTHR), LDS_BYTES, stream, a);
        a.pad = 0;
        a.ph_lo = EXTRA_PHASE; a.ph_hi = N_PHASES; a.li = 1;
        hipLaunchKernelGGL(mega_fwd, dim3(grid), dim3(NTHR), LDS_BYTES, stream, a);
#endif
    } else {
#else
    if (N_LAUNCHES == 1) {
        a.ph_lo = 0; a.ph_hi = N_PHASES; a.li = 0;
        hipLaunchKernelGGL(mega_fwd, dim3(grid), dim3(NTHR), LDS_BYTES, stream, a);
    } else {
#endif
        for (int li = 0; li < N_PHASES; ++li) { a.ph_lo = li; a.ph_hi = li + 1; a.li = 0; hipLaunchKernelGGL(mega_fwd, dim3(grid), dim3(NTHR), LDS_BYTES, stream, a); }
    }
}
```

```cpp
#include <hip/hip_runtime.h>
#include <cstdio>
#include <cstdint>
#include <cmath>
#ifndef PG8_WGM
#define PG8_WGM 8
#endif
namespace pg8 {
#define PG8_LAS __attribute__((address_space(3)))
typedef unsigned short bf16_t;
typedef short bf16x8 __attribute__((ext_vector_type(8)));
typedef float f32x4 __attribute__((ext_vector_type(4)));
typedef unsigned u32x4 __attribute__((ext_vector_type(4)));
constexpr int BM = 256, BK = 64, HALF = 128, HTB = HALF * BK * 2  , STAGE_BYTES = 8 * HTB, NXCD = 8, WGM = PG8_WGM;

__host__ __device__ __forceinline__ int lds_byte(int r, int c) { const int st = (r >> 4) * 2 + (c >> 5), rr = r & 15, cc = c & 31, ob = rr * 64 + cc * 2; return st * 1024 + (ob ^ (((ob >> 9) & 1) << 5)); }
__host__ __device__ __forceinline__ void stage_rc(int b, int& R, int& C) { const int st = b / 1024, sb = b % 1024, swz = sb ^ (((sb >> 9) & 1) << 5); R = (st >> 1) * 16 + swz / 64; C = (st & 1) * 32 + (swz % 64) / 2; }
__host__ __device__ __forceinline__ int perm32(int rho) { const int n = rho >> 4, i = rho & 15; return 8 * (i >> 2) + 4 * n + (i & 3); }

struct Unit { int pm, pn, seg; };
struct Gemm { const bf16_t* A; const bf16_t* Bt; int M, N, K; };

struct StaticOrder {
    int nM, nN, nwg, G, c;
    __host__ __device__ void init(int M, int N, int G_, int c_) { nM = M / BM; nN = N / BM; nwg = nM * nN; G = G_; c = c_; }
    __host__ __device__ bool next(int i, Unit& u) const {
        const long L = (long)i * G + c; if (L >= nwg) return false;
        int wgid = (int)L; { const int q = nwg / NXCD, r = nwg % NXCD, xcd = wgid % NXCD, off = wgid / NXCD; wgid = (xcd < r ? xcd * (q + 1) : r * (q + 1) + (xcd - r) * q) + off; }
        const int nig = WGM * nN, gid = wgid / nig, fm = gid * WGM, gsz = (nM - fm) < WGM ? (nM - fm) : WGM;
        u.pm = fm + ((wgid % nig) % gsz); u.pn = (wgid % nig) / gsz; return true;
    }
    __device__ __forceinline__ void a_ready(const Unit&) const {}
    __device__ __forceinline__ void done(const Unit&) const {}
};

__device__ __forceinline__ unsigned cvt_pk_bf16(float lo, float hi) { unsigned r; asm volatile("v_cvt_pk_bf16_f32 %0, %1, %2" : "=v"(r) : "v"(lo), "v"(hi)); return r; }
typedef float f32x2 __attribute__((ext_vector_type(2)));
__device__ __forceinline__ f32x2 gelu_pk(f32x2 v) {
    const f32x2 av = __builtin_elementwise_abs(v), d = av * 0.2316418882f + 1.0f;
    f32x2 t; t.x = __builtin_amdgcn_rcpf(d.x); t.y = __builtin_amdgcn_rcpf(d.y);
    f32x2 q = t * 0.5307027145f + (-0.7265760135f); q = q * t + 0.7107068705f; q = q * t + (-0.142248368f); q = q * t + 0.127414796f; q = q * t;
    const f32x2 s = (v * v) * (-0.72134752044f);
    f32x2 e; e.x = __builtin_amdgcn_exp2f(s.x); e.y = __builtin_amdgcn_exp2f(s.y);
    const f32x2 m = v * (q * e), r = v - m;
    f32x2 o; o.x = v.x < 0.f ? m.x : r.x; o.y = v.y < 0.f ? m.y : r.y; return o;
}

template <int ACT  > struct EpiBf16 {
    static constexpr bool PERM = true, AFTER_DRAIN = false; static_assert(ACT == 0 || ACT == 1, "EpiBf16: ACT is 0 (none) or 1 (gelu_pk)");
    bf16_t* O; int ldc; const float* bias; int split_cols; size_t split_stride; float scale0;
    __device__ __forceinline__ void operator()(const f32x4 (&acc)[2][2][4][2], const Unit& u, int wr, int wc, int fr, int fq) const {
        const int row0 = u.pm * BM + wr * 64 + fr; int colt = u.pn * BM; bf16_t* base = O;
        float sc = 1.f; if (split_cols) { const int t = colt / split_cols; base += (size_t)t * split_stride; colt -= t * split_cols; if (t == 0) sc = scale0; }
        const int col0 = colt + wc * 32 + 8 * fq, bcol0 = u.pn * BM + wc * 32 + 8 * fq;
        f32x4 bv[2][2];
#pragma unroll
        for (int bj = 0; bj < 2; ++bj)
#pragma unroll
            for (int n = 0; n < 2; ++n) bv[bj][n] = bias ? *(const f32x4*)(bias + bcol0 + bj * HALF + 4 * n) : (f32x4){0.f, 0.f, 0.f, 0.f};
#pragma unroll
        for (int ai = 0; ai < 2; ++ai)
#pragma unroll
            for (int m = 0; m < 4; ++m) { bf16_t* rowp = base + (size_t)(row0 + ai * HALF + m * 16) * ldc + col0;
#pragma unroll
                for (int bj = 0; bj < 2; ++bj) { f32x4 v0 = acc[ai][bj][m][0] + bv[bj][0], v1 = acc[ai][bj][m][1] + bv[bj][1];
                    if (ACT == 1) { f32x2 a = gelu_pk((f32x2){v0[0], v0[1]}), b = gelu_pk((f32x2){v0[2], v0[3]}), c = gelu_pk((f32x2){v1[0], v1[1]}), d = gelu_pk((f32x2){v1[2], v1[3]});
                        v0 = (f32x4){a.x, a.y, b.x, b.y}; v1 = (f32x4){c.x, c.y, d.x, d.y}; }
                    v0 = v0 * sc; v1 = v1 * sc; u32x4 w; w.x = cvt_pk_bf16(v0[0], v0[1]); w.y = cvt_pk_bf16(v0[2], v0[3]); w.z = cvt_pk_bf16(v1[0], v1[1]); w.w = cvt_pk_bf16(v1[2], v1[3]);
                    *(u32x4*)(rowp + bj * HALF) = w; } }
    }
};
typedef int v8i_t __attribute__((ext_vector_type(8))); typedef int v4i_t __attribute__((ext_vector_type(4)));
#ifdef F8_FRAG_CONTIG
__device__ __forceinline__ v8i_t pg8_ld8(const PG8_LAS unsigned char* p) { return *(const PG8_LAS v8i_t*)p; }
#else
__device__ __forceinline__ v8i_t pg8_ld8(const PG8_LAS unsigned char* p) { const v4i_t lo = *(const PG8_LAS v4i_t*)p, hi = *(const PG8_LAS v4i_t*)(p + 1024); return __builtin_shufflevector(lo, hi, 0, 1, 2, 3, 4, 5, 6, 7); }
#endif
__device__ __forceinline__ f32x4 mfma_f8_128(bf16x8 a0, bf16x8 a1, bf16x8 b0, bf16x8 b1, f32x4 c) {
    const v4i_t a0i = __builtin_bit_cast(v4i_t, a0), a1i = __builtin_bit_cast(v4i_t, a1), b0i = __builtin_bit_cast(v4i_t, b0), b1i = __builtin_bit_cast(v4i_t, b1);
    const v8i_t a = __builtin_shufflevector(a0i, a1i, 0, 1, 2, 3, 4, 5, 6, 7), b = __builtin_shufflevector(b0i, b1i, 0, 1, 2, 3, 4, 5, 6, 7);
    return __builtin_amdgcn_mfma_scale_f32_16x16x128_f8f6f4(a, b, c, 0, 0, 0, 0x7f7f7f7f, 0, 0x7f7f7f7f);
}
template <class Epi, class Sched, bool ALIGN_EPI = false, bool SP2 = false, bool F8 = false>
__device__ __forceinline__ void gemm_phase(PG8_LAS unsigned char* lds, const Gemm g, const Sched& S, const Epi& E) {
    int tid_ = threadIdx.x; asm volatile("" : "+v"(tid_));
    const int tid = tid_, wid = __builtin_amdgcn_readfirstlane(tid >> 6), lane = tid & 63, wr = wid >> 2, wc = wid & 3, fr = lane & 15, fq = lane >> 4;
    const int Kb = F8 ? g.K : 2 * g.K, nt = Kb / 128;
    unsigned voffA[2], voffB[2];
#pragma unroll
    for (int i = 0; i < 2; ++i) { int R, C; stage_rc(tid * 16 + i * 8192, R, C); const int Rb = Epi::PERM ? ((R & ~31) + perm32(R & 31)) : R;
        voffA[i] = (unsigned)(R * Kb + C * 2); voffB[i] = (unsigned)(Rb * Kb + C * 2); }
    const size_t kstep = (size_t)(BK * 2);
    const size_t hstep = (size_t)HALF * Kb;
    const size_t tstep = 2 * hstep;
    const unsigned ldsw = (unsigned)wid * 1024u;
#ifdef F8_FRAG_CONTIG
    const int aoff = lds_byte(wr * 64 + fr, F8 ? fq * 16 : fq * 8), boff = lds_byte(wc * 32 + fr, F8 ? fq * 16 : fq * 8);
    constexpr int KINC = F8 ? 16 : 1024;
#else
    const int aoff = lds_byte(wr * 64 + fr, fq * 8), boff = lds_byte(wc * 32 + fr, fq * 8);
    constexpr int KINC = 1024;
#endif
#define PG8_SA(b, h) (((b) * 2 + (h)) * HTB)
#define PG8_SB(b, h) ((4 + (b) * 2 + (h)) * HTB)
#define PG8_STAGE(bufoff, gbase, voff) do { _Pragma("unroll") for (int _i = 0; _i < 2; ++_i) \
        __builtin_amdgcn_global_load_lds((const unsigned*)((const char*)(gbase) + (size_t)_i * (size_t)(64 * Kb) + (voff)[0]), (PG8_LAS unsigned*)(lds + (bufoff) + ldsw + _i * 8192), 16, 0, 0); } while (0)
#define PG8_LDA(dst, b, h) do { if constexpr (F8) { _Pragma("unroll") for (int m = 0; m < 4; ++m) dst##8[m] = pg8_ld8(lds + PG8_SA(b, h) + aoff + m * 2048); } \
        else { _Pragma("unroll") for (int m = 0; m < 4; ++m) _Pragma("unroll") for (int k = 0; k < 2; ++k) dst[m][k] = *(const PG8_LAS bf16x8*)(lds + PG8_SA(b, h) + aoff + m * 2048 + k * KINC); } } while (0)
#define PG8_LDB(dst, b, h) do { if constexpr (F8) { _Pragma("unroll") for (int n = 0; n < 2; ++n) dst##8[n] = pg8_ld8(lds + PG8_SB(b, h) + boff + n * 2048); } \
        else { _Pragma("unroll") for (int n = 0; n < 2; ++n) _Pragma("unroll") for (int k = 0; k < 2; ++k) dst[n][k] = *(const PG8_LAS bf16x8*)(lds + PG8_SB(b, h) + boff + n * 2048 + k * KINC); } } while (0)
#define PG8_MMA(ai, bj, At, Bt) do { __builtin_amdgcn_s_setprio(1); _Pragma("unroll") for (int m = 0; m < 4; ++m) _Pragma("unroll") for (int n = 0; n < 2; ++n) { \
        if constexpr (F8) acc[ai][bj][m][n] = __builtin_amdgcn_mfma_scale_f32_16x16x128_f8f6f4(Bt##8[n], At##8[m], acc[ai][bj][m][n], 0, 0, 0, 0x7f7f7f7f, 0, 0x7f7f7f7f); \
        else { _Pragma("unroll") for (int k = 0; k < 2; ++k) acc[ai][bj][m][n] = __builtin_amdgcn_mfma_f32_16x16x32_bf16(Bt[n][k], At[m][k], acc[ai][bj][m][n], 0, 0, 0); } } \
        __builtin_amdgcn_s_setprio(0); } while (0)
#define PG8_WAIT_V(n) asm volatile("s_waitcnt vmcnt(" #n ")" ::: "memory")
#define PG8_WAIT_L(n) asm volatile("s_waitcnt lgkmcnt(" #n ")" ::: "memory")
#define PG8_BAR __builtin_amdgcn_s_barrier()
#define PG8_SCHED __builtin_amdgcn_sched_barrier(0)
    Unit cur, nxt; int ui = 0;
    if (!S.next(0, cur)) return;
    f32x4 acc[2][2][4][2];
#pragma unroll
    for (int a = 0; a < 2; ++a)
#pragma unroll
        for (int b = 0; b < 2; ++b)
#pragma unroll
            for (int m = 0; m < 4; ++m)
#pragma unroll
                for (int n = 0; n < 2; ++n) acc[a][b][m][n] = (f32x4){0.f, 0.f, 0.f, 0.f};
    bf16x8 At[4][2], B0[2][2], B1[2][2];
    v8i_t At8[4], B08[2], B18[2];
    const char* cA = (const char*)g.A + (size_t)cur.pm * tstep; const char* cB = (const char*)g.Bt + (size_t)cur.pn * tstep;
    S.a_ready(cur);
    if constexpr (SP2) {
        PG8_STAGE(PG8_SB(0, 0), cB, voffB); PG8_STAGE(PG8_SB(0, 1), cB + hstep, voffB); PG8_STAGE(PG8_SA(0, 0), cA, voffA); PG8_STAGE(PG8_SA(0, 1), cA + hstep, voffA);
        if (wr == 1) PG8_BAR;
        PG8_WAIT_V(2); PG8_BAR;
        PG8_STAGE(PG8_SB(1, 0), cB + kstep, voffB); PG8_STAGE(PG8_SA(1, 0), cA + kstep, voffA); PG8_STAGE(PG8_SB(1, 1), cB + hstep + kstep, voffB);
        PG8_WAIT_V(6); PG8_BAR;
    } else {
        PG8_STAGE(PG8_SB(0, 0), cB, voffB); PG8_STAGE(PG8_SA(0, 0), cA, voffA); PG8_STAGE(PG8_SB(0, 1), cB + hstep, voffB); PG8_STAGE(PG8_SA(0, 1), cA + hstep, voffA);
        if (wr == 1) PG8_BAR;
        PG8_WAIT_V(4); PG8_BAR;
        PG8_STAGE(PG8_SB(1, 0), cB + kstep, voffB); PG8_STAGE(PG8_SA(1, 0), cA + kstep, voffA); PG8_STAGE(PG8_SB(1, 1), cB + hstep + kstep, voffB);
        PG8_WAIT_V(6); PG8_BAR;
    }
    for (;;) {
        const bool has_next = S.next(ui + 1, nxt);
        const char* nA = has_next ? (const char*)g.A + (size_t)nxt.pm * tstep : cA; const char* nB = has_next ? (const char*)g.Bt + (size_t)nxt.pn * tstep : cB;
#pragma unroll 1
        for (int t = 0; t < nt; t += 2) {
            const bool last = (t == nt - 2);
            const char* a1 = cA + (size_t)(t + 1) * kstep;
            const char* a2 = last ? nA : cA + (size_t)(t + 2) * kstep; const char* b2 = last ? nB : cB + (size_t)(t + 2) * kstep;
            const char* a3 = a2 + kstep; const char* b3 = b2 + kstep;
            if (last && has_next) S.a_ready(nxt);
            if constexpr (SP2) {
            PG8_LDB(B0, 0, 0); PG8_LDB(B1, 0, 1); PG8_SCHED; PG8_LDA(At, 0, 0); PG8_STAGE(PG8_SA(1, 1), a1 + hstep, voffA);
            PG8_WAIT_V(8); PG8_WAIT_L(0); PG8_BAR; PG8_MMA(0, 0, At, B0); PG8_MMA(0, 1, At, B1); PG8_BAR; PG8_SCHED;
            PG8_LDA(At, 0, 1); PG8_STAGE(PG8_SB(0, 0), b2, voffB); PG8_STAGE(PG8_SB(0, 1), b2 + hstep, voffB); PG8_STAGE(PG8_SA(0, 0), a2, voffA);
            PG8_WAIT_V(8); PG8_WAIT_L(0); PG8_BAR; PG8_MMA(1, 0, At, B0); PG8_MMA(1, 1, At, B1); PG8_BAR; PG8_SCHED;
            PG8_LDB(B0, 1, 0); PG8_LDB(B1, 1, 1); PG8_SCHED; PG8_LDA(At, 1, 0); PG8_STAGE(PG8_SA(0, 1), a2 + hstep, voffA);
            PG8_WAIT_V(8); PG8_WAIT_L(0); PG8_BAR; PG8_MMA(0, 0, At, B0); PG8_MMA(0, 1, At, B1); PG8_BAR; PG8_SCHED;
            PG8_LDA(At, 1, 1); PG8_STAGE(PG8_SB(1, 0), b3, voffB); PG8_STAGE(PG8_SB(1, 1), b3 + hstep, voffB); PG8_STAGE(PG8_SA(1, 0), a3, voffA);
            PG8_WAIT_V(8); PG8_WAIT_L(0); PG8_BAR; PG8_MMA(1, 0, At, B0); PG8_MMA(1, 1, At, B1); PG8_BAR; PG8_SCHED;
            } else {
            PG8_LDB(B0, 0, 0); PG8_SCHED; PG8_LDA(At, 0, 0); PG8_STAGE(PG8_SA(1, 1), a1 + hstep, voffA);
            PG8_WAIT_L(8); PG8_BAR; PG8_WAIT_L(0); PG8_MMA(0, 0, At, B0); PG8_BAR; PG8_SCHED;
            PG8_LDB(B1, 0, 1); PG8_STAGE(PG8_SB(0, 0), b2, voffB);
            PG8_BAR; PG8_WAIT_L(0); PG8_MMA(0, 1, At, B1); PG8_BAR;
            PG8_LDA(At, 0, 1); PG8_STAGE(PG8_SA(0, 0), a2, voffA);
            PG8_BAR; PG8_WAIT_L(0); PG8_MMA(1, 0, At, B0); PG8_BAR; PG8_SCHED;
            PG8_STAGE(PG8_SB(0, 1), b2 + hstep, voffB);
            PG8_WAIT_V(6); PG8_BAR; PG8_MMA(1, 1, At, B1); PG8_BAR;
            PG8_LDB(B0, 1, 0); PG8_SCHED; PG8_LDA(At, 1, 0); PG8_STAGE(PG8_SA(0, 1), a2 + hstep, voffA);
            PG8_WAIT_L(8); PG8_BAR; PG8_WAIT_L(0); PG8_MMA(0, 0, At, B0); PG8_BAR; PG8_SCHED;
            PG8_LDB(B1, 1, 1); PG8_STAGE(PG8_SB(1, 0), b3, voffB);
            PG8_BAR; PG8_WAIT_L(0); PG8_MMA(0, 1, At, B1); PG8_BAR;
            PG8_LDA(At, 1, 1); PG8_STAGE(PG8_SA(1, 0), a3, voffA);
            PG8_BAR; PG8_WAIT_L(0); PG8_MMA(1, 0, At, B0); PG8_BAR; PG8_SCHED;
            PG8_STAGE(PG8_SB(1, 1), b3 + hstep, voffB);
            PG8_WAIT_V(6); PG8_BAR; PG8_MMA(1, 1, At, B1); PG8_BAR;
            }
        }
        if constexpr (ALIGN_EPI) { if (wr == 0) PG8_BAR; }
        if constexpr (!Epi::AFTER_DRAIN) { int t2_ = threadIdx.x; asm volatile("" : "+v"(t2_)); const int fr_ = t2_ & 15, fq_ = (t2_ >> 4) & 3;
            E(acc, cur, wr, wc, fr_, fq_); S.done(cur); }
        if (!has_next) break;
#pragma unroll
        for (int a = 0; a < 2; ++a)
#pragma unroll
            for (int b = 0; b < 2; ++b)
#pragma unroll
                for (int m = 0; m < 4; ++m)
#pragma unroll
                    for (int n = 0; n < 2; ++n) acc[a][b][m][n] = (f32x4){0.f, 0.f, 0.f, 0.f};
        cur = nxt; cA = nA; cB = nB; ++ui;
        if constexpr (ALIGN_EPI) { if (wr == 1) PG8_BAR; }
    }
    PG8_WAIT_V(0);
    if constexpr (!ALIGN_EPI) { if (wr == 0) PG8_BAR; }
    PG8_BAR;
    if constexpr (Epi::AFTER_DRAIN) { E.fused(acc, cur, wr, wc, fr, fq, lds, wid, lane); S.done(cur); }
#undef PG8_SA
#undef PG8_SB
#undef PG8_STAGE
#undef PG8_LDA
#undef PG8_LDB
#undef PG8_MMA
#undef PG8_WAIT_V
#undef PG8_WAIT_L
#undef PG8_BAR
#undef PG8_SCHED
}
struct Gemm3 { const bf16_t* A0; const bf16_t* B0; size_t strideA, strideB; int M, N, K;
    __device__ __forceinline__ const bf16_t* selA(int s) const { return A0 + (size_t)s * strideA; }
    __device__ __forceinline__ const bf16_t* selB(int s) const { return B0 + (size_t)s * strideB; } };
struct RowOrder { int nM, nN, G, c;
    __host__ __device__ void init(int M, int N, int G_, int c_) { nM = M / BM; nN = N / BM; G = G_; c = c_; }
#ifndef EXP_ROWREP
#define EXP_ROWREP 1
#endif
    __host__ __device__ bool next(int i0, Unit& u) const { const int i = i0 / EXP_ROWREP; const int pm = c + (i / nN) * G; if (pm >= nM) return false; u.pm = pm; u.pn = i % nN; u.seg = 0; return true; }
    __device__ __forceinline__ void a_ready(const Unit&) const {}
    __device__ __forceinline__ void done(const Unit&) const {} };
struct SubsetOrder { StaticOrder base; unsigned mask;
    __host__ __device__ void init(int M, unsigned mask_, int G_, int c_) { mask = mask_; base.init(M, __builtin_popcount(mask_) * BM, G_, c_); }
    __host__ __device__ bool next(int i, Unit& u) const { if (!base.next(i, u)) return false; unsigned m = mask; for (int j = 0; j < u.pn; ++j) m &= m - 1u; u.pn = __builtin_ctz(m); u.seg = 0; return true; }
    __device__ __forceinline__ void a_ready(const Unit&) const {}
    __device__ __forceinline__ void done(const Unit&) const {} };
struct RowOrderSeg2 { RowOrder base;
    __host__ __device__ void init(int M, int N, int G_, int c_) { base.init(M, N, G_, c_); }
    __host__ __device__ bool next(int i, Unit& u) const { const bool ok = base.next(i, u); u.seg = 2; return ok; } };
struct SameTileOrder { int n;
    __host__ __device__ bool next(int i, Unit& u) const { if (i >= n) return false; u.pm = 0; u.pn = 0; u.seg = 0; return true; }
    __device__ __forceinline__ void a_ready(const Unit&) const {}
    __device__ __forceinline__ void done(const Unit&) const {} };
struct StaticOrder3 { StaticOrder base;
    __host__ __device__ void init(int M, int N, int G_, int c_) { base.init(M, N, G_, c_); }
    __host__ __device__ bool next(int i, Unit& u) const { const bool ok = base.next(i / 3, u); u.seg = i % 3; return ok; } };
template <class Epi, class Sched, bool ALIGN_EPI = false, bool SP2 = false, bool F8 = false>
__device__ __forceinline__ void gemm_phase3(PG8_LAS unsigned char* lds, const Gemm3 g, const Sched& S, const Epi& E) {
    int tid_ = threadIdx.x; asm volatile("" : "+v"(tid_));
    const int tid = tid_, wid = __builtin_amdgcn_readfirstlane(tid >> 6), lane = tid & 63, wr = wid >> 2, wc = wid & 3, fr = lane & 15, fq = lane >> 4;
    const int Kb = F8 ? g.K : 2 * g.K, nt = Kb / 128;
    unsigned voffA[2], voffB[2];
#pragma unroll
    for (int i = 0; i < 2; ++i) { int R, C; stage_rc(tid * 16 + i * 8192, R, C); const int Rb = Epi::PERM ? ((R & ~31) + perm32(R & 31)) : R;
        voffA[i] = (unsigned)(R * Kb + C * 2); voffB[i] = (unsigned)(Rb * Kb + C * 2); }
    const size_t kstep = (size_t)(BK * 2);
    const size_t hstep = (size_t)HALF * Kb;
    const size_t tstep = 2 * hstep;
    const unsigned ldsw = (unsigned)wid * 1024u;
#ifdef F8_FRAG_CONTIG
    const int aoff = lds_byte(wr * 64 + fr, F8 ? fq * 16 : fq * 8), boff = lds_byte(wc * 32 + fr, F8 ? fq * 16 : fq * 8);
    constexpr int KINC = F8 ? 16 : 1024;
#else
    const int aoff = lds_byte(wr * 64 + fr, fq * 8), boff = lds_byte(wc * 32 + fr, fq * 8);
    constexpr int KINC = 1024;
#endif
#define PG8_SA(b, h) (((b) * 2 + (h)) * HTB)
#define PG8_SB(b, h) ((4 + (b) * 2 + (h)) * HTB)
#define PG8_STAGE(bufoff, gbase, voff) do { _Pragma("unroll") for (int _i = 0; _i < 2; ++_i) \
        __builtin_amdgcn_global_load_lds((const unsigned*)((const char*)(gbase) + (size_t)_i * (size_t)(64 * Kb) + (voff)[0]), (PG8_LAS unsigned*)(lds + (bufoff) + ldsw + _i * 8192), 16, 0, 0); } while (0)
#define PG8_LDA(dst, b, h) do { if constexpr (F8) { _Pragma("unroll") for (int m = 0; m < 4; ++m) dst##8[m] = pg8_ld8(lds + PG8_SA(b, h) + aoff + m * 2048); } \
        else { _Pragma("unroll") for (int m = 0; m < 4; ++m) _Pragma("unroll") for (int k = 0; k < 2; ++k) dst[m][k] = *(const PG8_LAS bf16x8*)(lds + PG8_SA(b, h) + aoff + m * 2048 + k * KINC); } } while (0)
#define PG8_LDB(dst, b, h) do { if constexpr (F8) { _Pragma("unroll") for (int n = 0; n < 2; ++n) dst##8[n] = pg8_ld8(lds + PG8_SB(b, h) + boff + n * 2048); } \
        else { _Pragma("unroll") for (int n = 0; n < 2; ++n) _Pragma("unroll") for (int k = 0; k < 2; ++k) dst[n][k] = *(const PG8_LAS bf16x8*)(lds + PG8_SB(b, h) + boff + n * 2048 + k * KINC); } } while (0)
#define PG8_MMA(ai, bj, At, Bt) do { __builtin_amdgcn_s_setprio(1); _Pragma("unroll") for (int m = 0; m < 4; ++m) _Pragma("unroll") for (int n = 0; n < 2; ++n) { \
        if constexpr (F8) acc[ai][bj][m][n] = __builtin_amdgcn_mfma_scale_f32_16x16x128_f8f6f4(Bt##8[n], At##8[m], acc[ai][bj][m][n], 0, 0, 0, 0x7f7f7f7f, 0, 0x7f7f7f7f); \
        else { _Pragma("unroll") for (int k = 0; k < 2; ++k) acc[ai][bj][m][n] = __builtin_amdgcn_mfma_f32_16x16x32_bf16(Bt[n][k], At[m][k], acc[ai][bj][m][n], 0, 0, 0); } } \
        __builtin_amdgcn_s_setprio(0); } while (0)
#define PG8_WAIT_V(n) asm volatile("s_waitcnt vmcnt(" #n ")" ::: "memory")
#define PG8_WAIT_L(n) asm volatile("s_waitcnt lgkmcnt(" #n ")" ::: "memory")
#define PG8_BAR __builtin_amdgcn_s_barrier()
#define PG8_SCHED __builtin_amdgcn_sched_barrier(0)
    Unit cur, nxt; int ui = 0;
    if (!S.next(0, cur)) return;
    f32x4 acc[2][2][4][2];
#pragma unroll
    for (int a = 0; a < 2; ++a)
#pragma unroll
        for (int b = 0; b < 2; ++b)
#pragma unroll
            for (int m = 0; m < 4; ++m)
#pragma unroll
                for (int n = 0; n < 2; ++n) acc[a][b][m][n] = (f32x4){0.f, 0.f, 0.f, 0.f};
    bf16x8 At[4][2], B0[2][2], B1[2][2];
    v8i_t At8[4], B08[2], B18[2];
    const char* cA = (const char*)g.selA(cur.seg) + (size_t)cur.pm * tstep; const char* cB = (const char*)g.selB(cur.seg) + (size_t)cur.pn * tstep;
    if constexpr (SP2) {
        PG8_STAGE(PG8_SB(0, 0), cB, voffB); PG8_STAGE(PG8_SB(0, 1), cB + hstep, voffB); PG8_STAGE(PG8_SA(0, 0), cA, voffA); PG8_STAGE(PG8_SA(0, 1), cA + hstep, voffA);
        if (wr == 1) PG8_BAR;
        PG8_WAIT_V(2); PG8_BAR;
        PG8_STAGE(PG8_SB(1, 0), cB + kstep, voffB); PG8_STAGE(PG8_SA(1, 0), cA + kstep, voffA); PG8_STAGE(PG8_SB(1, 1), cB + hstep + kstep, voffB);
        PG8_WAIT_V(6); PG8_BAR;
    } else {
        PG8_STAGE(PG8_SB(0, 0), cB, voffB); PG8_STAGE(PG8_SA(0, 0), cA, voffA); PG8_STAGE(PG8_SB(0, 1), cB + hstep, voffB); PG8_STAGE(PG8_SA(0, 1), cA + hstep, voffA);
        if (wr == 1) PG8_BAR;
        PG8_WAIT_V(4); PG8_BAR;
        PG8_STAGE(PG8_SB(1, 0), cB + kstep, voffB); PG8_STAGE(PG8_SA(1, 0), cA + kstep, voffA); PG8_STAGE(PG8_SB(1, 1), cB + hstep + kstep, voffB);
        PG8_WAIT_V(6); PG8_BAR;
    }
    for (;;) {
        const bool has_next = S.next(ui + 1, nxt);
        const char* nA = has_next ? (const char*)g.selA(nxt.seg) + (size_t)nxt.pm * tstep : cA; const char* nB = has_next ? (const char*)g.selB(nxt.seg) + (size_t)nxt.pn * tstep : cB;
#pragma unroll 1
        for (int t = 0; t < nt; t += 2) {
            const bool last = (t == nt - 2);
            const char* a1 = cA + (size_t)(t + 1) * kstep;
            const char* a2 = last ? nA : cA + (size_t)(t + 2) * kstep; const char* b2 = last ? nB : cB + (size_t)(t + 2) * kstep;
            const char* a3 = a2 + kstep; const char* b3 = b2 + kstep;
            if constexpr (SP2) {
            PG8_LDB(B0, 0, 0); PG8_LDB(B1, 0, 1); PG8_SCHED; PG8_LDA(At, 0, 0); PG8_STAGE(PG8_SA(1, 1), a1 + hstep, voffA);
            PG8_WAIT_V(8); PG8_WAIT_L(0); PG8_BAR; PG8_MMA(0, 0, At, B0); PG8_MMA(0, 1, At, B1); PG8_BAR; PG8_SCHED;
            PG8_LDA(At, 0, 1); PG8_STAGE(PG8_SB(0, 0), b2, voffB); PG8_STAGE(PG8_SB(0, 1), b2 + hstep, voffB); PG8_STAGE(PG8_SA(0, 0), a2, voffA);
            PG8_WAIT_V(8); PG8_WAIT_L(0); PG8_BAR; PG8_MMA(1, 0, At, B0); PG8_MMA(1, 1, At, B1); PG8_BAR; PG8_SCHED;
            PG8_LDB(B0, 1, 0); PG8_LDB(B1, 1, 1); PG8_SCHED; PG8_LDA(At, 1, 0); PG8_STAGE(PG8_SA(0, 1), a2 + hstep, voffA);
            PG8_WAIT_V(8); PG8_WAIT_L(0); PG8_BAR; PG8_MMA(0, 0, At, B0); PG8_MMA(0, 1, At, B1); PG8_BAR; PG8_SCHED;
            PG8_LDA(At, 1, 1); PG8_STAGE(PG8_SB(1, 0), b3, voffB); PG8_STAGE(PG8_SB(1, 1), b3 + hstep, voffB); PG8_STAGE(PG8_SA(1, 0), a3, voffA);
            PG8_WAIT_V(8); PG8_WAIT_L(0); PG8_BAR; PG8_MMA(1, 0, At, B0); PG8_MMA(1, 1, At, B1); PG8_BAR; PG8_SCHED;
            } else {
            PG8_LDB(B0, 0, 0); PG8_SCHED; PG8_LDA(At, 0, 0); PG8_STAGE(PG8_SA(1, 1), a1 + hstep, voffA);
            PG8_WAIT_L(8); PG8_BAR; PG8_WAIT_L(0); PG8_MMA(0, 0, At, B0); PG8_BAR; PG8_SCHED;
            PG8_LDB(B1, 0, 1); PG8_STAGE(PG8_SB(0, 0), b2, voffB);
            PG8_BAR; PG8_WAIT_L(0); PG8_MMA(0, 1, At, B1); PG8_BAR;
            PG8_LDA(At, 0, 1); PG8_STAGE(PG8_SA(0, 0), a2, voffA);
            PG8_BAR; PG8_WAIT_L(0); PG8_MMA(1, 0, At, B0); PG8_BAR; PG8_SCHED;
            PG8_STAGE(PG8_SB(0, 1), b2 + hstep, voffB);
            PG8_WAIT_V(6); PG8_BAR; PG8_MMA(1, 1, At, B1); PG8_BAR;
            PG8_LDB(B0, 1, 0); PG8_SCHED; PG8_LDA(At, 1, 0); PG8_STAGE(PG8_SA(0, 1), a2 + hstep, voffA);
            PG8_WAIT_L(8); PG8_BAR; PG8_WAIT_L(0); PG8_MMA(0, 0, At, B0); PG8_BAR; PG8_SCHED;
            PG8_LDB(B1, 1, 1); PG8_STAGE(PG8_SB(1, 0), b3, voffB);
            PG8_BAR; PG8_WAIT_L(0); PG8_MMA(0, 1, At, B1); PG8_BAR;
            PG8_LDA(At, 1, 1); PG8_STAGE(PG8_SA(1, 0), a3, voffA);
            PG8_BAR; PG8_WAIT_L(0); PG8_MMA(1, 0, At, B0); PG8_BAR; PG8_SCHED;
            PG8_STAGE(PG8_SB(1, 1), b3 + hstep, voffB);
            PG8_WAIT_V(6); PG8_BAR; PG8_MMA(1, 1, At, B1); PG8_BAR;
            }
        }
        if constexpr (ALIGN_EPI) { if (wr == 0) PG8_BAR; }
        { int t2_ = threadIdx.x; asm volatile("" : "+v"(t2_)); const int fr_ = t2_ & 15, fq_ = (t2_ >> 4) & 3;
          if (cur.seg < 2) E.mid(acc, cur, wr, wc, fr_, fq_); else E(acc, cur, wr, wc, fr_, fq_); }
        if (!has_next) break;
        if (cur.seg == 2) {
#pragma unroll
        for (int a = 0; a < 2; ++a)
#pragma unroll
            for (int b = 0; b < 2; ++b)
#pragma unroll
                for (int m = 0; m < 4; ++m)
#pragma unroll
                    for (int n = 0; n < 2; ++n) acc[a][b][m][n] = (f32x4){0.f, 0.f, 0.f, 0.f};
        }
        cur = nxt; cA = nA; cB = nB; ++ui;
        if constexpr (ALIGN_EPI) { if (wr == 1) PG8_BAR; }
    }
    PG8_WAIT_V(0);
    if constexpr (!ALIGN_EPI) { if (wr == 0) PG8_BAR; }
    PG8_BAR;
#undef PG8_SA
#undef PG8_SB
#undef PG8_STAGE
#undef PG8_LDA
#undef PG8_LDB
#undef PG8_MMA
#undef PG8_WAIT_V
#undef PG8_WAIT_L
#undef PG8_BAR
#undef PG8_SCHED
}
}
namespace pg8 {
__device__ __forceinline__ float bf_lo(unsigned u) { return __uint_as_float(u << 16); }
__device__ __forceinline__ float bf_hi(unsigned u) { return __uint_as_float(u & 0xffff0000u); }
__device__ __forceinline__ float sigmoidf_(float x) { return 1.0f / (1.0f + __expf(-x)); }
__device__ const float ROTC[32] = {1.591549431e-01f, 1.182463853e-01f, 8.785280159e-02f, 6.527146455e-02f, 4.849434518e-02f, 3.602955028e-02f, 2.676865702e-02f, 1.988814718e-02f, 1.477617640e-02f, 1.097816640e-02f, 8.156381877e-03f, 6.059897703e-03f, 4.502285539e-03f, 3.345035851e-03f, 2.485241052e-03f, 1.846444510e-03f, 1.371841708e-03f, 1.019228935e-03f, 7.572503565e-04f, 5.626097166e-04f, 4.179987378e-04f, 3.105579936e-04f, 2.307333939e-04f, 1.714265939e-04f, 1.273637795e-04f, 9.462669678e-05f, 7.030422448e-05f, 5.223350438e-05f, 3.880761077e-05f, 2.883265582e-05f, 2.142162388e-05f, 1.591549431e-05f};

struct EpiInProj {
    static constexpr bool PERM = true, AFTER_DRAIN = false;
    bf16_t *AQ, *AK, *AV, *RQ, *RK, *RV, *RG, *MQ, *G; const float* biasp; float ascale;
    __device__ __forceinline__ void operator()(const f32x4 (&acc)[2][2][4][2], const Unit& u, int wr, int wc, int fr, int fq) const {
        const int pn = u.pn, row0 = u.pm * BM + wr * 64 + fr, cw = wc * 32 + 8 * fq;
#pragma unroll
        for (int bj = 0; bj < 2; ++bj) {
            const int ct = bj * HALF + cw;
            bf16_t* base; int ld, col, mode;
            if (pn < 2)       { base = AQ; ld = 512; col = pn * 256 + ct; mode = 0; }
            else if (pn == 2) { base = bj == 0 ? AK : AV; ld = 128; col = cw; mode = 0; }
            else if (pn == 3) { base = RQ; ld = 256; col = ct; mode = 1; }
            else if (pn == 4) { base = RK; ld = 256; col = ct; mode = 2; }
            else if (pn < 7)  { base = RV; ld = 512; col = (pn - 5) * 256 + ct; mode = 0; }
            else if (pn < 9)  { base = RG; ld = 512; col = (pn - 7) * 256 + ct; mode = 3; }
            else if (pn < 11) { base = MQ; ld = 512; col = (pn - 9) * 256 + ct; mode = 0; }
            else              { base = G; ld = 3072; col = (pn - 11) * 256 + ct; mode = 4; }
            const f32x4 b0 = *(const f32x4*)(biasp + pn * 256 + ct), b1 = *(const f32x4*)(biasp + pn * 256 + ct + 4);
            f32x4 rc = (f32x4){0.f, 0.f, 0.f, 0.f};
            if (mode == 1 || mode == 2) rc = *(const f32x4*)(ROTC + 4 * (4 * (wc & 1) + fq));
#pragma unroll
            for (int ai = 0; ai < 2; ++ai)
#pragma unroll
                for (int m = 0; m < 4; ++m) {
                    const int row = row0 + ai * HALF + m * 16;
                    f32x4 v0 = acc[ai][bj][m][0] * ascale + b0, v1 = acc[ai][bj][m][1] * ascale + b1;
                    if (mode == 1 || mode == 2) {
                        const float pos = (float)(row & 8191), sc = (mode == 2) ? 0.125f : 1.0f;
                        f32x4 o0, o1;
#pragma unroll
                        for (int e = 0; e < 4; ++e) {
                            float rev = pos * rc[e]; rev = rev - floorf(rev);
                            const float sn = __builtin_amdgcn_sinf(rev) * sc, cs = __builtin_amdgcn_cosf(rev) * sc;
                            o0[e] = v0[e] * cs - v1[e] * sn; o1[e] = v0[e] * sn + v1[e] * cs;
                        }
                        v0 = o0; v1 = o1;
                    } else if (mode == 3) {
#pragma unroll
                        for (int e = 0; e < 4; ++e) { v0[e] = v0[e] * sigmoidf_(v0[e]); v1[e] = v1[e] * sigmoidf_(v1[e]); }
                    } else if (mode == 4) {
#pragma unroll
                        for (int e = 0; e < 4; ++e) { v0[e] = fmaxf(sigmoidf_(v0[e]), 1e-30f); v1[e] = fmaxf(sigmoidf_(v1[e]), 1e-30f); }
                    }
                    u32x4 w; w.x = cvt_pk_bf16(v0[0], v0[1]); w.y = cvt_pk_bf16(v0[2], v0[3]); w.z = cvt_pk_bf16(v1[0], v1[1]); w.w = cvt_pk_bf16(v1[2], v1[3]);
                    *(u32x4*)(base + (size_t)row * ld + col) = w;
                }
        }
    }
};

struct EpiMkv {
    static constexpr bool PERM = true, AFTER_DRAIN = false;
    bf16_t *MK, *MVT;
    __device__ __forceinline__ void operator()(const f32x4 (&acc)[2][2][4][2], const Unit& u, int wr, int wc, int fr, int fq) const {
        const int row0 = u.pm * BM + wr * 64 + fr;
#pragma unroll
        for (int bj = 0; bj < 2; ++bj) {
            const int c0 = u.pn * 256 + bj * HALF + wc * 32 + 8 * fq;
#pragma unroll
            for (int ai = 0; ai < 2; ++ai)
#pragma unroll
                for (int m = 0; m < 4; ++m) {
                    const int row = row0 + ai * HALF + m * 16;
                    const f32x4 v0 = acc[ai][bj][m][0], v1 = acc[ai][bj][m][1];
                    if (u.pn < 2) {
                        u32x4 w; w.x = cvt_pk_bf16(v0[0], v0[1]); w.y = cvt_pk_bf16(v0[2], v0[3]); w.z = cvt_pk_bf16(v1[0], v1[1]); w.w = cvt_pk_bf16(v1[2], v1[3]);
                        *(u32x4*)(MK + (size_t)row * 512 + c0) = w;
                    } else {
                        const int c = c0 - 512, h = c >> 7, d = c & 127, b = row >> 8, mm = row & 255;
                        bf16_t* p = MVT + ((size_t)((b * 4 + h) * 128 + d)) * 256 + mm;
#pragma unroll
                        for (int e = 0; e < 4; ++e) { p[(size_t)e * 256] = (bf16_t)(cvt_pk_bf16(v0[e], 0.f) & 0xffffu); p[(size_t)(e + 4) * 256] = (bf16_t)(cvt_pk_bf16(v1[e], 0.f) & 0xffffu); }
                    }
                }
        }
    }
};

struct EpiGate {
    static constexpr bool PERM = true, AFTER_DRAIN = false;
    bf16_t* Mg; const bf16_t* G; int goff; int first;
    __device__ __forceinline__ void operator()(const f32x4 (&acc)[2][2][4][2], const Unit& u, int wr, int wc, int fr, int fq) const {
        const int row0 = u.pm * BM + wr * 64 + fr, col0 = u.pn * BM + wc * 32 + 8 * fq;
#pragma unroll
        for (int ai = 0; ai < 2; ++ai)
#pragma unroll
            for (int m = 0; m < 4; ++m) {
                const int row = row0 + ai * HALF + m * 16;
#pragma unroll
                for (int bj = 0; bj < 2; ++bj) {
                    const int col = col0 + bj * HALF;
                    const u32x4 g = *(const u32x4*)(G + (size_t)row * 3072 + goff + col);
                    u32x4 pv = (u32x4){0u, 0u, 0u, 0u};
                    if (!first) pv = *(const u32x4*)(Mg + (size_t)row * 1024 + col);
                    const f32x4 v0 = acc[ai][bj][m][0], v1 = acc[ai][bj][m][1];
                    u32x4 w;
                    w.x = cvt_pk_bf16(bf_lo(pv.x) + bf_lo(g.x) * v0[0], bf_hi(pv.x) + bf_hi(g.x) * v0[1]);
                    w.y = cvt_pk_bf16(bf_lo(pv.y) + bf_lo(g.y) * v0[2], bf_hi(pv.y) + bf_hi(g.y) * v0[3]);
                    w.z = cvt_pk_bf16(bf_lo(pv.z) + bf_lo(g.z) * v1[0], bf_hi(pv.z) + bf_hi(g.z) * v1[1]);
                    w.w = cvt_pk_bf16(bf_lo(pv.w) + bf_lo(g.w) * v1[2], bf_hi(pv.w) + bf_hi(g.w) * v1[3]);
                    *(u32x4*)(Mg + (size_t)row * 1024 + col) = w;
                }
            }
    }
};

struct EpiGate3 {
    static constexpr bool PERM = true, AFTER_DRAIN = false;
    bf16_t* Mg; const bf16_t* G; float f8scale, bscale;
#ifdef EXP_P5MID
    int skipmid = 0;
#endif
    __device__ __forceinline__ void mid(f32x4 (&acc)[2][2][4][2], const Unit& u, int wr, int wc, int fr, int fq) const {
        const int row0 = u.pm * BM + wr * 64 + fr, col0 = u.pn * BM + wc * 32 + 8 * fq, ga_off = u.seg * 1024, gb_off = ga_off + 1024;
#ifdef EXP_P5MID
        if (skipmid) return;
#endif
        const bf16_t* g0 = G + (size_t)row0 * 3072 + col0;
#pragma unroll
        for (int ai = 0; ai < 2; ++ai) {
            u32x4 GA[8], GB[8];
#pragma unroll
            for (int i = 0; i < 8; ++i) { const bf16_t* grow = g0 + (size_t)(ai * HALF + (i >> 1) * 16) * 3072 + (i & 1) * HALF; GA[i] = *(const u32x4*)(grow + ga_off); GB[i] = *(const u32x4*)(grow + gb_off); }
            __builtin_amdgcn_sched_barrier(0);
#pragma unroll
            for (int i = 0; i < 8; ++i) {
                const u32x4 ga = GA[i], gb = GB[i];
                f32x4& v0 = acc[ai][i & 1][i >> 1][0]; f32x4& v1 = acc[ai][i & 1][i >> 1][1];
                v0[0] *= bf_lo(ga.x) * __builtin_amdgcn_rcpf(bf_lo(gb.x)); v0[1] *= bf_hi(ga.x) * __builtin_amdgcn_rcpf(bf_hi(gb.x));
                v0[2] *= bf_lo(ga.y) * __builtin_amdgcn_rcpf(bf_lo(gb.y)); v0[3] *= bf_hi(ga.y) * __builtin_amdgcn_rcpf(bf_hi(gb.y));
                v1[0] *= bf_lo(ga.z) * __builtin_amdgcn_rcpf(bf_lo(gb.z)); v1[1] *= bf_hi(ga.z) * __builtin_amdgcn_rcpf(bf_hi(gb.z));
                v1[2] *= bf_lo(ga.w) * __builtin_amdgcn_rcpf(bf_lo(gb.w)); v1[3] *= bf_hi(ga.w) * __builtin_amdgcn_rcpf(bf_hi(gb.w));
            }
            __builtin_amdgcn_sched_barrier(0);
        }
    }
    __device__ __forceinline__ void operator()(const f32x4 (&acc)[2][2][4][2], const Unit& u, int wr, int wc, int fr, int fq) const {
        const int row0 = u.pm * BM + wr * 64 + fr, col0 = u.pn * BM + wc * 32 + 8 * fq;
        u32x4 GG[16];
#pragma unroll
        for (int i = 0; i < 16; ++i) GG[i] = *(const u32x4*)(G + (size_t)(row0 + (i >> 3) * HALF + ((i >> 1) & 3) * 16) * 3072 + 2048 + col0 + (i & 1) * HALF);
        __builtin_amdgcn_sched_barrier(0);
#pragma unroll
        for (int ai = 0; ai < 2; ++ai)
#pragma unroll
            for (int m = 0; m < 4; ++m) {
                const int row = row0 + ai * HALF + m * 16;
#pragma unroll
                for (int bj = 0; bj < 2; ++bj) {
                    const int col = col0 + bj * HALF;
                    const u32x4 g = GG[ai * 8 + m * 2 + bj];
                    const f32x4 v0 = acc[ai][bj][m][0], v1 = acc[ai][bj][m][1];
                    if (f8scale != 0.f) {
                        const float s = f8scale;
                        int lo = __builtin_amdgcn_cvt_pk_fp8_f32(bf_lo(g.x) * v0[0] * s, bf_hi(g.x) * v0[1] * s, 0, false); lo = __builtin_amdgcn_cvt_pk_fp8_f32(bf_lo(g.y) * v0[2] * s, bf_hi(g.y) * v0[3] * s, lo, true);
                        int hi = __builtin_amdgcn_cvt_pk_fp8_f32(bf_lo(g.z) * v1[0] * s, bf_hi(g.z) * v1[1] * s, 0, false); hi = __builtin_amdgcn_cvt_pk_fp8_f32(bf_lo(g.w) * v1[2] * s, bf_hi(g.w) * v1[3] * s, hi, true);
                        typedef unsigned u32x2_ __attribute__((ext_vector_type(2)));
                        *(u32x2_*)((unsigned char*)Mg + (size_t)row * 1024 + col) = (u32x2_){(unsigned)lo, (unsigned)hi};
                    } else {
                        u32x4 w;
                        const float b = bscale;
                        w.x = cvt_pk_bf16(bf_lo(g.x) * v0[0] * b, bf_hi(g.x) * v0[1] * b); w.y = cvt_pk_bf16(bf_lo(g.y) * v0[2] * b, bf_hi(g.y) * v0[3] * b);
                        w.z = cvt_pk_bf16(bf_lo(g.z) * v1[0] * b, bf_hi(g.z) * v1[1] * b); w.w = cvt_pk_bf16(bf_lo(g.w) * v1[2] * b, bf_hi(g.w) * v1[3] * b);
                        *(u32x4*)(Mg + (size_t)row * 1024 + col) = w;
                    }
                }
            }
    }
};

struct EpiResid {
    static constexpr bool PERM = true, AFTER_DRAIN = false;
    const float* X; bf16_t* out; float alpha, ascale;
    __device__ __forceinline__ void operator()(const f32x4 (&acc)[2][2][4][2], const Unit& u, int wr, int wc, int fr, int fq) const {
        const unsigned row0 = u.pm * BM + wr * 64 + fr, col0 = u.pn * BM + wc * 32 + 8 * fq;
#pragma unroll
        for (int ai = 0; ai < 2; ++ai) {
            f32x4 X0[8], X1[8];
#pragma unroll
            for (int i = 0; i < 8; ++i) { const unsigned off = (row0 + ai * HALF + (i >> 1) * 16) * 1024u + col0 + (i & 1) * HALF; X0[i] = *(const f32x4*)(X + off); X1[i] = *(const f32x4*)(X + (off + 4)); }
            __builtin_amdgcn_sched_barrier(0);
#pragma unroll
            for (int i = 0; i < 8; ++i) {
                const int m = i >> 1, bj = i & 1;
                const unsigned off = (row0 + ai * HALF + m * 16) * 1024u + col0 + bj * HALF;
                const f32x4 v0 = X0[i] * alpha + acc[ai][bj][m][0] * ascale, v1 = X1[i] * alpha + acc[ai][bj][m][1] * ascale;
                u32x4 w; w.x = cvt_pk_bf16(v0[0], v0[1]); w.y = cvt_pk_bf16(v0[2], v0[3]); w.z = cvt_pk_bf16(v1[0], v1[1]); w.w = cvt_pk_bf16(v1[2], v1[3]);
                *(u32x4*)(out + off) = w;
            }
            __builtin_amdgcn_sched_barrier(0);
        }
    }
};
struct EpiResid3 : EpiResid {
    __device__ __forceinline__ void mid(f32x4 (&)[2][2][4][2], const Unit&, int, int, int, int) const {}
};
}
#define GAS __attribute__((address_space(1)))
#define LAS __attribute__((address_space(3)))
typedef unsigned short bf16;
typedef unsigned v4u __attribute__((ext_vector_type(4)));
typedef float f32x4 __attribute__((ext_vector_type(4)));
typedef short bf16x8 __attribute__((ext_vector_type(8)));
typedef GAS unsigned gu32;
typedef GAS unsigned long long gu64;
#define RLX_AGENT __ATOMIC_RELAXED, __HIP_MEMORY_SCOPE_AGENT
#define LDS_WAIT() asm volatile("s_waitcnt lgkmcnt(0)" ::: "memory")
#define VM_WAIT() asm volatile("s_waitcnt vmcnt(0)" ::: "memory")
__device__ __forceinline__ unsigned long long rt() { return __builtin_amdgcn_s_memrealtime(); }
__device__ __forceinline__ unsigned f2bf(float f) { unsigned u = __builtin_bit_cast(unsigned, f); return (u + 0x7fffu + ((u >> 16) & 1u)) >> 16; }
__device__ __forceinline__ unsigned pk2(float lo, float hi) { return f2bf(lo) | (f2bf(hi) << 16); }
#define XB_TMO      128
#define XB_XCNT(j)  (256  + 64 * (j))
#define XB_XSUB(j)  (1280 + 64 * (j))
#define XB_XGEN(j)  (2304 + 64 * (j))
#define XB_TOP      3328
#define XB_TOPGEN   3392
#define XCD_BAR_WORDS 3456
#define XB_SPIN_CAP (1u << 18)

__device__ __forceinline__ unsigned xb_ld(unsigned* p)              { return __hip_atomic_load(p, __ATOMIC_RELAXED, __HIP_MEMORY_SCOPE_AGENT); }
__device__ __forceinline__ unsigned xb_add(unsigned* p, unsigned v) { return __hip_atomic_fetch_add(p, v, __ATOMIC_RELAXED, __HIP_MEMORY_SCOPE_AGENT); }
__device__ __forceinline__ unsigned xb_xcc_id() { return (unsigned)__builtin_amdgcn_s_getreg((3 << 11) | 20) & 0xFu; }
#define XB_SPIN(cond, bar) do { unsigned _sp = 0; while (cond) { __builtin_amdgcn_s_sleep(1); \
    if ((++_sp & 255u) == 0u) { if (xb_ld(&(bar)[XB_TMO])) break; if (_sp > XB_SPIN_CAP) { atomicAdd(&(bar)[XB_TMO], 1u); break; } } } } while (0)

struct XcdBarrier {
    unsigned* bar; unsigned x;
    volatile LAS unsigned* st;
};

__device__ __forceinline__ XcdBarrier xcd_barrier_post(unsigned* bar, volatile LAS unsigned* st) {
    XcdBarrier b; b.bar = bar; b.x = xb_xcc_id(); b.st = st;
    if (threadIdx.x == 0) (void)xb_add(&bar[XB_XCNT(b.x)], 1u);
    return b;
}
__device__ __forceinline__ void xcd_barrier_complete(unsigned* bar, unsigned x, unsigned& nloc, unsigned& nx) {
    const unsigned G = gridDim.x * gridDim.y * gridDim.z;
    unsigned sum, cnt, mine, sp = 0u;
    for (;;) {
        sum = 0u; cnt = 0u; mine = 0u;
#pragma unroll
        for (unsigned j = 0; j < 16; ++j) { const unsigned c = xb_ld(&bar[XB_XCNT(j)]); sum += c; cnt += (c > 0u) ? 1u : 0u; mine = (j == x) ? c : mine; }
        if (sum == G) break;
        __builtin_amdgcn_s_sleep(1);
        if ((++sp & 255u) == 0u) { if (xb_ld(&bar[XB_TMO])) break; if (sp > XB_SPIN_CAP) { atomicAdd(&bar[XB_TMO], 1u); break; } }
    }
    nloc = mine > 0u ? mine : 1u; nx = cnt > 0u ? cnt : 1u;
}

__device__ __forceinline__ void xcd_barrier(const XcdBarrier& b) {
    asm volatile("s_waitcnt vmcnt(0)" ::: "memory");
    __syncthreads();
    if (threadIdx.x == 0) {
        unsigned* bar = b.bar;
        __builtin_amdgcn_s_waitcnt(0);
        unsigned nloc = b.st[0], nx = b.st[1];
        if (nloc == 0u) { xcd_barrier_complete(bar, b.x, nloc, nx); b.st[0] = nloc; b.st[1] = nx; }
        const unsigned old = xb_add(&bar[XB_XSUB(b.x)], 1u);
        const unsigned gen = old / nloc;
        if (old + 1u == (gen + 1u) * nloc) {
            __builtin_amdgcn_fence(__ATOMIC_RELEASE, "agent");
            asm volatile("s_waitcnt vmcnt(0)" ::: "memory");
            const unsigned og = xb_add(&bar[XB_TOP], 1u);
            const unsigned tg = og / nx;
            if (og + 1u == (tg + 1u) * nx) xb_add(&bar[XB_TOPGEN], 1u);
            else XB_SPIN(xb_ld(&bar[XB_TOPGEN]) == tg, bar);
            __builtin_amdgcn_fence(__ATOMIC_ACQUIRE, "agent");
            xb_add(&bar[XB_XGEN(b.x)], 1u);
            asm volatile("s_waitcnt vmcnt(0)" ::: "memory");
        } else {
            XB_SPIN(xb_ld(&bar[XB_XGEN(b.x)]) == gen, bar);
            __builtin_amdgcn_fence(__ATOMIC_ACQUIRE, "agent");
            asm volatile("s_waitcnt vmcnt(0)" ::: "memory");
        }
    }
    __syncthreads();
}
#ifndef PEER_U_INT8
#define PEER_U_INT4 1
#ifndef PEER_U_NO_DOT8
#define PEER_U_DOT8 1
#endif
#endif
#ifndef P1_ALIGN
#define P1_ALIGN true
#endif
#ifndef P1_SP2
#define P1_SP2 true
#endif
#ifndef P6_F8
#define P6_BF16 1
#endif
#if !defined(GEMM_BF16_ONLY) && !defined(P56_BF16)
#define GEMM56_F8 1
#endif
#ifndef GEMM_BF16_ONLY
#define GEMM_F8 1
#endif
#ifndef P5_ALIGN
#define P5_ALIGN true
#endif
#ifndef P6_ALIGN
#define P6_ALIGN true
#endif
#ifndef P1_BF16_TILES
#define P1_BF16_TILES 0x198u
#endif
#ifndef P6_SP2
#define P6_SP2 false
#endif
#ifndef P1F8_SP2
#define P1F8_SP2 true
#endif
#ifndef P5F8_SP2
#define P5F8_SP2 true
#endif
constexpr int NWAVES = 8, NTHR = 512;
constexpr int T = 65536, D = 1024, SEQ = 8192, NBATCH = 8, NCHUNK = 64, INW = 5888;
constexpr float LN_EPS = 1e-5f, ALPHA = 1.189207115002721f;
constexpr float W8_SCALE = 64.f;
constexpr float BR8_SCALE = 8.f, MG8_SCALE = 16.f;
#ifndef MK_N_LAUNCHES
#define MK_N_LAUNCHES 1
#endif
constexpr int N_PHASES = 10;
constexpr int N_LAUNCHES = MK_N_LAUNCHES;

constexpr size_t MiB = 1u << 20;
constexpr size_t WS_CTL = 0, CTL_ZERO_BYTES = 64 * 1024;
constexpr size_t WS_WIN = 2 * MiB;
constexpr size_t WS_WBA = 14 * MiB, WS_WBR = 15 * MiB, WS_WBM = 16 * MiB;
constexpr size_t WS_WOUT = 17 * MiB;
constexpr size_t WS_WPQ = 19 * MiB;
constexpr size_t WS_WMKV = 23 * MiB;
constexpr size_t WS_SUBK = 25 * MiB;
constexpr size_t WS_BIASP = 25 * MiB + 512 * 1024;
constexpr size_t WS_MEMN = 26 * MiB;
constexpr size_t WS_MK = 30 * MiB;
constexpr size_t WS_MVT = 32 * MiB;
constexpr size_t WS_PU = 34 * MiB, WS_PV = 66 * MiB;
constexpr size_t WS_KV = 98 * MiB;
constexpr size_t WS_ST = 162 * MiB;
constexpr size_t WS_AQ = 194 * MiB, WS_RV = 258 * MiB, WS_MQ = 322 * MiB;
constexpr size_t WS_AK = 386 * MiB, WS_AV = 402 * MiB, WS_RQ = 418 * MiB, WS_RK = 450 * MiB, WS_RG = 482 * MiB;
constexpr size_t WS_MERGED = 386 * MiB;
constexpr size_t WS_G = 546 * MiB;
constexpr size_t WS_PQ = 546 * MiB;
constexpr size_t WS_HB = 194 * MiB;
constexpr size_t WS_H8 = 322 * MiB;
constexpr size_t WS_HS = 25 * MiB + 768 * 1024;
constexpr size_t WS_VS = 25 * MiB + 704 * 1024;
constexpr size_t WS_US = 25 * MiB + 640 * 1024;
constexpr size_t WS_PO = 802 * MiB;
constexpr size_t WS_WIN8 = 932 * MiB;
constexpr size_t WS_END = 940 * MiB;
constexpr int CW_BAR = 4096;

constexpr int LDS_BYTES = 163840, LDSCTL_OFF = 163840 - 512, MISC_OFF = LDSCTL_OFF + 320;

typedef unsigned long long u64;
typedef unsigned short u16;
typedef __bf16 bf16x2_t __attribute__((ext_vector_type(2)));

__device__ __forceinline__ const float* karg_in(int k) {
    const __attribute__((address_space(4))) char* kp = (const __attribute__((address_space(4))) char*)__builtin_amdgcn_kernarg_segment_ptr();
    asm volatile("" : "+s"(kp));
    return *(const float* const __attribute__((address_space(4)))*)(kp + 8 * k);
}
struct Frame {
    LAS unsigned char* lds;
    int tid, lane, wave, fr, fq;
    int G;
    float* out; unsigned char* ws;
};

__device__ __forceinline__ f32x4 mma16(bf16x8 arow, bf16x8 bcol, f32x4 acc) { return __builtin_amdgcn_mfma_f32_16x16x32_bf16(bcol, arow, acc, 0, 0, 0); }
__device__ __forceinline__ float bflo(unsigned u) { return __uint_as_float(u << 16); }
__device__ __forceinline__ float bfhi(unsigned u) { return __uint_as_float(u & 0xffff0000u); }
template <int CTRL> __device__ __forceinline__ float dpp(float x) { return __builtin_bit_cast(float, __builtin_amdgcn_mov_dpp(__builtin_bit_cast(int, x), CTRL, 0xf, 0xf, true)); }
constexpr int XOR1 = 0xB1, XOR2 = 0x4E, XOR7 = 0x141, XOR8 = 0x128;
__device__ __forceinline__ float xrow16_sum(float x) {
    auto s = __builtin_amdgcn_permlane16_swap(__float_as_uint(x), __float_as_uint(x), false, false);
    x = __uint_as_float(s[0]) + __uint_as_float(s[1]);
    auto t = __builtin_amdgcn_permlane32_swap(__float_as_uint(x), __float_as_uint(x), false, false);
    return __uint_as_float(t[0]) + __uint_as_float(t[1]);
}
__device__ __forceinline__ float xrow16_max(float x) {
    auto s = __builtin_amdgcn_permlane16_swap(__float_as_uint(x), __float_as_uint(x), false, false);
    x = fmaxf(__uint_as_float(s[0]), __uint_as_float(s[1]));
    auto t = __builtin_amdgcn_permlane32_swap(__float_as_uint(x), __float_as_uint(x), false, false);
    return fmaxf(__uint_as_float(t[0]), __uint_as_float(t[1]));
}
__device__ __forceinline__ float wave_sum(float v) { v += dpp<XOR1>(v); v += dpp<XOR2>(v); v += dpp<XOR7>(v); v += dpp<XOR8>(v); return xrow16_sum(v); }
__device__ __forceinline__ float quad_sum(float v) { v += __shfl_xor(v, 16); v += __shfl_xor(v, 32); return v; }
__device__ __forceinline__ float quad_max(float v) { v = fmaxf(v, __shfl_xor(v, 16)); v = fmaxf(v, __shfl_xor(v, 32)); return v; }

__device__ __forceinline__ int win_src_col(int c) {
    if (c < 768 || c >= 1280) return c;
    const int p = c & 63, base = c - p, i = p >> 3, e = p & 7;
    return base + (e < 4 ? 4 * i + e : 32 + 4 * i + (e - 4));
}
template <bool WIN>
__device__ __forceinline__ void p0_transpose_item(const float* W, int K, int N, bf16* WT, LAS float* scr, int item, int lane) {
    const int nblk = N / 32, kb = item / nblk, nb = item % nblk, k0 = 64 * kb, n0 = 32 * nb;
    const int nsrc = WIN ? win_src_col(n0 + (lane & 31)) : n0 + (lane & 31);
#pragma unroll 8
    for (int i = 0; i < 32; ++i) { const int kk = 2 * i + (lane >> 5); scr[kk * 33 + (lane & 31)] = W[(size_t)(k0 + kk) * N + nsrc]; }
    LDS_WAIT(); asm volatile("" ::: "memory");
    const int c = lane & 7;
#pragma unroll
    for (int j = 0; j < 4; ++j) { const int n = (lane >> 3) + 8 * j; const LAS float* s = scr + (8 * c) * 33 + n;
        v4u o; o.x = pk2(s[0 * 33], s[1 * 33]); o.y = pk2(s[2 * 33], s[3 * 33]); o.z = pk2(s[4 * 33], s[5 * 33]); o.w = pk2(s[6 * 33], s[7 * 33]);
        *(v4u*)(WT + (size_t)(n0 + n) * K + k0 + 8 * c) = o; }
    LDS_WAIT(); asm volatile("" ::: "memory");
}
__device__ __forceinline__ unsigned pk4_fp8(float a, float b, float c, float d) { int r = __builtin_amdgcn_cvt_pk_fp8_f32(a, b, 0, false); r = __builtin_amdgcn_cvt_pk_fp8_f32(c, d, r, true); return (unsigned)r; }
template <bool WIN>
__device__ __forceinline__ void p0_transpose_item_f8(const float* W, int K, int N, unsigned char* WT, float scale, LAS float* scr, int item, int lane) {
    const int nblk = N / 32, kb = item / nblk, nb = item % nblk, k0 = 64 * kb, n0 = 32 * nb;
    const int nsrc = WIN ? win_src_col(n0 + (lane & 31)) : n0 + (lane & 31);
#pragma unroll 8
    for (int i = 0; i < 32; ++i) { const int kk = 2 * i + (lane >> 5); scr[kk * 33 + (lane & 31)] = W[(size_t)(k0 + kk) * N + nsrc] * scale; }
    LDS_WAIT(); asm volatile("" ::: "memory");
    const int n = lane >> 1, hf = lane & 1;
#pragma unroll
    for (int q = 0; q < 2; ++q) { const int ch = 2 * hf + q; const LAS float* sp = scr + (16 * ch) * 33 + n;
        v4u o; o.x = pk4_fp8(sp[0 * 33], sp[1 * 33], sp[2 * 33], sp[3 * 33]); o.y = pk4_fp8(sp[4 * 33], sp[5 * 33], sp[6 * 33], sp[7 * 33]);
        o.z = pk4_fp8(sp[8 * 33], sp[9 * 33], sp[10 * 33], sp[11 * 33]); o.w = pk4_fp8(sp[12 * 33], sp[13 * 33], sp[14 * 33], sp[15 * 33]);
        *(v4u*)(WT + (size_t)(n0 + n) * K + k0 + 16 * ch) = o; }
    LDS_WAIT(); asm volatile("" ::: "memory");
}
__device__ __forceinline__ void cvt_row_1024(const float* src, bf16* dst, int lane) {
    f32x4 v[4];
#pragma unroll
    for (int j = 0; j < 4; ++j) v[j] = ((const f32x4*)src)[lane + 64 * j];
#pragma unroll
    for (int j = 0; j < 4; ++j) ((u64*)dst)[lane + 64 * j] = (u64)pk2(v[j].x, v[j].y) | ((u64)pk2(v[j].z, v[j].w) << 32);
}
constexpr float PU_SCALE = 256.f, PV_SCALE = 32.f;
__device__ __forceinline__ void cvt_row_1024_fp8(const float* src, unsigned char* dst_base, int row, float scale, int lane) {
    f32x4 v[4];
#pragma unroll
    for (int j = 0; j < 4; ++j) v[j] = ((const f32x4*)src)[4 * lane + j] * scale;
    v4u o; o.x = pk4_fp8(v[0].x, v[0].y, v[0].z, v[0].w); o.y = pk4_fp8(v[1].x, v[1].y, v[1].z, v[1].w); o.z = pk4_fp8(v[2].x, v[2].y, v[2].z, v[2].w); o.w = pk4_fp8(v[3].x, v[3].y, v[3].z, v[3].w);
    *(v4u*)(dst_base + (size_t)(lane >> 3) * (16384 * 128) + (size_t)row * 128 + 16 * (lane & 7)) = o;
}
__device__ __forceinline__ float wave_max(float v) { v = fmaxf(v, dpp<XOR1>(v)); v = fmaxf(v, dpp<XOR2>(v)); v = fmaxf(v, dpp<XOR7>(v)); v = fmaxf(v, dpp<XOR8>(v)); return xrow16_max(v); }
__device__ __forceinline__ unsigned pk4_i8(float a, float b, float c, float d) {
    const int q0 = __float2int_rn(a), q1 = __float2int_rn(b), q2 = __float2int_rn(c), q3 = __float2int_rn(d);
    return (unsigned)(q0 & 0xff) | ((unsigned)(q1 & 0xff) << 8) | ((unsigned)(q2 & 0xff) << 16) | ((unsigned)(q3 & 0xff) << 24);
}
__device__ __forceinline__ void cvt_row_regs_i8(f32x4 (&v)[4], unsigned char* dst_base, int row, float* scale_out, int lane) {
    float mx = 0.f;
#pragma unroll
    for (int j = 0; j < 4; ++j) mx = fmaxf(mx, fmaxf(fmaxf(fabsf(v[j].x), fabsf(v[j].y)), fmaxf(fabsf(v[j].z), fabsf(v[j].w))));
    mx = fmaxf(wave_max(mx), 1e-30f);
    const float inv = 127.0f / mx;
    v4u o; o.x = pk4_i8(v[0].x * inv, v[0].y * inv, v[0].z * inv, v[0].w * inv); o.y = pk4_i8(v[1].x * inv, v[1].y * inv, v[1].z * inv, v[1].w * inv);
    o.z = pk4_i8(v[2].x * inv, v[2].y * inv, v[2].z * inv, v[2].w * inv); o.w = pk4_i8(v[3].x * inv, v[3].y * inv, v[3].z * inv, v[3].w * inv);
    *(v4u*)(dst_base + (size_t)(lane >> 3) * (16384 * 128) + (size_t)row * 128 + 16 * (lane & 7)) = o;
    if (lane == 0) *scale_out = mx * (1.0f / 127.0f);
}
__device__ __forceinline__ void ln_row_1024(const float* src, const float* g, const float* bta, float* of32, bf16* obf, int lane, unsigned char* oi8 = nullptr, float* oscale = nullptr) {
    f32x4 v[4]; float s = 0.f;
#pragma unroll
    for (int j = 0; j < 4; ++j) { v[j] = ((const f32x4*)src)[lane + 64 * j]; s += (v[j].x + v[j].y) + (v[j].z + v[j].w); }
    const float mean = wave_sum(s) * (1.f / 1024.f); float s2 = 0.f;
#pragma unroll
    for (int j = 0; j < 4; ++j) { v[j] = v[j] - mean; s2 += (v[j].x * v[j].x + v[j].y * v[j].y) + (v[j].z * v[j].z + v[j].w * v[j].w); }
    const float rstd = 1.f / sqrtf(wave_sum(s2) * (1.f / 1024.f) + LN_EPS);
    float mx = 0.f;
#pragma unroll
    for (int j = 0; j < 4; ++j) {
        const f32x4 gg = ((const f32x4*)g)[lane + 64 * j], bb = ((const f32x4*)bta)[lane + 64 * j];
        const f32x4 o = v[j] * rstd * gg + bb;
        v[j] = o;
        mx = fmaxf(mx, fmaxf(fmaxf(fabsf(o.x), fabsf(o.y)), fmaxf(fabsf(o.z), fabsf(o.w))));
        if (of32) ((f32x4*)of32)[lane + 64 * j] = o;
        if (obf) ((u64*)obf)[lane + 64 * j] = (u64)pk2(o.x, o.y) | ((u64)pk2(o.z, o.w) << 32);
    }
    if (oi8) {
        mx = fmaxf(wave_max(mx), 1e-30f);
        const float inv = 127.0f / mx;
#pragma unroll
        for (int j = 0; j < 4; ++j) ((unsigned*)oi8)[lane + 64 * j] = pk4_i8(v[j].x * inv, v[j].y * inv, v[j].z * inv, v[j].w * inv);
        if (lane == 0) *oscale = mx * (1.0f / 127.0f);
    }
}

__device__ __forceinline__ void cvt_row_regs_i4(f32x4 (&v)[4], unsigned char* dst_base, int row, float* scale_out, int lane) {
    float mx = 0.f;
#pragma unroll
    for (int j = 0; j < 4; ++j) mx = fmaxf(mx, fmaxf(fmaxf(fabsf(v[j].x), fabsf(v[j].y)), fmaxf(fabsf(v[j].z), fabsf(v[j].w))));
    mx = fmaxf(wave_max(mx), 1e-30f);
    float best_err = 3.0e38f, best_f = 1.0f;
#pragma unroll
    for (int k = 0; k < 5; ++k) {
        const float f = 1.0f - 0.1f * (float)k, step = mx * f * (1.0f / 7.0f), inv = 1.0f / step;
        float err = 0.f;
#pragma unroll
        for (int j = 0; j < 4; ++j)
#pragma unroll
            for (int i = 0; i < 4; ++i) { const float x = v[j][i], q = fminf(fmaxf(rintf(x * inv), -7.0f), 7.0f), d = x - q * step; err += d * d; }
        err = wave_sum(err);
        if (err < best_err) { best_err = err; best_f = f; }
    }
    const float step = mx * best_f * (1.0f / 7.0f), inv = 1.0f / step;
    unsigned w0 = 0u, w1 = 0u;
#pragma unroll
    for (int j = 0; j < 4; ++j) {
        unsigned n[4];
#pragma unroll
        for (int i = 0; i < 4; ++i) n[i] = (unsigned)(int)fminf(fmaxf(rintf(v[j][i] * inv), -7.0f), 7.0f) & 0xfu;
        const unsigned h = n[0] | (n[1] << 4) | (n[2] << 8) | (n[3] << 12);
        if (j < 2) w0 |= h << (16 * j); else w1 |= h << (16 * (j - 2));
    }
    *(u64*)(dst_base + (size_t)(lane >> 4) * (16384 * 128) + (size_t)row * 128 + 8 * (lane & 15)) = (u64)w0 | ((u64)w1 << 32);
#ifdef PEER_U_DOT8
    if (lane == 0) *scale_out = step;
#else
    if (lane == 0) *scale_out = step * (1.0f / 16.0f);
#endif
}
__device__ __forceinline__ void ln1_finish(f32x4 (&v)[4], const float* g, const float* bta, bf16* obf, unsigned char* oi8, float* oscale, int lane) {
    float s = 0.f;
#pragma unroll
    for (int j = 0; j < 4; ++j) s += (v[j].x + v[j].y) + (v[j].z + v[j].w);
    const float mean = wave_sum(s) * (1.f / 1024.f); float s2 = 0.f;
#pragma unroll
    for (int j = 0; j < 4; ++j) { v[j] = v[j] - mean; s2 += (v[j].x * v[j].x + v[j].y * v[j].y) + (v[j].z * v[j].z + v[j].w * v[j].w); }
    const float rstd = 1.f / sqrtf(wave_sum(s2) * (1.f / 1024.f) + LN_EPS);
    float mx = 0.f;
#pragma unroll
    for (int j = 0; j < 4; ++j) {
        const f32x4 gg = ((const f32x4*)g)[lane + 64 * j], bb = ((const f32x4*)bta)[lane + 64 * j];
        const f32x4 o = v[j] * rstd * gg + bb;
        v[j] = o;
        mx = fmaxf(mx, fmaxf(fmaxf(fabsf(o.x), fabsf(o.y)), fmaxf(fabsf(o.z), fabsf(o.w))));
        ((u64*)obf)[lane + 64 * j] = (u64)pk2(o.x, o.y) | ((u64)pk2(o.z, o.w) << 32);
    }
    mx = fmaxf(wave_max(mx), 1e-30f);
#ifdef PEER_U_DOT8
    const float inv = 119.0f / mx;
    const int odd = lane & 1;
#pragma unroll
    for (int j = 0; j < 4; ++j) {
        unsigned hi16 = 0u, lo16 = 0u;
#pragma unroll
        for (int i = 0; i < 4; ++i) { const int t = __float2int_rn(v[j][i] * inv) + 8; hi16 |= ((unsigned)(t >> 4) & 15u) << (4 * i); lo16 |= ((unsigned)(t ^ 8) & 15u) << (4 * i); }
        const unsigned recv = (unsigned)__builtin_amdgcn_mov_dpp((int)(odd ? hi16 : lo16), XOR1, 0xf, 0xf, true);
        const unsigned dw = odd ? (recv | (lo16 << 16)) : (hi16 | (recv << 16));
        *(unsigned*)(oi8 + 256 * j + 32 * (lane >> 3) + 16 * odd + 4 * ((lane >> 1) & 3)) = dw;
    }
    if (lane == 0) *oscale = mx * (1.0f / 119.0f);
#else
    const float inv = 127.0f / mx;
#pragma unroll
    for (int j = 0; j < 4; ++j) ((unsigned*)oi8)[lane + 64 * j] = pk4_i8(v[j].x * inv, v[j].y * inv, v[j].z * inv, v[j].w * inv);
    if (lane == 0) *oscale = mx * (1.0f / 127.0f);
#endif
}

__device__ __forceinline__ void p0_prologue(Frame& F) {
    LAS float* scr = (LAS float*)(F.lds + F.wave * 16384);
    const int gw = blockIdx.x * NWAVES + F.wave, NGW = F.G * NWAVES;
    unsigned char* ws = F.ws;
    constexpr int I_IN = 16 * (INW / 32), I_BR = 8 * 32, I_OUT = 16 * 32, I_PQ = 16 * 64, I_MKV = 16 * 32;
    constexpr int NITEMS = I_IN + 3 * I_BR + I_OUT + I_PQ + I_MKV;
    for (int it = gw; it < NITEMS; it += NGW) {
        int r = it;
        if (r < I_IN) { p0_transpose_item<true>(karg_in(2), 1024, INW, (bf16*)(ws + WS_WIN), scr, r, F.lane);
#ifdef GEMM_F8
            p0_transpose_item_f8<true>(karg_in(2), 1024, INW, ws + WS_WIN8, W8_SCALE, scr, r, F.lane);
#endif
            continue; } r -= I_IN;
#ifdef GEMM56_F8
        if (r < I_BR) { p0_transpose_item_f8<false>(karg_in(9), 512, 1024, ws + WS_WBA, W8_SCALE, scr, r, F.lane); continue; } r -= I_BR;
#else
        if (r < I_BR) { p0_transpose_item<false>(karg_in(9), 512, 1024, (bf16*)(ws + WS_WBA), scr, r, F.lane); continue; } r -= I_BR;
#endif
#ifdef GEMM56_F8
        if (r < I_BR) { p0_transpose_item_f8<false>(karg_in(10), 512, 1024, ws + WS_WBR, W8_SCALE, scr, r, F.lane); continue; } r -= I_BR;
#else
        if (r < I_BR) { p0_transpose_item<false>(karg_in(10), 512, 1024, (bf16*)(ws + WS_WBR), scr, r, F.lane); continue; } r -= I_BR;
#endif
#ifdef GEMM56_F8
        if (r < I_BR) { p0_transpose_item_f8<false>(karg_in(11), 512, 1024, ws + WS_WBM, W8_SCALE, scr, r, F.lane); continue; } r -= I_BR;
#else
        if (r < I_BR) { p0_transpose_item<false>(karg_in(11), 512, 1024, (bf16*)(ws + WS_WBM), scr, r, F.lane); continue; } r -= I_BR;
#endif
#if defined(GEMM56_F8) && !defined(P6_BF16)
        if (r < I_OUT) { p0_transpose_item_f8<false>(karg_in(12), 1024, 1024, ws + WS_WOUT, W8_SCALE, scr, r, F.lane); continue; } r -= I_OUT;
#else
        if (r < I_OUT) { p0_transpose_item<false>(karg_in(12), 1024, 1024, (bf16*)(ws + WS_WOUT), scr, r, F.lane); continue; } r -= I_OUT;
#endif
        if (r < I_PQ) { p0_transpose_item<false>(karg_in(15), 1024, 2048, (bf16*)(ws + WS_WPQ), scr, r, F.lane); continue; } r -= I_PQ;
        p0_transpose_item<false>(karg_in(8), 1024, 1024, (bf16*)(ws + WS_WMKV), scr, r, F.lane);
    }
    bf16* XB = (bf16*)F.out;
    for (int m = gw; m < T; m += 4 * NGW) {
        f32x4 v[4][4];
#pragma unroll
        for (int q = 0; q < 4; ++q)
#pragma unroll
            for (int j = 0; j < 4; ++j) v[q][j] = ((const f32x4*)(karg_in(0) + (size_t)(m + q * NGW) * 1024))[F.lane + 64 * j];
#ifdef GEMM_F8
#pragma unroll
        for (int q = 0; q < 4; ++q)
#pragma unroll
            for (int j = 0; j < 4; ++j) ((unsigned*)((unsigned char*)F.out + (size_t)T * 2048 + (size_t)(m + q * NGW) * 1024))[F.lane + 64 * j] = pk4_fp8(v[q][j].x, v[q][j].y, v[q][j].z, v[q][j].w);
#endif
#pragma unroll
        for (int q = 0; q < 4; ++q)
#pragma unroll
            for (int j = 0; j < 4; ++j) ((u64*)(XB + (size_t)(m + q * NGW) * 1024))[F.lane + 64 * j] = (u64)pk2(v[q][j].x, v[q][j].y) | ((u64)pk2(v[q][j].z, v[q][j].w) << 32);
    }
    for (int m = gw; m < 16384; m += NGW) {
        f32x4 a[4], b[4];
#pragma unroll
        for (int j = 0; j < 4; ++j) { a[j] = ((const f32x4*)(karg_in(17) + (size_t)m * 1024))[4 * F.lane + j]; b[j] = ((const f32x4*)(karg_in(18) + (size_t)m * 1024))[4 * F.lane + j]; }
#ifdef PEER_U_INT4
        cvt_row_regs_i4(a, ws + WS_PU, m, (float*)(ws + WS_US) + m, F.lane);
#else
        cvt_row_regs_i8(a, ws + WS_PU, m, (float*)(ws + WS_US) + m, F.lane);
#endif
        cvt_row_regs_i8(b, ws + WS_PV, m, (float*)(ws + WS_VS) + m, F.lane);
    }
    for (int m = gw; m < 256; m += NGW) cvt_row_1024(karg_in(16) + (size_t)m * 1024, (bf16*)(ws + WS_SUBK) + (size_t)m * 1024, F.lane);
    for (int m = gw; m < 2048; m += NGW) ln_row_1024(karg_in(1) + (size_t)m * 1024, karg_in(6), karg_in(7), nullptr, (bf16*)(ws + WS_MEMN) + (size_t)m * 1024, F.lane);
    float* biasp = (float*)(ws + WS_BIASP);
    for (int c = blockIdx.x * NTHR + F.tid; c < INW; c += F.G * NTHR) biasp[c] = karg_in(3)[win_src_col(c)];
}

__device__ __forceinline__ float ret_log2gamma(int h) { return log2f(1.0f - exp2f(-5.0f - (float)h)); }
__device__ __forceinline__ void kvinc_load(Frame& F, int u, v4u (&rv)[4], v4u (&rk)[2]) {
    const int b = u >> 8, n = (u >> 2) & 63, h = u & 3;
    const bf16* RK = (const bf16*)(F.ws + WS_RK); const bf16* RV = (const bf16*)(F.ws + WS_RV);
    const size_t tok0 = (size_t)b * SEQ + (size_t)n * 128;
#pragma unroll
    for (int k = 0; k < 4; ++k) { const int idx = F.tid + NTHR * k, r = idx & 127, c = idx >> 7; rv[k] = *(const v4u*)(RV + (tok0 + r) * 512 + h * 128 + 8 * c); }
#pragma unroll
    for (int k = 0; k < 2; ++k) { const int idx = F.tid + NTHR * k, r = idx & 127, c = idx >> 7; rk[k] = *(const v4u*)(RK + (tok0 + r) * 256 + h * 64 + 8 * c); }
}
__device__ __forceinline__ void kvinc_stage(Frame& F, int u, const v4u (&rv)[4], const v4u (&rk)[2]) {
    LAS bf16* Vt = (LAS bf16*)(F.lds);
    LAS bf16* Kt = (LAS bf16*)(F.lds + 34816);
    const float lg = ret_log2gamma(u & 3);
#pragma unroll
    for (int k = 0; k < 4; ++k) { const int idx = F.tid + NTHR * k, r = idx & 127, c = idx >> 7; const v4u v = rv[k]; LAS bf16* d = Vt + (8 * c) * 136 + r;
        d[0 * 136] = (bf16)(v.x & 0xffffu); d[1 * 136] = (bf16)(v.x >> 16); d[2 * 136] = (bf16)(v.y & 0xffffu); d[3 * 136] = (bf16)(v.y >> 16); d[4 * 136] = (bf16)(v.z & 0xffffu); d[5 * 136] = (bf16)(v.z >> 16); d[6 * 136] = (bf16)(v.w & 0xffffu); d[7 * 136] = (bf16)(v.w >> 16); }
#pragma unroll
    for (int k = 0; k < 2; ++k) { const int idx = F.tid + NTHR * k, r = idx & 127, c = idx >> 7; const v4u v = rk[k]; const float wk = exp2f(lg * (float)(127 - r)); LAS bf16* d = Kt + (8 * c) * 136 + r;
        d[0 * 136] = (bf16)f2bf(bflo(v.x) * wk); d[1 * 136] = (bf16)f2bf(bfhi(v.x) * wk); d[2 * 136] = (bf16)f2bf(bflo(v.y) * wk); d[3 * 136] = (bf16)f2bf(bfhi(v.y) * wk);
        d[4 * 136] = (bf16)f2bf(bflo(v.z) * wk); d[5 * 136] = (bf16)f2bf(bfhi(v.z) * wk); d[6 * 136] = (bf16)f2bf(bflo(v.w) * wk); d[7 * 136] = (bf16)f2bf(bfhi(v.w) * wk); }
}
__device__ __forceinline__ void kvinc_compute(Frame& F, int u) {
    const int b = u >> 8, n = (u >> 2) & 63, h = u & 3;
    LAS bf16* Vt = (LAS bf16*)(F.lds); LAS bf16* Kt = (LAS bf16*)(F.lds + 34816);
    const int w = F.wave, fr = F.fr, fq = F.fq;
    f32x4 acc[4];
#pragma unroll
    for (int dt = 0; dt < 4; ++dt) acc[dt] = (f32x4){0.f, 0.f, 0.f, 0.f};
#pragma unroll
    for (int ks = 0; ks < 4; ++ks) {
        const bf16x8 a = *(const LAS bf16x8*)(Vt + (16 * w + fr) * 136 + 32 * ks + 8 * fq);
#pragma unroll
        for (int dt = 0; dt < 4; ++dt) acc[dt] = mma16(a, *(const LAS bf16x8*)(Kt + (16 * dt + fr) * 136 + 32 * ks + 8 * fq), acc[dt]);
    }
    float* KV = (float*)(F.ws + WS_KV) + ((size_t)((b * NCHUNK + n) * 4 + h)) * 8192 + (16 * w + fr) * 64 + 4 * fq;
#pragma unroll
    for (int dt = 0; dt < 4; ++dt) *(f32x4*)(KV + 16 * dt) = acc[dt];
}
__device__ __forceinline__ void kvinc_phase(Frame& F) {
    constexpr int NU = NBATCH * NCHUNK * 4;
    v4u rv[4], rk[2];
    int u = blockIdx.x;
    if (u < NU) kvinc_load(F, u, rv, rk);
    for (; u < NU; u += F.G) {
        kvinc_stage(F, u, rv, rk);
        __syncthreads();
        if (u + F.G < NU) kvinc_load(F, u + F.G, rv, rk);
        kvinc_compute(F, u);
        __syncthreads();
    }
}

__device__ __forceinline__ void scan_phase(Frame& F) {
    const float* KV = (const float*)(F.ws + WS_KV); bf16* ST = (bf16*)(F.ws + WS_ST);
    for (int q = blockIdx.x * NTHR + F.tid; q < NBATCH * 32768; q += F.G * NTHR) {
        const int b = q >> 15, r = q & 32767, h = r >> 13;
        const float decay = exp2f(ret_log2gamma(h) * 128.0f);
        float st = 0.f;
        size_t off = (size_t)b * NCHUNK * 32768 + r;
        for (int n = 0; n < NCHUNK; ++n) { ST[off] = (bf16)f2bf(st); st = decay * st + KV[off]; off += 32768; }
    }
}

__device__ __forceinline__ bf16x8 pack_p(f32x4 a, f32x4 b) { const v4u w = (v4u){pk2(a[0], a[1]), pk2(a[2], a[3]), pk2(b[0], b[1]), pk2(b[2], b[3])}; return __builtin_bit_cast(bf16x8, w); }
__device__ __forceinline__ bf16x8 frag_kperm(const LAS bf16* p, int fq) {
    const u64 lo = *(const LAS u64*)(p + 4 * fq), hi = *(const LAS u64*)(p + 16 + 4 * fq);
    const v4u w = (v4u){(unsigned)lo, (unsigned)(lo >> 32), (unsigned)hi, (unsigned)(hi >> 32)};
    return __builtin_bit_cast(bf16x8, w);
}

typedef short s16x4 __attribute__((ext_vector_type(4)));
__device__ __forceinline__ bf16x8 frag_kperm_tr(const LAS bf16* v, int pl, int off_lo, int off_hi) {
    const s16x4 lo = __builtin_amdgcn_ds_read_tr16_b64_v4i16((LAS s16x4*)(v + pl + off_lo)), hi = __builtin_amdgcn_ds_read_tr16_b64_v4i16((LAS s16x4*)(v + pl + off_hi));
    return (bf16x8){lo[0], lo[1], lo[2], lo[3], hi[0], hi[1], hi[2], hi[3]};
}
__device__ __forceinline__ bf16x8 frag_kperm_tr_lo(const LAS bf16* v, int pl) {
    const s16x4 lo = __builtin_amdgcn_ds_read_tr16_b64_v4i16((LAS s16x4*)(v + pl));
    return (bf16x8){lo[0], lo[1], lo[2], lo[3], 0, 0, 0, 0};
}
__device__ __forceinline__ bf16x8 frag_kperm_lo(const LAS bf16* p, int fq) {
    const u64 lo = *(const LAS u64*)(p + 4 * fq);
    const v4u w = (v4u){(unsigned)lo, (unsigned)(lo >> 32), 0u, 0u};
    return __builtin_bit_cast(bf16x8, w);
}
__device__ __forceinline__ void swa_load(Frame& F, int u, v4u (&rk)[4], v4u (&rv)[4]) {
    const int b = u >> 7, n = (u >> 1) & 63, g = u & 1;
    const bf16* AK = (const bf16*)(F.ws + WS_AK); const bf16* AV = (const bf16*)(F.ws + WS_AV);
    const size_t tok0 = (size_t)b * SEQ + (size_t)n * 128;
#pragma unroll
    for (int k = 0; k < 4; ++k) { const int idx = F.tid + NTHR * k, r = idx >> 3, c = idx & 7; rk[k] = (v4u){0u, 0u, 0u, 0u};
        if (n > 0 || r >= 128) rk[k] = *(const v4u*)(AK + (tok0 - 128 + r) * 128 + g * 64 + 8 * c); }
#pragma unroll
    for (int k = 0; k < 4; ++k) { const int idx = F.tid + NTHR * k, r = idx >> 3, c = idx & 7; rv[k] = (v4u){0u, 0u, 0u, 0u};
        if (n > 0 || r >= 128) rv[k] = *(const v4u*)(AV + (tok0 - 128 + r) * 128 + g * 64 + 8 * c); }
}
__device__ __forceinline__ void swa_stage(Frame& F, const v4u (&rk)[4], const v4u (&rv)[4]) {
    LAS bf16* Ks = (LAS bf16*)(F.lds);
    LAS bf16* Vs = (LAS bf16*)(F.lds + 36864);
#pragma unroll
    for (int k = 0; k < 4; ++k) { const int idx = F.tid + NTHR * k, r = idx >> 3, c = idx & 7; *(LAS v4u*)(Ks + r * 72 + 8 * c) = rk[k]; *(LAS v4u*)(Vs + r * 80 + 8 * c) = rv[k]; }
}
__device__ __forceinline__ void swa_compute(Frame& F, int u) {
    const int b = u >> 7, n = (u >> 1) & 63, g = u & 1;
    LAS bf16* Ks = (LAS bf16*)(F.lds); LAS bf16* Vs = (LAS bf16*)(F.lds + 36864);
    const bf16* AQ = (const bf16*)(F.ws + WS_AQ);
    const size_t tok0 = (size_t)b * SEQ + (size_t)n * 128;
    const int w = F.wave, fr = F.fr, fq = F.fq;
    const int hq = 4 * g + (w >> 1);
    const float sink = karg_in(4)[hq];
    const int vpl = (4 * fq + (fr >> 2)) * 80 + 4 * (fr & 3);
    bf16x8 qfa[4][2];
#pragma unroll
    for (int rg = 0; rg < 4; ++rg)
#pragma unroll
        for (int ks = 0; ks < 2; ++ks) qfa[rg][ks] = *(const bf16x8*)(AQ + (tok0 + (w & 1) * 64 + 16 * rg + fr) * 512 + hq * 64 + 32 * ks + 8 * fq);
#pragma unroll
    for (int rg = 0; rg < 4; ++rg) {
        const int qi0 = (w & 1) * 64 + 16 * rg, qi = qi0 + fr;
#ifdef GEMM56_F8
        unsigned char* orow8 = (unsigned char*)F.out + (tok0 + qi) * 512 + hq * 64;
#else
        bf16* orow = (bf16*)F.out + (tok0 + qi) * 512 + hq * 64;
#endif
        const bf16x8 (&qf)[2] = qfa[rg];
        const int t0 = qi0 >> 4;
        f32x4 s[10];
#pragma unroll
        for (int tt = 0; tt < 9; ++tt) {
            s[tt] = (f32x4){0.f, 0.f, 0.f, 0.f};
#pragma unroll
            for (int ks = 0; ks < 2; ++ks) s[tt] = mma16(qf[ks], *(const LAS bf16x8*)(Ks + (16 * (t0 + tt) + fr) * 72 + 32 * ks + 8 * fq), s[tt]);
        }
        s[9] = (f32x4){0.f, 0.f, 0.f, 0.f};
        float mx = -INFINITY;
#pragma unroll
        for (int tt = 0; tt < 9; ++tt)
#pragma unroll
            for (int i = 0; i < 4; ++i) {
                const int c = 4 * fq + i;
                bool valid = true;
                if (tt == 0) valid = c > fr;
                if (tt == 8) valid = c <= fr;
                if (n == 0) valid = valid && (t0 + tt >= 8);
                const float l = valid ? s[tt][i] * 0.125f : -INFINITY;
                s[tt][i] = l; mx = fmaxf(mx, l);
            }
        mx = quad_max(mx);
        const float m = fmaxf(mx, sink);
        float sum = 0.f;
#pragma unroll
        for (int tt = 0; tt < 9; ++tt)
#pragma unroll
            for (int i = 0; i < 4; ++i) { s[tt][i] = __expf(s[tt][i] - m); sum += s[tt][i]; }
        sum = quad_sum(sum);
        const float inv = 1.0f / (sum + __expf(sink - m));
        f32x4 o[4];
#pragma unroll
        for (int dt = 0; dt < 4; ++dt) o[dt] = (f32x4){0.f, 0.f, 0.f, 0.f};
#pragma unroll
        for (int kk = 0; kk < 5; ++kk) {
            const bf16x8 pa = pack_p(s[2 * kk], s[2 * kk + 1]);
#pragma unroll
            for (int dt = 0; dt < 4; ++dt) {
                const LAS bf16* vp = Vs + (16 * t0 + 32 * kk) * 80 + 16 * dt;
                o[dt] = mma16(pa, kk < 4 ? frag_kperm_tr(vp, vpl, 0, 16 * 80) : frag_kperm_tr_lo(vp, vpl), o[dt]);
            }
            asm volatile("" ::: "memory");
        }
#pragma unroll
        for (int dt = 0; dt < 4; ++dt)
#ifdef GEMM56_F8
            { const float i8 = inv * BR8_SCALE; *(unsigned*)(orow8 + 16 * dt + 4 * fq) = pk4_fp8(o[dt][0] * i8, o[dt][1] * i8, o[dt][2] * i8, o[dt][3] * i8); }
#else
            *(u64*)(orow + 16 * dt + 4 * fq) = (u64)pk2(o[dt][0] * inv, o[dt][1] * inv) | ((u64)pk2(o[dt][2] * inv, o[dt][3] * inv) << 32);
#endif
    }
}
__device__ __forceinline__ void swa_phase(Frame& F) {
    constexpr int NU = NBATCH * NCHUNK * 2;
    v4u rk[4], rv[4];
    int u = blockIdx.x;
    if (u < NU) swa_load(F, u, rk, rv);
    for (; u < NU; u += F.G) {
        swa_stage(F, rk, rv);
        __syncthreads();
        if (u + F.G < NU) swa_load(F, u + F.G, rk, rv);
        swa_compute(F, u);
        __syncthreads();
    }
}

__device__ __forceinline__ void ret_load(Frame& F, int u, v4u (&rk)[2], v4u (&rs)[2], v4u (&rv)[4], bf16x8 (&qf)[2], u64 (&rgv)[8]) {
    const int b = u >> 8, n = (u >> 2) & 63, h = u & 3;
    const bf16* RK = (const bf16*)(F.ws + WS_RK); const bf16* RV = (const bf16*)(F.ws + WS_RV);
    {
        const bf16* RQ = (const bf16*)(F.ws + WS_RQ); const bf16* RG = (const bf16*)(F.ws + WS_RG);
        const size_t tok = (size_t)b * SEQ + (size_t)n * 128 + 16 * F.wave + F.fr;
#pragma unroll
        for (int ks = 0; ks < 2; ++ks) qf[ks] = *(const bf16x8*)(RQ + tok * 256 + h * 64 + 32 * ks + 8 * F.fq);
#pragma unroll
        for (int et = 0; et < 8; ++et) rgv[et] = *(const u64*)(RG + tok * 512 + h * 128 + 16 * et + 4 * F.fq);
    }
    const bf16* ST = (const bf16*)(F.ws + WS_ST) + ((size_t)((b * NCHUNK + n) * 4 + h)) * 8192;
    const size_t tok0 = (size_t)b * SEQ + (size_t)n * 128;
#pragma unroll
    for (int k = 0; k < 2; ++k) { const int idx = F.tid + NTHR * k, r = idx >> 3, c = idx & 7; rk[k] = *(const v4u*)(RK + (tok0 + r) * 256 + h * 64 + 8 * c); rs[k] = *(const v4u*)(ST + r * 64 + 8 * c); }
#pragma unroll
    for (int k = 0; k < 4; ++k) { const int idx = F.tid + NTHR * k, r = idx >> 4, c = idx & 15; rv[k] = *(const v4u*)(RV + (tok0 + r) * 512 + h * 128 + 8 * c); }
}
__device__ __forceinline__ void ret_stage(Frame& F, const v4u (&rk)[2], const v4u (&rs)[2], const v4u (&rv)[4]) {
    LAS bf16* Ks = (LAS bf16*)(F.lds);
    LAS bf16* Vs = (LAS bf16*)(F.lds + 18432);
    LAS bf16* St = (LAS bf16*)(F.lds + 18432 + 36864);
#pragma unroll
    for (int k = 0; k < 2; ++k) { const int idx = F.tid + NTHR * k, r = idx >> 3, c = idx & 7; *(LAS v4u*)(Ks + r * 72 + 8 * c) = rk[k]; *(LAS v4u*)(St + r * 72 + 8 * c) = rs[k]; }
#pragma unroll
    for (int k = 0; k < 4; ++k) { const int idx = F.tid + NTHR * k, r = idx >> 4, c = idx & 15; *(LAS v4u*)(Vs + r * 144 + 8 * c) = rv[k]; }
#if 0
    for (int k = 0; k < 4; ++k) { const int idx = F.tid + NTHR * k, r = idx & 127, c = idx >> 7; const v4u v = rv[k]; LAS bf16* d = Vt + (8 * c) * 136 + r;
        d[0 * 136] = (bf16)(v.x & 0xffffu); d[1 * 136] = (bf16)(v.x >> 16); d[2 * 136] = (bf16)(v.y & 0xffffu); d[3 * 136] = (bf16)(v.y >> 16); d[4 * 136] = (bf16)(v.z & 0xffffu); d[5 * 136] = (bf16)(v.z >> 16); d[6 * 136] = (bf16)(v.w & 0xffffu); d[7 * 136] = (bf16)(v.w >> 16); }
#endif
}
__device__ __forceinline__ void ret_compute(Frame& F, int u, const bf16x8 (&qf)[2], const u64 (&rgv)[8]) {
    const int b = u >> 8, n = (u >> 2) & 63, h = u & 3;
    LAS bf16* Ks = (LAS bf16*)(F.lds); LAS bf16* Vs = (LAS bf16*)(F.lds + 18432); LAS bf16* St = (LAS bf16*)(F.lds + 18432 + 36864);
    const bf16* RQ = (const bf16*)(F.ws + WS_RQ); const bf16* RG = (const bf16*)(F.ws + WS_RG);
    const size_t tok0 = (size_t)b * SEQ + (size_t)n * 128;
    const int w = F.wave, fr = F.fr, fq = F.fq;
    const float lg = ret_log2gamma(h);
    const int i = 16 * w + fr;
    const size_t tok = tok0 + i;
    f32x4 pt[8];
#pragma unroll
    for (int t = 0; t < 8; ++t) {
        f32x4 s = (f32x4){0.f, 0.f, 0.f, 0.f};
        if (t <= w) {
#pragma unroll
            for (int ks = 0; ks < 2; ++ks) s = mma16(qf[ks], *(const LAS bf16x8*)(Ks + (16 * t + fr) * 72 + 32 * ks + 8 * fq), s);
        }
#pragma unroll
        for (int ii = 0; ii < 4; ++ii) { const int j = 16 * t + 4 * fq + ii; pt[t][ii] = (i >= j) ? s[ii] * exp2f(lg * (float)(i - j)) : 0.f; }
    }
    f32x4 o1[8], o2[8];
    const int vpl = (4 * fq + (fr >> 2)) * 144 + 4 * (fr & 3);
#pragma unroll
    for (int et = 0; et < 8; ++et) { o1[et] = (f32x4){0.f, 0.f, 0.f, 0.f}; o2[et] = (f32x4){0.f, 0.f, 0.f, 0.f}; }
#pragma unroll
    for (int ks = 0; ks < 4; ++ks) {
        if (2 * ks <= w) {
            const bf16x8 pa = pack_p(pt[2 * ks], pt[2 * ks + 1]);
#pragma unroll
            for (int et = 0; et < 8; ++et) o1[et] = mma16(pa, frag_kperm_tr(Vs, vpl, 32 * ks * 144 + 16 * et, (32 * ks + 16) * 144 + 16 * et), o1[et]);
            asm volatile("" ::: "memory");
        }
    }
#pragma unroll
    for (int ks = 0; ks < 2; ++ks)
#pragma unroll
        for (int et = 0; et < 8; ++et) o2[et] = mma16(qf[ks], *(const LAS bf16x8*)(St + (16 * et + fr) * 72 + 32 * ks + 8 * fq), o2[et]);
    const float wq = exp2f(lg * (float)(i + 1));
    float sum = 0.f;
#pragma unroll
    for (int et = 0; et < 8; ++et) { o1[et] = o1[et] + o2[et] * wq; sum += (o1[et][0] + o1[et][1]) + (o1[et][2] + o1[et][3]); }
    const float mean = quad_sum(sum) * (1.f / 128.f);
    float s2 = 0.f;
#pragma unroll
    for (int et = 0; et < 8; ++et) { o1[et] = o1[et] - mean; s2 += (o1[et][0] * o1[et][0] + o1[et][1] * o1[et][1]) + (o1[et][2] * o1[et][2] + o1[et][3] * o1[et][3]); }
    const float rstd = 1.f / sqrtf(quad_sum(s2) * (1.f / 128.f) + LN_EPS);
    const float* gng = karg_in(5) + h * 128;
#pragma unroll
    for (int et = 0; et < 8; ++et) {
        const int e = 16 * et + 4 * fq;
        const f32x4 gg = *(const f32x4*)(gng + e);
        const unsigned long long rgp = rgv[et];
        const unsigned r0 = (unsigned)rgp, r1 = (unsigned)(rgp >> 32);
        const float a0 = o1[et][0] * rstd * gg[0] * bflo(r0), a1 = o1[et][1] * rstd * gg[1] * bfhi(r0);
        const float a2 = o1[et][2] * rstd * gg[2] * bflo(r1), a3 = o1[et][3] * rstd * gg[3] * bfhi(r1);
#ifdef GEMM56_F8
        *(unsigned*)((unsigned char*)F.out + (size_t)T * 512 + tok * 512 + h * 128 + e) = pk4_fp8(a0 * BR8_SCALE, a1 * BR8_SCALE, a2 * BR8_SCALE, a3 * BR8_SCALE);
#else
        *(u64*)((bf16*)F.out + (size_t)T * 512 + tok * 512 + h * 128 + e) = (u64)pk2(a0, a1) | ((u64)pk2(a2, a3) << 32);
#endif
    }
}
__device__ __forceinline__ void ret_phase(Frame& F, int xflags = 0) {
    constexpr int NU = NBATCH * NCHUNK * 4;
    v4u rk[2], rs[2], rv[4]; bf16x8 qn[2]; u64 gn[8];
    int u = blockIdx.x;
    if (u < NU) ret_load(F, u, rk, rs, rv, qn, gn);
    for (; u < NU; u += F.G) {
#ifdef EXP_RET
        if (!(xflags & 8))
#endif
        ret_stage(F, rk, rs, rv);
        bf16x8 qc[2] = {qn[0], qn[1]}; u64 gc[8];
#pragma unroll
        for (int et = 0; et < 8; ++et) gc[et] = gn[et];
        __syncthreads();
        if (u + F.G < NU) ret_load(F, u + F.G, rk, rs, rv, qn, gn);
#ifdef EXP_RET
        if (!(xflags & 16))
#endif
        ret_compute(F, u, qc, gc);
        __syncthreads();
    }
}

__device__ __forceinline__ void xattn_unit(Frame& F, int b, int h, int sq) {
    LAS bf16* Ks = (LAS bf16*)(F.lds);
    LAS bf16* Vt = (LAS bf16*)(F.lds + 69632);
    const bf16* MQ = (const bf16*)(F.ws + WS_MQ); const bf16* MK = (const bf16*)(F.ws + WS_MK);
    const bf16* MVT = (const bf16*)(F.ws + WS_MVT) + (size_t)(b * 4 + h) * 128 * 256;
#pragma unroll 2
    for (int idx = F.tid; idx < 256 * 16; idx += NTHR) { const int r = idx >> 4, c = idx & 15; *(LAS v4u*)(Ks + r * 136 + 8 * c) = *(const v4u*)(MK + (size_t)(b * 256 + r) * 512 + h * 128 + 8 * c); }
#pragma unroll 2
    for (int idx = F.tid; idx < 128 * 32; idx += NTHR) { const int r = idx >> 5, c = idx & 31; *(LAS v4u*)(Vt + r * 264 + 8 * c) = *(const v4u*)(MVT + r * 256 + 8 * c); }
    __syncthreads();
    const int w = F.wave, fr = F.fr, fq = F.fq;
    const float scale = 0.08838834764831845f;
    for (int sub = 0; sub < 4; ++sub) {
        const size_t tok = (size_t)b * SEQ + (size_t)sq * 1024 + sub * 256 + 32 * w + fr;
        const bf16* qrow = MQ + tok * 512 + h * 128;
#ifdef GEMM56_F8
        unsigned char* orow8 = (unsigned char*)F.out + (size_t)T * 1024 + tok * 512 + h * 128;
#else
        bf16* orow = (bf16*)F.out + (size_t)T * 1024 + tok * 512 + h * 128;
#endif
        bf16x8 qa[4], qb[4];
#pragma unroll
        for (int ks = 0; ks < 4; ++ks) { qa[ks] = *(const bf16x8*)(qrow + 32 * ks + 8 * fq); qb[ks] = *(const bf16x8*)(qrow + 16 * 512 + 32 * ks + 8 * fq); }
        f32x4 sa[16], sb[16];
#pragma unroll
        for (int t = 0; t < 16; ++t) {
            sa[t] = (f32x4){0.f, 0.f, 0.f, 0.f}; sb[t] = (f32x4){0.f, 0.f, 0.f, 0.f};
#pragma unroll
            for (int ks = 0; ks < 4; ++ks) { const bf16x8 kf = *(const LAS bf16x8*)(Ks + (16 * t + fr) * 136 + 32 * ks + 8 * fq); sa[t] = mma16(qa[ks], kf, sa[t]); sb[t] = mma16(qb[ks], kf, sb[t]); }
            if (t & 1) asm volatile("" ::: "memory");
        }
        float mxa = -INFINITY, mxb = -INFINITY;
#pragma unroll
        for (int t = 0; t < 16; ++t)
#pragma unroll
            for (int i = 0; i < 4; ++i) { sa[t][i] *= scale; mxa = fmaxf(mxa, sa[t][i]); sb[t][i] *= scale; mxb = fmaxf(mxb, sb[t][i]); }
        mxa = quad_max(mxa); mxb = quad_max(mxb);
        float suma = 0.f, sumb = 0.f;
#pragma unroll
        for (int t = 0; t < 16; ++t)
#pragma unroll
            for (int i = 0; i < 4; ++i) { sa[t][i] = __expf(sa[t][i] - mxa); suma += sa[t][i]; sb[t][i] = __expf(sb[t][i] - mxb); sumb += sb[t][i]; }
        const float inva = 1.0f / quad_sum(suma), invb = 1.0f / quad_sum(sumb);
        bf16x8 pa[8], pb[8];
#pragma unroll
        for (int ks = 0; ks < 8; ++ks) { pa[ks] = pack_p(sa[2 * ks], sa[2 * ks + 1]); pb[ks] = pack_p(sb[2 * ks], sb[2 * ks + 1]); }
        asm volatile("" ::: "memory");
#pragma unroll
        for (int dh = 0; dh < 2; ++dh) {
            f32x4 oa[4], ob[4];
#pragma unroll
            for (int dt = 0; dt < 4; ++dt) { oa[dt] = (f32x4){0.f, 0.f, 0.f, 0.f}; ob[dt] = (f32x4){0.f, 0.f, 0.f, 0.f}; }
#pragma unroll
            for (int ks = 0; ks < 8; ++ks) {
#pragma unroll
                for (int dt = 0; dt < 4; ++dt) { const bf16x8 vf = frag_kperm(Vt + (16 * (4 * dh + dt) + fr) * 264 + 32 * ks, fq); oa[dt] = mma16(pa[ks], vf, oa[dt]); ob[dt] = mma16(pb[ks], vf, ob[dt]); }
                asm volatile("" ::: "memory");
            }
#pragma unroll
            for (int dt = 0; dt < 4; ++dt) {
#ifdef GEMM56_F8
                { const float ia = inva * BR8_SCALE, ib = invb * BR8_SCALE;
                  *(unsigned*)(orow8 + 16 * (4 * dh + dt) + 4 * fq) = pk4_fp8(oa[dt][0] * ia, oa[dt][1] * ia, oa[dt][2] * ia, oa[dt][3] * ia);
                  *(unsigned*)(orow8 + 16 * 512 + 16 * (4 * dh + dt) + 4 * fq) = pk4_fp8(ob[dt][0] * ib, ob[dt][1] * ib, ob[dt][2] * ib, ob[dt][3] * ib); }
#else
                *(u64*)(orow + 16 * (4 * dh + dt) + 4 * fq) = (u64)pk2(oa[dt][0] * inva, oa[dt][1] * inva) | ((u64)pk2(oa[dt][2] * inva, oa[dt][3] * inva) << 32);
                *(u64*)(orow + 16 * 512 + 16 * (4 * dh + dt) + 4 * fq) = (u64)pk2(ob[dt][0] * invb, ob[dt][1] * invb) | ((u64)pk2(ob[dt][2] * invb, ob[dt][3] * invb) << 32);
#endif
            }
        }
    }
    __syncthreads();
}

__device__ __forceinline__ unsigned f2ord(float f) { const unsigned u = __float_as_uint(f); return u ^ ((unsigned)((int)u >> 31) | 0x80000000u); }
__device__ __forceinline__ float ord2f(unsigned o) { return __uint_as_float(o ^ (~(unsigned)((int)o >> 31) | 0x80000000u)); }
template <int N> __device__ __forceinline__ void bitonic_sort_desc(unsigned (&a)[N]) {
#pragma unroll
    for (int k = 2; k <= N; k <<= 1)
#pragma unroll
        for (int j = k >> 1; j > 0; j >>= 1)
#pragma unroll
            for (int i = 0; i < N; ++i) { const int l = i ^ j; if (l > i) { const bool desc = ((i & k) == 0); const unsigned hi = max(a[i], a[l]), lo = min(a[i], a[l]); a[i] = desc ? hi : lo; a[l] = desc ? lo : hi; } }
}
__device__ __forceinline__ void sort16_desc(unsigned (&a)[16]) {
#define CE_(i, j) do { const unsigned hi_ = max(a[i], a[j]), lo_ = min(a[i], a[j]); a[i] = hi_; a[j] = lo_; } while (0)
    CE_(0, 13); CE_(1, 12); CE_(2, 15); CE_(3, 14); CE_(4, 8); CE_(5, 6); CE_(7, 11); CE_(9, 10);
    CE_(0, 5); CE_(1, 7); CE_(2, 9); CE_(3, 4); CE_(6, 13); CE_(8, 14); CE_(10, 15); CE_(11, 12);
    CE_(0, 1); CE_(2, 3); CE_(4, 5); CE_(6, 8); CE_(7, 9); CE_(10, 11); CE_(12, 13); CE_(14, 15);
    CE_(0, 2); CE_(1, 3); CE_(4, 10); CE_(5, 11); CE_(6, 7); CE_(8, 9); CE_(12, 14); CE_(13, 15);
    CE_(1, 2); CE_(3, 12); CE_(4, 6); CE_(5, 7); CE_(8, 10); CE_(9, 11); CE_(13, 14);
    CE_(1, 4); CE_(2, 6); CE_(5, 8); CE_(7, 10); CE_(9, 13); CE_(11, 14);
    CE_(2, 4); CE_(3, 6); CE_(9, 12); CE_(11, 13);
    CE_(3, 5); CE_(6, 8); CE_(7, 9); CE_(10, 12);
    CE_(3, 4); CE_(5, 6); CE_(7, 8); CE_(9, 10); CE_(11, 12);
    CE_(6, 7); CE_(8, 9);
#undef CE_
}
template <int N> __device__ __forceinline__ void bitonic_merge_desc(unsigned (&a)[N]) {
#pragma unroll
    for (int j = N >> 1; j > 0; j >>= 1)
#pragma unroll
        for (int i = 0; i < N; ++i) { const int l = i ^ j; if (l > i) { const unsigned hi = max(a[i], a[l]), lo = min(a[i], a[l]); a[i] = hi; a[l] = lo; } }
}
__device__ __forceinline__ void merge_top16(unsigned (&L)[16], const unsigned (&R)[16]) {
#pragma unroll
    for (int i = 0; i < 16; ++i) L[i] = max(L[i], R[15 - i]);
    bitonic_merge_desc<16>(L);
}
__device__ __forceinline__ unsigned tab_lookup(u64 tlo, u64 thi, unsigned i) {
    const u64 v = (i & 8u) ? thi : tlo;
    return (unsigned)(v >> ((i & 7u) * 8u)) & 0xffu;
}
__device__ __forceinline__ float dot2_bf16(unsigned w, unsigned x, float acc) { return __builtin_amdgcn_fdot2_f32_bf16(__builtin_bit_cast(bf16x2_t, w), __builtin_bit_cast(bf16x2_t, x), acc, false); }
__device__ __forceinline__ float dot4_fp8_bf16(unsigned w, unsigned hlo, unsigned hhi, float acc) {
    const bf16x2_t a = __builtin_amdgcn_cvt_scalef32_pk_bf16_fp8(w, 1.0f / PU_SCALE, false), b = __builtin_amdgcn_cvt_scalef32_pk_bf16_fp8(w, 1.0f / PU_SCALE, true);
    acc = __builtin_amdgcn_fdot2_f32_bf16(a, __builtin_bit_cast(bf16x2_t, hlo), acc, false);
    return __builtin_amdgcn_fdot2_f32_bf16(b, __builtin_bit_cast(bf16x2_t, hhi), acc, false);
}
typedef float f32x2_t __attribute__((ext_vector_type(2)));
__device__ __forceinline__ void axpy4_fp8(unsigned w, float c, float& o0, float& o1, float& o2, float& o3) {
    const f32x2_t lo = __builtin_amdgcn_cvt_pk_f32_fp8(w, false), hi = __builtin_amdgcn_cvt_pk_f32_fp8(w, true);
    o0 += c * lo.x; o1 += c * lo.y; o2 += c * hi.x; o3 += c * hi.y;
}
__device__ __forceinline__ float gelu_erf(float x) { return 0.5f * x * (1.0f + erff(x * 0.70710678118654752f)); }

constexpr int CW_PACE = 8192;
__device__ __forceinline__ void xcd_pace(const XcdBarrier& b, unsigned* pace) {
    __syncthreads();
    if (threadIdx.x == 0 && b.st != nullptr) {
        const unsigned nloc = b.st[0];
        if (nloc > 1u) {
            const unsigned old = xb_add(&pace[64 * b.x], 1u), target = (old / nloc + 1u) * nloc;
            unsigned sp = 0u;
            while (xb_ld(&pace[64 * b.x]) < target) { __builtin_amdgcn_s_sleep(1); if (++sp > (1u << 17)) break; }
        }
    }
    __syncthreads();
}
__device__ __forceinline__ float sum8_lo(float d) { d += dpp<XOR1>(d); d += dpp<XOR2>(d); d += dpp<XOR7>(d); return d; }
__device__ __forceinline__ float sum8_hi(float d) { d += dpp<XOR8>(d); return xrow16_sum(d); }

__device__ __forceinline__ int opaque_v(int x) { asm volatile("" : "+v"(x)); return x; }
__device__ __forceinline__ void peer_route_scores(Frame& F, size_t tokb, int hh, int p, const LAS unsigned char* SKp, unsigned (&topp)[16]) {
    const bf16* PQ = (const bf16*)(F.ws + WS_PQ);
    const int w = F.wave, ln_ = opaque_v(F.lane), fr = ln_ & 15, fq = ln_ >> 4;
    const size_t row = tokb + 16 * w + fr;
                bf16x8 qf[4];
#pragma unroll
                for (int ks = 0; ks < 4; ++ks) qf[ks] = *(const bf16x8*)(PQ + row * 2048 + hh * 256 + p * 128 + 32 * ks + 8 * fq);
                unsigned lo[16], hi[16];
#pragma unroll
                for (int t = 0; t < 8; ++t) {
                    f32x4 s = (f32x4){0.f, 0.f, 0.f, 0.f};
                    const int kr = 16 * t + fr;
#pragma unroll
                    for (int ks = 0; ks < 4; ++ks) s = mma16(qf[ks], *(const LAS bf16x8*)(SKp + kr * 256 + (((4 * ks + fq) ^ (kr & 15)) << 4)), s);
#pragma unroll
                    for (int i = 0; i < 4; ++i) {
                        const unsigned key = (f2ord(s[i]) & ~0x7fu) | (unsigned)(127 - (16 * t + 4 * fq + i));
                        if (t < 4) lo[4 * t + i] = key; else hi[4 * (t - 4) + i] = key;
                    }
                }
                sort16_desc(lo); sort16_desc(hi);
                merge_top16(lo, hi);
#pragma unroll
                for (int mask = 16; mask <= 32; mask <<= 1) {
                    unsigned r[16];
#pragma unroll
                    for (int i = 0; i < 16; ++i) r[i] = __shfl_xor(lo[i], mask);
                    merge_top16(lo, r);
                }
#pragma unroll
                for (int i = 0; i < 16; ++i) topp[i] = lo[i];
}
#ifdef PEER_CANDS_REDUNDANT
__device__ __forceinline__ void peer_route_cands(Frame& F, int hh, const unsigned (&top0)[16], const unsigned (&top1)[16], LAS u16* EI, LAS bf16* GWb) {
    const int w = F.wave, ln_ = opaque_v(F.lane), fr = ln_ & 15, fq = ln_ >> 4;
            float sv0[16], sv1[16]; u64 t0lo = 0ull, t0hi = 0ull, t1lo = 0ull, t1hi = 0ull;
#pragma unroll
            for (int i = 0; i < 16; ++i) {
                sv0[i] = ord2f(top0[i] & ~0x7fu); sv1[i] = ord2f(top1[i] & ~0x7fu);
                const u64 n0 = (u64)(127u - (top0[i] & 0x7fu)) << ((i & 7) * 8), n1 = (u64)(127u - (top1[i] & 0x7fu)) << ((i & 7) * 8);
                if (i < 8) { t0lo |= n0; t1lo |= n1; } else { t0hi |= n0; t1hi |= n1; }
            }
#define CKEY(i, j) ((f2ord(sv0[i] + sv1[j]) & ~0xffu) | (unsigned)(255 - (16 * (i) + (j))))
            unsigned L[16], R[16];
#pragma unroll
            for (int j = 0; j < 16; ++j) L[j] = CKEY(0, j);
#pragma unroll
            for (int j = 0; j < 16; ++j) R[j] = (j < 8) ? CKEY(1, j) : 0u;
            merge_top16(L, R);
            R[0] = CKEY(2, 0); R[1] = CKEY(2, 1); R[2] = CKEY(2, 2); R[3] = CKEY(2, 3); R[4] = CKEY(2, 4);
            R[5] = CKEY(3, 0); R[6] = CKEY(3, 1); R[7] = CKEY(3, 2); R[8] = CKEY(3, 3);
            R[9] = CKEY(4, 0); R[10] = CKEY(4, 1); R[11] = CKEY(4, 2);
            R[12] = CKEY(5, 0); R[13] = CKEY(5, 1); R[14] = CKEY(6, 0); R[15] = CKEY(6, 1);
            bitonic_sort_desc<16>(R); merge_top16(L, R);
            R[0] = CKEY(7, 0); R[1] = CKEY(7, 1);
            R[2] = CKEY(8, 0); R[3] = CKEY(9, 0); R[4] = CKEY(10, 0); R[5] = CKEY(11, 0); R[6] = CKEY(12, 0); R[7] = CKEY(13, 0); R[8] = CKEY(14, 0); R[9] = CKEY(15, 0);
            R[10] = 0u; R[11] = 0u; R[12] = 0u; R[13] = 0u; R[14] = 0u; R[15] = 0u;
            bitonic_sort_desc<16>(R); merge_top16(L, R);
#undef CKEY
            float ts[16], sum = 0.f; unsigned ei[16];
#pragma unroll
            for (int k = 0; k < 16; ++k) {
                ts[k] = ord2f(L[k] & ~0xffu);
                const unsigned ij = 255u - (L[k] & 0xffu);
                ei[k] = tab_lookup(t0lo, t0hi, ij >> 4) * 128u + tab_lookup(t1lo, t1hi, ij & 15u);
            }
            const float tmax = ts[0];
#pragma unroll
            for (int k = 0; k < 16; ++k) { ts[k] = __expf(ts[k] - tmax); sum += ts[k]; }
            const float inv = 1.0f / sum;
            if (fq == 0) {
                const int tl = 16 * w + fr;
#pragma unroll
                for (int k = 0; k < 16; ++k) { EI[tl * 128 + hh * 16 + k] = (u16)ei[k]; GWb[tl * 128 + hh * 16 + k] = (bf16)f2bf(ts[k] * inv); }
            }
}

#else
__device__ __forceinline__ void peer_route_cands(Frame& F, int hh, const unsigned (&top0)[16], const unsigned (&top1)[16], LAS u16* EI, LAS bf16* GWb, LAS unsigned* TS) {
    const int w = F.wave, ln_ = opaque_v(F.lane), fr = ln_ & 15, fq = ln_ >> 4;
    LAS unsigned* ts_ = TS + (w * 16 + fr) * 36;
    if (fq == 0) {
#pragma unroll
        for (int q = 0; q < 4; ++q) { *(LAS v4u*)(ts_ + 4 * q) = (v4u){top0[4 * q], top0[4 * q + 1], top0[4 * q + 2], top0[4 * q + 3]}; *(LAS v4u*)(ts_ + 16 + 4 * q) = (v4u){top1[4 * q], top1[4 * q + 1], top1[4 * q + 2], top1[4 * q + 3]}; }
    }
    const u64 IA = fq == 0 ? 0x0000000000000ull : fq == 1 ? 0x2211111111000ull : fq == 2 ? 0x0554443333222ull : 0x0FEDCBA987766ull;
    const u64 JB = fq == 0 ? 0xCBA9876543210ull : fq == 1 ? 0x1076543210FEDull : fq == 2 ? 0x0102103210432ull : 0x0000000001010ull;
    LDS_WAIT();
    unsigned C[16];
#pragma unroll
    for (int sl = 0; sl < 13; ++sl) {
        const unsigned ia = (unsigned)(IA >> (4 * sl)) & 15u, jb = (unsigned)(JB >> (4 * sl)) & 15u;
        const unsigned ka = ts_[ia], kb = ts_[16 + jb];
        const unsigned key = (f2ord(ord2f(ka & ~0x7fu) + ord2f(kb & ~0x7fu)) & ~0xffu) | (255u - (16u * ia + jb));
        C[sl] = (sl == 12 && fq >= 2) ? 0u : key;
    }
    C[13] = 0u; C[14] = 0u; C[15] = 0u;
    sort16_desc(C);
#pragma unroll
    for (int mask = 16; mask <= 32; mask <<= 1) {
        unsigned r[16];
#pragma unroll
        for (int i = 0; i < 16; ++i) r[i] = __shfl_xor(C[i], mask);
        merge_top16(C, r);
    }
    const float tmax = ord2f(C[0] & ~0xffu);
    float pr[4], sum = 0.f; unsigned ei[4];
    const unsigned m1 = 0u - (unsigned)(fq & 1), m2 = 0u - (unsigned)((fq >> 1) & 1);
#pragma unroll
    for (int q = 0; q < 4; ++q) {
        const unsigned lo_ = (C[4 + q] & m1) | (C[q] & ~m1), hi_ = (C[12 + q] & m1) | (C[8 + q] & ~m1), k = (hi_ & m2) | (lo_ & ~m2);
        const unsigned ij = 255u - (k & 0xffu);
        const unsigned ka = ts_[ij >> 4], kb = ts_[16 + (ij & 15u)];
        ei[q] = (127u - (ka & 0x7fu)) * 128u + (127u - (kb & 0x7fu));
        pr[q] = __expf(ord2f(k & ~0xffu) - tmax); sum += pr[q];
    }
    const float inv = 1.0f / xrow16_sum(sum);
    const int o_ = (16 * w + fr) * 128 + hh * 16 + 4 * fq;
    *(LAS u64*)(EI + o_) = (u64)(ei[0] | (ei[1] << 16)) | ((u64)(ei[2] | (ei[3] << 16)) << 32);
    *(LAS u64*)(GWb + o_) = (u64)(f2bf(pr[0] * inv) | (f2bf(pr[1] * inv) << 16)) | ((u64)(f2bf(pr[2] * inv) | (f2bf(pr[3] * inv) << 16)) << 32);
}
#endif

template <int CTRL> __device__ __forceinline__ int dppi(int x) { return __builtin_amdgcn_mov_dpp(x, CTRL, 0xf, 0xf, true); }
__device__ __forceinline__ int isum8_lo(int d) { d += dppi<XOR1>(d); d += dppi<XOR2>(d); d += dppi<XOR7>(d); return d; }
__device__ __forceinline__ int sdot16(v4u a, v4u b, int acc) {
    acc = __builtin_amdgcn_sdot4((int)a.x, (int)b.x, acc, false); acc = __builtin_amdgcn_sdot4((int)a.y, (int)b.y, acc, false);
    acc = __builtin_amdgcn_sdot4((int)a.z, (int)b.z, acc, false); return __builtin_amdgcn_sdot4((int)a.w, (int)b.w, acc, false);
}
__device__ __forceinline__ int ixrow16_sum(int x) {
    auto s = __builtin_amdgcn_permlane16_swap((unsigned)x, (unsigned)x, false, false);
    x = (int)(s[0] + s[1]);
    auto t = __builtin_amdgcn_permlane32_swap((unsigned)x, (unsigned)x, false, false);
    return (int)(t[0] + t[1]);
}
__device__ __forceinline__ int isum8_hi(int d) { d += dppi<XOR8>(d); return ixrow16_sum(d); }
__device__ __forceinline__ void vred16_hi(int (&a)[16], int& d0, int& d1, int lane) {
#pragma unroll
    for (int i = 0; i < 8; ++i) { auto s = __builtin_amdgcn_permlane32_swap((unsigned)a[i], (unsigned)a[i + 8], false, false); a[i] = (int)(s[0] + s[1]); }
#pragma unroll
    for (int i = 0; i < 4; ++i) { auto s = __builtin_amdgcn_permlane16_swap((unsigned)a[i], (unsigned)a[i + 4], false, false); a[i] = (int)(s[0] + s[1]); }
    const bool b3 = (lane & 8) != 0;
    d0 = (b3 ? a[2] : a[0]) + dppi<XOR8>(b3 ? a[0] : a[2]);
    d1 = (b3 ? a[3] : a[1]) + dppi<XOR8>(b3 ? a[1] : a[3]);
}
__device__ __forceinline__ void tr_dot4_quad(unsigned A, unsigned B, unsigned C, unsigned D, unsigned cq, int& a0, int& a1, int& a2, int& a3) {
    const unsigned t0 = __builtin_amdgcn_perm(B, A, 0x05010400u), t1 = __builtin_amdgcn_perm(B, A, 0x07030602u);
    const unsigned u0 = __builtin_amdgcn_perm(D, C, 0x05010400u), u1 = __builtin_amdgcn_perm(D, C, 0x07030602u);
    a0 = __builtin_amdgcn_sdot4((int)__builtin_amdgcn_perm(u0, t0, 0x05040100u), (int)cq, a0, false);
    a1 = __builtin_amdgcn_sdot4((int)__builtin_amdgcn_perm(u0, t0, 0x07060302u), (int)cq, a1, false);
    a2 = __builtin_amdgcn_sdot4((int)__builtin_amdgcn_perm(u1, t1, 0x05040100u), (int)cq, a2, false);
    a3 = __builtin_amdgcn_sdot4((int)__builtin_amdgcn_perm(u1, t1, 0x07060302u), (int)cq, a3, false);
}
__device__ __forceinline__ int sdot4_z(unsigned a, unsigned b) { int d; asm("v_dot4_i32_i8 %0, %1, %2, 0" : "=v"(d) : "v"(a), "v"(b)); return d; }
__device__ __forceinline__ void tr_dot4_quad_z(unsigned A, unsigned B, unsigned C, unsigned D, unsigned cq, int& a0, int& a1, int& a2, int& a3) {
    const unsigned t0 = __builtin_amdgcn_perm(B, A, 0x05010400u), t1 = __builtin_amdgcn_perm(B, A, 0x07030602u);
    const unsigned u0 = __builtin_amdgcn_perm(D, C, 0x05010400u), u1 = __builtin_amdgcn_perm(D, C, 0x07030602u);
    a0 = sdot4_z(__builtin_amdgcn_perm(u0, t0, 0x05040100u), cq); a1 = sdot4_z(__builtin_amdgcn_perm(u0, t0, 0x07060302u), cq);
    a2 = sdot4_z(__builtin_amdgcn_perm(u1, t1, 0x05040100u), cq); a3 = sdot4_z(__builtin_amdgcn_perm(u1, t1, 0x07060302u), cq);
}
__device__ __forceinline__ void tr_dot4_z(v4u A, v4u B, v4u C, v4u D, unsigned cq, int (&acc)[16]) {
    tr_dot4_quad_z(A.x, B.x, C.x, D.x, cq, acc[0], acc[1], acc[2], acc[3]); tr_dot4_quad_z(A.y, B.y, C.y, D.y, cq, acc[4], acc[5], acc[6], acc[7]);
    tr_dot4_quad_z(A.z, B.z, C.z, D.z, cq, acc[8], acc[9], acc[10], acc[11]); tr_dot4_quad_z(A.w, B.w, C.w, D.w, cq, acc[12], acc[13], acc[14], acc[15]);
}
__device__ __forceinline__ void tr_dot4(v4u A, v4u B, v4u C, v4u D, unsigned cq, int (&acc)[16]) {
    tr_dot4_quad(A.x, B.x, C.x, D.x, cq, acc[0], acc[1], acc[2], acc[3]); tr_dot4_quad(A.y, B.y, C.y, D.y, cq, acc[4], acc[5], acc[6], acc[7]);
    tr_dot4_quad(A.z, B.z, C.z, D.z, cq, acc[8], acc[9], acc[10], acc[11]); tr_dot4_quad(A.w, B.w, C.w, D.w, cq, acc[12], acc[13], acc[14], acc[15]);
}
__device__ __forceinline__ int sdot32_i4(v4u u, const unsigned (&he)[4], const unsigned (&ho)[4]) {
    int acc = 0;
    acc = __builtin_amdgcn_sdot4((int)(u.x & 0xf0f0f0f0u), (int)ho[0], acc, false); acc = __builtin_amdgcn_sdot4((int)((u.x << 4) & 0xf0f0f0f0u), (int)he[0], acc, false);
    acc = __builtin_amdgcn_sdot4((int)(u.y & 0xf0f0f0f0u), (int)ho[1], acc, false); acc = __builtin_amdgcn_sdot4((int)((u.y << 4) & 0xf0f0f0f0u), (int)he[1], acc, false);
    acc = __builtin_amdgcn_sdot4((int)(u.z & 0xf0f0f0f0u), (int)ho[2], acc, false); acc = __builtin_amdgcn_sdot4((int)((u.z << 4) & 0xf0f0f0f0u), (int)he[2], acc, false);
    acc = __builtin_amdgcn_sdot4((int)(u.w & 0xf0f0f0f0u), (int)ho[3], acc, false); return __builtin_amdgcn_sdot4((int)((u.w << 4) & 0xf0f0f0f0u), (int)he[3], acc, false);
}
__device__ __forceinline__ int sdot32_i4_planes(v4u u, v4u hi, v4u lo) {
    int ah, al;
    asm("v_dot8_i32_i4 %0, %1, %2, 0" : "=v"(ah) : "v"(u.x), "v"(hi.x));
    asm("v_dot8_i32_i4 %0, %1, %2, 0" : "=v"(al) : "v"(u.x), "v"(lo.x));
    ah = __builtin_amdgcn_sdot8((int)u.y, (int)hi.y, ah, false); al = __builtin_amdgcn_sdot8((int)u.y, (int)lo.y, al, false);
    ah = __builtin_amdgcn_sdot8((int)u.z, (int)hi.z, ah, false); al = __builtin_amdgcn_sdot8((int)u.z, (int)lo.z, al, false);
    ah = __builtin_amdgcn_sdot8((int)u.w, (int)hi.w, ah, false); al = __builtin_amdgcn_sdot8((int)u.w, (int)lo.w, al, false);
    return (ah << 4) + al;
}
__device__ __forceinline__ void sdot32_i4_planes_init(v4u u, v4u hi, v4u lo, int& ah, int& al) {
    asm("v_dot8_i32_i4 %0, %1, %2, 0" : "=v"(ah) : "v"(u.x), "v"(hi.x));
    asm("v_dot8_i32_i4 %0, %1, %2, 0" : "=v"(al) : "v"(u.x), "v"(lo.x));
    ah = __builtin_amdgcn_sdot8((int)u.y, (int)hi.y, ah, false); al = __builtin_amdgcn_sdot8((int)u.y, (int)lo.y, al, false);
    ah = __builtin_amdgcn_sdot8((int)u.z, (int)hi.z, ah, false); al = __builtin_amdgcn_sdot8((int)u.z, (int)lo.z, al, false);
    ah = __builtin_amdgcn_sdot8((int)u.w, (int)hi.w, ah, false); al = __builtin_amdgcn_sdot8((int)u.w, (int)lo.w, al, false);
}
__device__ __forceinline__ void sdot32_i4_planes_acc(v4u u, v4u hi, v4u lo, int& ah, int& al) {
    ah = __builtin_amdgcn_sdot8((int)u.x, (int)hi.x, ah, false); al = __builtin_amdgcn_sdot8((int)u.x, (int)lo.x, al, false);
    ah = __builtin_amdgcn_sdot8((int)u.y, (int)hi.y, ah, false); al = __builtin_amdgcn_sdot8((int)u.y, (int)lo.y, al, false);
    ah = __builtin_amdgcn_sdot8((int)u.z, (int)hi.z, ah, false); al = __builtin_amdgcn_sdot8((int)u.z, (int)lo.z, al, false);
    ah = __builtin_amdgcn_sdot8((int)u.w, (int)hi.w, ah, false); al = __builtin_amdgcn_sdot8((int)u.w, (int)lo.w, al, false);
}
__device__ __forceinline__ void ured16_lo(const int (&d)[16], int& o0, int& o1, int lane) {
    const bool b2 = (lane & 4) != 0, b0 = (lane & 1) != 0, b1 = (lane & 2) != 0;
    int x[8], y[4];
#pragma unroll
    for (int i = 0; i < 8; ++i) x[i] = (b2 ? d[i + 8] : d[i]) + dppi<XOR7>(b2 ? d[i] : d[i + 8]);
#pragma unroll
    for (int i = 0; i < 4; ++i) y[i] = (b0 ? x[i + 4] : x[i]) + dppi<XOR1>(b0 ? x[i] : x[i + 4]);
    o0 = (b1 ? y[2] : y[0]) + dppi<XOR2>(b1 ? y[0] : y[2]);
    o1 = (b1 ? y[3] : y[1]) + dppi<XOR2>(b1 ? y[1] : y[3]);
}
__device__ __forceinline__ void load_eids(const LAS u16* EI, int tl, int r, unsigned (&e)[16]) {
    const v4u a = *(const LAS v4u*)(EI + tl * 128 + r * 16), b = *(const LAS v4u*)(EI + tl * 128 + r * 16 + 8);
    e[0] = a.x & 0xffffu; e[1] = a.x >> 16; e[2] = a.y & 0xffffu; e[3] = a.y >> 16; e[4] = a.z & 0xffffu; e[5] = a.z >> 16; e[6] = a.w & 0xffffu; e[7] = a.w >> 16;
    e[8] = b.x & 0xffffu; e[9] = b.x >> 16; e[10] = b.y & 0xffffu; e[11] = b.y >> 16; e[12] = b.z & 0xffffu; e[13] = b.z >> 16; e[14] = b.w & 0xffffu; e[15] = b.w >> 16;
}
__device__ __forceinline__ void load_eoffs(const LAS u16* EI, int tl, int r, unsigned c16, unsigned (&e)[16]) {
    const v4u a = *(const LAS v4u*)(EI + tl * 128 + r * 16), b = *(const LAS v4u*)(EI + tl * 128 + r * 16 + 8);
    const unsigned p[8] = {a.x, a.y, a.z, a.w, b.x, b.y, b.z, b.w};
#pragma unroll
    for (int k = 0; k < 8; ++k) { e[2 * k] = ((p[k] & 0xffffu) << 7) | c16; e[2 * k + 1] = ((p[k] >> 9) & 0x7fff80u) | c16; }
}

__device__ __forceinline__ void ln2_store(const u64 (&h)[4], const u64 (&po)[4], float* yrow, const float* g2, const float* b2, int lane) {
    f32x4 hv[4]; float sm = 0.f;
#pragma unroll
    for (int j = 0; j < 4; ++j) {
        const unsigned h0 = (unsigned)h[j], h1 = (unsigned)(h[j] >> 32), p0 = (unsigned)po[j], p1 = (unsigned)(po[j] >> 32);
        hv[j] = (f32x4){bflo(h0), bfhi(h0), bflo(h1), bfhi(h1)} * ALPHA + (f32x4){bflo(p0), bfhi(p0), bflo(p1), bfhi(p1)};
        sm += (hv[j][0] + hv[j][1]) + (hv[j][2] + hv[j][3]);
    }
    const float mean = wave_sum(sm) * (1.f / 1024.f); float s2 = 0.f;
#pragma unroll
    for (int q = 0; q < 4; ++q) { hv[q] = hv[q] - mean; s2 += (hv[q][0] * hv[q][0] + hv[q][1] * hv[q][1]) + (hv[q][2] * hv[q][2] + hv[q][3] * hv[q][3]); }
    const float rstd = 1.f / sqrtf(wave_sum(s2) * (1.f / 1024.f) + LN_EPS);
#pragma unroll
    for (int j = 0; j < 4; ++j) ((f32x4*)yrow)[lane + 64 * j] = hv[j] * rstd * ((const f32x4*)g2)[lane + 64 * j] + ((const f32x4*)b2)[lane + 64 * j];
}

__device__ __forceinline__ void peer_phase(Frame& F, const XcdBarrier& bar, unsigned* pace, const int mode) {
    LAS u16* EI = (LAS u16*)(F.lds);
    LAS bf16* GWb = (LAS bf16*)(F.lds + 32768);
    LAS int* Di = (LAS int*)(F.lds + 65536);
    LAS float* Df = (LAS float*)(F.lds + 65536);
    LAS unsigned char* SK = F.lds + 65536;
    LAS unsigned char* Dq = F.lds + 131072;
    LAS float* CS = (LAS float*)(F.lds + 131072 + 16384);
    const bf16* HB = (const bf16*)(F.ws + WS_HB); const unsigned char* H8 = F.ws + WS_H8; const float* HS = (const float*)(F.ws + WS_HS);
    const unsigned char* PU8 = F.ws + WS_PU; const float* US = (const float*)(F.ws + WS_US); const unsigned char* PV8 = F.ws + WS_PV;
    const bf16* SUBK = (const bf16*)(F.ws + WS_SUBK);
    bf16* PO = (bf16*)(F.ws + WS_PO);
    const int w = F.wave;
    for (int blk = blockIdx.x; blk < T / 256; blk += F.G)
        for (int half = 0; half < 2; ++half) {
            int blk_o = blk; asm volatile("" : "+s"(blk_o));
            const size_t tokb = (size_t)blk_o * 256 + (size_t)half * 128;
            {
#define SK_ISSUE(stage, buf) do { const bf16* src_ = SUBK + (size_t)(stage) * 128 * 128; \
        const int ln_ = opaque_v(F.lane);     \
        _Pragma("unroll") for (int q_ = 0; q_ < 4; ++q_) { const int kr_ = 16 * w + 4 * q_ + (ln_ >> 4), pos_ = ln_ & 15, ch_ = pos_ ^ (kr_ & 15);     \
            __builtin_amdgcn_global_load_lds((const unsigned*)(src_ + (size_t)kr_ * 128 + 8 * ch_), (LAS unsigned*)(SK + (buf) * 32768 + (16 * w + 4 * q_) * 256), 16, 0, 0); } } while (0)
                unsigned top0[16], top1[16];
                SK_ISSUE(0, 0);
                for (int hh = 0; hh < 8; ++hh) {
                    __syncthreads();
                    SK_ISSUE(2 * hh + 1, 1);
                    peer_route_scores(F, tokb, hh, 0, SK, top0);
                    __syncthreads();
                    if (hh < 7) SK_ISSUE(2 * hh + 2, 0);
                    peer_route_scores(F, tokb, hh, 1, SK + 32768, top1);
#ifdef PEER_CANDS_REDUNDANT
                    peer_route_cands(F, hh, top0, top1, EI, GWb);
#else
                    peer_route_cands(F, hh, top0, top1, EI, GWb, (LAS unsigned*)(F.lds + 131072));
#endif
                }
                __syncthreads();
#undef SK_ISSUE
            }
            const int lane = opaque_v(F.lane), r = lane >> 3, c = lane & 7;
#if defined(PEER_U_INT4) && defined(PEER_U_DOT8) && defined(PEER_U_TOKMAJOR)
            if (mode & 1) {
                const unsigned c16 = 16u * (unsigned)c;
                v4u uA[16], uB[16], hA0, hA1, hB0, hB1; unsigned e[16]; int AH[16], AL[16];
#define U_LOAD(UU, H0, H1, t, s) do { const int tl_ = 16 * w + (t); const unsigned char* us_ = PU8 + (size_t)(s) * (16384 * 128); \
        const unsigned char* hrow_ = H8 + (tokb + tl_) * 1024 + 256 * (s);     \
        H0 = *(const v4u*)(hrow_ + 2u * c16); H1 = *(const v4u*)(hrow_ + 2u * c16 + 16u); \
        _Pragma("unroll") for (int g = 0; g < 16; ++g) UU[g] = *(const v4u*)(us_ + e[g]); } while (0)
#define U_ACC0(UU, H0, H1) _Pragma("unroll") for (int g = 0; g < 16; ++g) sdot32_i4_planes_init(UU[g], H0, H1, AH[g], AL[g])
#define U_ACC(UU, H0, H1) _Pragma("unroll") for (int g = 0; g < 16; ++g) sdot32_i4_planes_acc(UU[g], H0, H1, AH[g], AL[g])
#define U_FIN(t) do { const int tl_ = 16 * w + (t); int d_[16]; \
        _Pragma("unroll") for (int g = 0; g < 16; ++g) d_[g] = isum8_lo((AH[g] << 4) + AL[g]); \
        if (c == 0) { LAS int* p_ = Di + tl_ * 128 + r * 16; \
            _Pragma("unroll") for (int q = 0; q < 4; ++q) *(LAS v4u*)(p_ + 4 * q) = (v4u){(unsigned)d_[4 * q], (unsigned)d_[4 * q + 1], (unsigned)d_[4 * q + 2], (unsigned)d_[4 * q + 3]}; } } while (0)
                load_eoffs(EI, 16 * w, r, c16, e);
                U_LOAD(uA, hA0, hA1, 0, 0);
#pragma unroll 1
                for (int t = 0; t < 16; ++t) {
                    U_LOAD(uB, hB0, hB1, t, 1);
                    U_ACC0(uA, hA0, hA1);
                    asm volatile("" ::: "memory");
                    U_LOAD(uA, hA0, hA1, t, 2);
                    U_ACC(uB, hB0, hB1);
                    asm volatile("" ::: "memory");
                    U_LOAD(uB, hB0, hB1, t, 3);
                    U_ACC(uA, hA0, hA1);
                    asm volatile("" ::: "memory");
                    { const int tn = t + 1 < 16 ? t + 1 : 15; load_eoffs(EI, 16 * w + tn, r, c16, e); U_LOAD(uA, hA0, hA1, tn, 0); }
                    U_ACC(uB, hB0, hB1);
                    U_FIN(t);
                    asm volatile("" ::: "memory");
                }
#undef U_LOAD
#undef U_ACC0
#undef U_ACC
#undef U_FIN
            }
#elif defined(PEER_U_INT4)
            if (mode & 1) for (int s = 0; s < 4; ++s) {
                const unsigned char* us = PU8 + (size_t)s * (16384 * 128);
                const unsigned c16 = 16u * (unsigned)c;
                v4u uA[16], uB[16], hA0, hA1, hB0, hB1; unsigned e[16];
#ifdef PEER_U_DOT8
#define U_DOTS(UU, H0, H1) _Pragma("unroll") for (int g = 0; g < 16; ++g) d_[g] = sdot32_i4_planes(UU[g], H0, H1)
#else
#define U_DOTS(UU, H0, H1) unsigned he_[4], ho_[4];     \
        he_[0] = __builtin_amdgcn_perm(H0.y, H0.x, 0x06040200u); ho_[0] = __builtin_amdgcn_perm(H0.y, H0.x, 0x07050301u); \
        he_[1] = __builtin_amdgcn_perm(H0.w, H0.z, 0x06040200u); ho_[1] = __builtin_amdgcn_perm(H0.w, H0.z, 0x07050301u); \
        he_[2] = __builtin_amdgcn_perm(H1.y, H1.x, 0x06040200u); ho_[2] = __builtin_amdgcn_perm(H1.y, H1.x, 0x07050301u); \
        he_[3] = __builtin_amdgcn_perm(H1.w, H1.z, 0x06040200u); ho_[3] = __builtin_amdgcn_perm(H1.w, H1.z, 0x07050301u); \
        _Pragma("unroll") for (int g = 0; g < 16; ++g) d_[g] = sdot32_i4(UU[g], he_, ho_)
#endif
#define U_LOAD(UU, H0, H1, t) do { const int tl_ = 16 * w + (t); load_eoffs(EI, tl_, r, c16, e); \
        H0 = *(const v4u*)(H8 + (tokb + tl_) * 1024 + 256 * s + 32 * c); H1 = *(const v4u*)(H8 + (tokb + tl_) * 1024 + 256 * s + 32 * c + 16); \
        _Pragma("unroll") for (int g = 0; g < 16; ++g) UU[g] = *(const v4u*)(us + e[g]); } while (0)
#ifdef PEER_U_PLAINRED
#define U_COMP(UU, H0, H1, t) do { const int tl_ = 16 * w + (t); int d_[16]; \
        U_DOTS(UU, H0, H1); \
        _Pragma("unroll") for (int g = 0; g < 16; ++g) d_[g] = isum8_lo(d_[g]); \
        if (c == 0) { LAS int* p_ = Di + tl_ * 128 + r * 16; \
            if (s == 0) { _Pragma("unroll") for (int q = 0; q < 4; ++q) *(LAS v4u*)(p_ + 4 * q) = (v4u){(unsigned)d_[4 * q], (unsigned)d_[4 * q + 1], (unsigned)d_[4 * q + 2], (unsigned)d_[4 * q + 3]}; } \
            else { _Pragma("unroll") for (int q = 0; q < 4; ++q) { const v4u o_ = *(const LAS v4u*)(p_ + 4 * q); *(LAS v4u*)(p_ + 4 * q) = (v4u){o_.x + (unsigned)d_[4 * q], o_.y + (unsigned)d_[4 * q + 1], o_.z + (unsigned)d_[4 * q + 2], o_.w + (unsigned)d_[4 * q + 3]}; } } } } while (0)
#else
#define U_COMP(UU, H0, H1, t) do { const int tl_ = 16 * w + (t); int d_[16], o0_, o1_; \
        U_DOTS(UU, H0, H1); \
        ured16_lo(d_, o0_, o1_, lane); \
        LAS u64* p_ = (LAS u64*)(Di + tl_ * 128 + r * 16 + g0); \
        if (s == 0) *p_ = (u64)(unsigned)o0_ | ((u64)(unsigned)o1_ << 32); \
        else { const u64 v_ = *p_; *p_ = (u64)((unsigned)v_ + (unsigned)o0_) | ((u64)((unsigned)(v_ >> 32) + (unsigned)o1_) << 32); } } while (0)
                const int g0 = (lane & 2) + ((lane & 1) << 2) + ((lane & 4) << 1);
#endif
                U_LOAD(uA, hA0, hA1, 0);
                for (int t = 0; t < 16; t += 2) {
                    U_LOAD(uB, hB0, hB1, t + 1);
                    U_COMP(uA, hA0, hA1, t);
                    if (t + 2 < 16) U_LOAD(uA, hA0, hA1, t + 2);
                    U_COMP(uB, hB0, hB1, t + 1);
                }
#undef U_LOAD
#undef U_COMP
#undef U_DOTS
            }
#else
            if (mode & 1) for (int s = 0; s < 8; ++s) {
                if (mode & 8) xcd_pace(bar, pace);
                const unsigned char* us = PU8 + (size_t)s * (16384 * 128) + 16 * c;
                v4u uA[16], uB[16], hA, hB; unsigned e[16];
#define U_LOAD(UU, HH, t) do { const int tl_ = 16 * w + (t); load_eids(EI, tl_, r, e); HH = *(const v4u*)(H8 + (tokb + tl_) * 1024 + 128 * s + 16 * c); \
        _Pragma("unroll") for (int g = 0; g < 16; ++g) UU[g] = *(const v4u*)(us + (size_t)e[g] * 128); } while (0)
#define U_COMP(UU, HH, t) do { const int tl_ = 16 * w + (t); int d_[16]; \
        _Pragma("unroll") for (int g = 0; g < 16; ++g) d_[g] = sdot16(UU[g], HH, 0); \
        _Pragma("unroll") for (int g = 0; g < 16; ++g) d_[g] = isum8_lo(d_[g]); \
        if (c == 0) { LAS int* p_ = Di + tl_ * 128 + r * 16; \
            if (s == 0) { _Pragma("unroll") for (int q = 0; q < 4; ++q) *(LAS v4u*)(p_ + 4 * q) = (v4u){(unsigned)d_[4 * q], (unsigned)d_[4 * q + 1], (unsigned)d_[4 * q + 2], (unsigned)d_[4 * q + 3]}; } \
            else { _Pragma("unroll") for (int q = 0; q < 4; ++q) { const v4u o_ = *(const LAS v4u*)(p_ + 4 * q); *(LAS v4u*)(p_ + 4 * q) = (v4u){o_.x + (unsigned)d_[4 * q], o_.y + (unsigned)d_[4 * q + 1], o_.z + (unsigned)d_[4 * q + 2], o_.w + (unsigned)d_[4 * q + 3]}; } } } } while (0)
                U_LOAD(uA, hA, 0);
                for (int t = 0; t < 16; t += 2) {
                    U_LOAD(uB, hB, t + 1);
                    U_COMP(uA, hA, t);
                    if (t + 2 < 16) U_LOAD(uA, hA, t + 2);
                    U_COMP(uB, hB, t + 1);
                }
#undef U_LOAD
#undef U_COMP
            }
#endif
            LDS_WAIT();
            {
                const float* VS = (const float*)(F.ws + WS_VS);
                for (int t4 = 0; t4 < 16; t4 += 4) {
                    float us0[4], us1[4], vs0[4], vs1[4], hs[4];
#pragma unroll
                    for (int q = 0; q < 4; ++q) { const int tl = 16 * w + t4 + q, i0 = tl * 128 + lane; const unsigned e0 = EI[i0], e1 = EI[i0 + 64];
                        us0[q] = US[e0]; us1[q] = US[e1]; vs0[q] = VS[e0]; vs1[q] = VS[e1]; hs[q] = HS[tokb + tl]; }
#pragma unroll
                    for (int q = 0; q < 4; ++q) {
                        const int tl = 16 * w + t4 + q, i0 = tl * 128 + lane, i1 = i0 + 64;
                        const float c0 = bflo((unsigned)GWb[i0]) * gelu_erf((float)Di[i0] * us0[q] * hs[q]) * vs0[q];
                        const float c1 = bflo((unsigned)GWb[i1]) * gelu_erf((float)Di[i1] * us1[q] * hs[q]) * vs1[q];
                        const float m = fmaxf(wave_max(fmaxf(fabsf(c0), fabsf(c1))), 1e-30f), inv = 127.0f / m;
                        Dq[i0] = (unsigned char)(__float2int_rn(c0 * inv) & 0xff); Dq[i1] = (unsigned char)(__float2int_rn(c1 * inv) & 0xff);
                        if (lane == 0) CS[tl] = m * (1.0f / 127.0f);
                    }
                }
            }
            LDS_WAIT();
            if (mode & 2) for (int s = 0; s < 8; ++s) {
                if (mode & 8) xcd_pace(bar, pace);
                const unsigned char* vs = PV8 + (size_t)s * (16384 * 128);
                const unsigned c16 = 16u * (unsigned)c;
                v4u vA[16], vB[16]; unsigned e[16];
#define V_LOAD(VV, t) do { const int tl_ = 16 * w + (t); load_eoffs(EI, tl_, r, c16, e); \
        _Pragma("unroll") for (int g = 0; g < 16; ++g) VV[g] = *(const v4u*)(vs + e[g]); } while (0)
#define V_COMP(VV, t) do { const int tl_ = 16 * w + (t); int acc[16]; \
        const v4u cq_ = *(const LAS v4u*)(Dq + tl_ * 128 + r * 16); \
        tr_dot4_z(VV[0], VV[1], VV[2], VV[3], cq_.x, acc); tr_dot4(VV[4], VV[5], VV[6], VV[7], cq_.y, acc); \
        tr_dot4(VV[8], VV[9], VV[10], VV[11], cq_.z, acc); tr_dot4(VV[12], VV[13], VV[14], VV[15], cq_.w, acc); \
        int d0_, d1_; vred16_hi(acc, d0_, d1_, lane);     \
        { const float cs_ = CS[tl_]; *(unsigned*)(PO + (tokb + tl_) * 1024 + 128 * s + 16 * c + 2 * r) = pk2((float)d0_ * cs_, (float)d1_ * cs_); } } while (0)
                V_LOAD(vA, 0);
                for (int t = 0; t < 16; t += 2) {
                    V_LOAD(vB, t + 1);
                    V_COMP(vA, t);
                    if (t + 2 < 16) V_LOAD(vA, t + 2);
                    V_COMP(vB, t + 1);
                }
#undef V_LOAD
#undef V_COMP
            }
            VM_WAIT();
            __syncthreads();
            if (mode & 4) for (int t = 0; t < 16; t += 4) {
                u64 hh_[4][4], pp_[4][4];
#pragma unroll
                for (int q = 0; q < 4; ++q)
#pragma unroll
                    for (int j = 0; j < 4; ++j) { const size_t tok = tokb + 16 * w + t + q; hh_[q][j] = ((const u64*)(HB + tok * 1024))[lane + 64 * j]; pp_[q][j] = ((const u64*)(PO + tok * 1024))[lane + 64 * j]; }
#pragma unroll
                for (int q = 0; q < 4; ++q) ln2_store(hh_[q], pp_[q], F.out + (tokb + 16 * w + t + q) * 1024, karg_in(19), karg_in(20), lane);
            }
            __syncthreads();
        }
}

struct Args { const float* in[21]; float* out; unsigned char* ws; int ph_lo, ph_hi, li, pad; };

__global__ void __launch_bounds__(NTHR, 2) mega_fwd(Args args) {
    extern __shared__ __attribute__((aligned(16))) unsigned char lds_raw[];
    Frame F;
    F.lds = (LAS unsigned char*)lds_raw;
    F.tid = threadIdx.x; F.lane = F.tid & 63; F.wave = __builtin_amdgcn_readfirstlane(F.tid >> 6); F.fr = F.lane & 15; F.fq = F.lane >> 4;
    F.G = gridDim.x;
    F.out = args.out; F.ws = args.ws;
    unsigned char* ws = args.ws;
    gu32* ctl = (gu32*)(ws + WS_CTL);
    volatile LAS unsigned* MISC = (volatile LAS unsigned*)(F.lds + MISC_OFF);
    for (int u = F.tid; u < (LDS_BYTES - LDSCTL_OFF) / 4; u += NTHR) ((LAS unsigned*)(F.lds + LDSCTL_OFF))[u] = 0u;
    __syncthreads();
    XcdBarrier bar; bar.bar = (unsigned*)(ctl + CW_BAR) + args.li * XCD_BAR_WORDS; bar.x = 0; bar.st = nullptr;
    if (N_LAUNCHES != N_PHASES) bar = xcd_barrier_post((unsigned*)(ctl + CW_BAR) + args.li * XCD_BAR_WORDS, MISC + 8);
#define GRID_BAR() do { if (N_LAUNCHES != N_PHASES) xcd_barrier(bar); } while (0)
    const int lo = args.ph_lo, hi = args.ph_hi;
#define FRAME_REFRESH() do { int t_ = threadIdx.x; asm volatile("" : "+v"(t_)); F.tid = t_; F.lane = t_ & 63; F.fr = F.lane & 15; F.fq = F.lane >> 4; } while (0)
#define IN(k) (lo <= (k) && (k) < hi)
#define BOTH(k) (IN(k) && IN((k) + 1))

    bf16* XB = (bf16*)args.out;
#ifndef PEER_MODE
#define PEER_MODE 7
#endif
#ifndef REP_MASK
#define REP_MASK 0
#endif
#define NREP(k) ((((REP_MASK) >> (k)) & 1) + 1)
#define SEAM(k, r) do { if (BOTH(k) || (r) + 1 < NREP(k)) GRID_BAR(); } while (0)
    FRAME_REFRESH();
    if (IN(0)) for (int r_ = 0; r_ < NREP(0); ++r_) { p0_prologue(F); SEAM(0, r_); }
    FRAME_REFRESH();
    if (IN(1)) for (int r_ = 0; r_ < NREP(1); ++r_) {
#ifdef GEMM_F8
        { pg8::Gemm g{XB, (const bf16*)(ws + WS_WIN), T, INW, 1024}; pg8::SubsetOrder S; S.init(T, P1_BF16_TILES, F.G, (int)blockIdx.x);
          pg8::EpiInProj E{(bf16*)(ws + WS_AQ), (bf16*)(ws + WS_AK), (bf16*)(ws + WS_AV), (bf16*)(ws + WS_RQ), (bf16*)(ws + WS_RK), (bf16*)(ws + WS_RV), (bf16*)(ws + WS_RG), (bf16*)(ws + WS_MQ), (bf16*)(ws + WS_G), (const float*)(ws + WS_BIASP), 1.0f};
          pg8::gemm_phase<pg8::EpiInProj, pg8::SubsetOrder, true, true, false>(F.lds, g, S, E); }
        { pg8::Gemm g{(const bf16*)((const unsigned char*)args.out + (size_t)T * 2048), (const bf16*)(ws + WS_WIN8), T, INW, 1024}; pg8::SubsetOrder S; S.init(T, 0x7fffffu & ~P1_BF16_TILES, F.G, (int)blockIdx.x);
          pg8::EpiInProj E{(bf16*)(ws + WS_AQ), (bf16*)(ws + WS_AK), (bf16*)(ws + WS_AV), (bf16*)(ws + WS_RQ), (bf16*)(ws + WS_RK), (bf16*)(ws + WS_RV), (bf16*)(ws + WS_RG), (bf16*)(ws + WS_MQ), (bf16*)(ws + WS_G), (const float*)(ws + WS_BIASP), 1.0f / W8_SCALE};
          pg8::gemm_phase<pg8::EpiInProj, pg8::SubsetOrder, true, P1F8_SP2, true>(F.lds, g, S, E); }
#else
        { pg8::Gemm g{XB, (const bf16*)(ws + WS_WIN), T, INW, 1024}; pg8::StaticOrder S; S.init(T, INW, F.G, (int)blockIdx.x);
          pg8::EpiInProj E{(bf16*)(ws + WS_AQ), (bf16*)(ws + WS_AK), (bf16*)(ws + WS_AV), (bf16*)(ws + WS_RQ), (bf16*)(ws + WS_RK), (bf16*)(ws + WS_RV), (bf16*)(ws + WS_RG), (bf16*)(ws + WS_MQ), (bf16*)(ws + WS_G), (const float*)(ws + WS_BIASP), 1.0f};
          pg8::gemm_phase<pg8::EpiInProj, pg8::StaticOrder, P1_ALIGN, P1_SP2, false>(F.lds, g, S, E); }
#endif
        { pg8::Gemm g{(const bf16*)(ws + WS_MEMN), (const bf16*)(ws + WS_WMKV), 2048, 1024, 1024}; pg8::StaticOrder S; S.init(2048, 1024, F.G, (int)blockIdx.x);
          pg8::EpiMkv E{(bf16*)(ws + WS_MK), (bf16*)(ws + WS_MVT)};
          pg8::gemm_phase<pg8::EpiMkv, pg8::StaticOrder, true, true>(F.lds, g, S, E); }
        SEAM(1, r_);
    }
    FRAME_REFRESH();
    if (IN(2)) for (int r_ = 0; r_ < NREP(2); ++r_) {
        kvinc_phase(F);
        SEAM(2, r_);
    }
    FRAME_REFRESH();
    if (IN(3)) for (int r_ = 0; r_ < NREP(3); ++r_) { scan_phase(F); SEAM(3, r_); }
    FRAME_REFRESH();
    if (IN(4)) {
        const int m4 = (args.pad && !IN(9)) ? args.pad : 7;
        if (m4 & 1) swa_phase(F);
#ifdef EXP_RET
        if (m4 & 2) ret_phase(F, m4);
#else
        if (m4 & 2) ret_phase(F);
#endif
        if (m4 & 4) for (int u = blockIdx.x; u < NBATCH * 4 * 8; u += F.G) xattn_unit(F, u >> 5, (u >> 3) & 3, u & 7);
        if (BOTH(4)) GRID_BAR();
    }
    FRAME_REFRESH();
    if (IN(5)) for (int r_ = 0; r_ < NREP(5); ++r_) {
#ifdef P5_STAGGER
#ifdef P5_STAGGER4
        for (int i_ = 0; i_ < (int)((blockIdx.x >> 3) & 3) * P5_STAGGER; ++i_) __builtin_amdgcn_s_sleep(64);
#else
        if ((blockIdx.x >> 3) & 1) for (int i_ = 0; i_ < P5_STAGGER; ++i_) __builtin_amdgcn_s_sleep(127);
#endif
#endif
        pg8::StaticOrder3 S; S.init(T, 1024, F.G, (int)blockIdx.x);
        static_assert(WS_WBR - WS_WBA == WS_WBM - WS_WBR, "the three branch weights are equally spaced in d_ws");
#ifdef GEMM56_F8
        pg8::Gemm3 g{(const bf16*)F.out, (const bf16*)(ws + WS_WBA), (size_t)T * 256, (WS_WBR - WS_WBA) / 2, T, 1024, 512};
#ifdef P6_BF16
        pg8::EpiGate3 E{(bf16*)(ws + WS_MERGED), (const bf16*)(ws + WS_G), 0.f, 1.0f / (BR8_SCALE * W8_SCALE)};
#else
        pg8::EpiGate3 E{(bf16*)(ws + WS_MERGED), (const bf16*)(ws + WS_G), MG8_SCALE / (BR8_SCALE * W8_SCALE), 1.0f};
#endif
#ifdef EXP_P5MID
        E.skipmid = args.pad & 64;
#endif
        pg8::gemm_phase3<pg8::EpiGate3, pg8::StaticOrder3, P5_ALIGN, P5F8_SP2, true>(F.lds, g, S, E);
#else
        pg8::Gemm3 g{(const bf16*)F.out, (const bf16*)(ws + WS_WBA), (size_t)T * 512, (WS_WBR - WS_WBA) / 2, T, 1024, 512};
        pg8::EpiGate3 E{(bf16*)(ws + WS_MERGED), (const bf16*)(ws + WS_G), 0.f, 1.0f};
        pg8::gemm_phase3<pg8::EpiGate3, pg8::StaticOrder3, true, true>(F.lds, g, S, E);
#endif
        SEAM(5, r_);
    }
    FRAME_REFRESH();
    if (IN(6)) for (int r_ = 0; r_ < NREP(6); ++r_) {
        pg8::Gemm g{(const bf16*)(ws + WS_MERGED), (const bf16*)(ws + WS_WOUT), T, 1024, 1024}; pg8::RowOrder S; S.init(T, 1024, F.G, (int)blockIdx.x);
#if defined(GEMM56_F8) && !defined(P6_BF16)
        { pg8::EpiResid3 E3; E3.X = karg_in(0); E3.out = (bf16*)(ws + WS_HB); E3.alpha = ALPHA; E3.ascale = 1.0f / (MG8_SCALE * W8_SCALE);
          pg8::Gemm3 g3{(const bf16*)(ws + WS_MERGED), (const bf16*)(ws + WS_WOUT), 0, 0, T, 1024, 1024}; pg8::RowOrderSeg2 S3; S3.init(T, 1024, F.G, (int)blockIdx.x);
          pg8::gemm_phase3<pg8::EpiResid3, pg8::RowOrderSeg2, P6_ALIGN, P6_SP2, true>(F.lds, g3, S3, E3); }
#else
        pg8::EpiResid E{karg_in(0), (bf16*)(ws + WS_HB), ALPHA, 1.0f};
        pg8::gemm_phase<pg8::EpiResid, pg8::RowOrder, true, true>(F.lds, g, S, E);
#endif
        VM_WAIT(); __syncthreads();
        if (r_ + 1 < NREP(6)) GRID_BAR();
    }
    FRAME_REFRESH();
    if (IN(7)) for (int r_ = 0; r_ < NREP(7); ++r_) {
        for (int blk = blockIdx.x; blk < T / 256; blk += F.G)
            for (int st = 0; st < 8; ++st) {
                const size_t m0 = (size_t)blk * 256 + 32 * F.wave + 4 * st;
                f32x4 v[4][4];
#pragma unroll
                for (int q = 0; q < 4; ++q)
#pragma unroll
                    for (int j = 0; j < 4; ++j) {
                        const u64 a = ((const u64*)((const bf16*)(ws + WS_HB) + (m0 + q) * 1024))[F.lane + 64 * j];
                        v[q][j] = (f32x4){bflo((unsigned)a), bfhi((unsigned)a), bflo((unsigned)(a >> 32)), bfhi((unsigned)(a >> 32))};
                    }
#pragma unroll
                for (int q = 0; q < 4; ++q) { const size_t mm = m0 + q;
                    ln1_finish(v[q], karg_in(13), karg_in(14), (bf16*)(ws + WS_HB) + mm * 1024, ws + WS_H8 + mm * 1024, (float*)(ws + WS_HS) + mm, F.lane); }
            }
        VM_WAIT(); __syncthreads();
        if (r_ + 1 < NREP(7)) GRID_BAR();
    }
    FRAME_REFRESH();
    if (IN(8)) for (int r_ = 0; r_ < NREP(8); ++r_) {
        pg8::Gemm g{(const bf16*)(ws + WS_HB), (const bf16*)(ws + WS_WPQ), T, 2048, 1024}; pg8::RowOrder S; S.init(T, 2048, F.G, (int)blockIdx.x);
        pg8::EpiBf16<0> E{(bf16*)(ws + WS_PQ), 2048, nullptr, 0, 0, 1.f};
        pg8::gemm_phase<pg8::EpiBf16<0>, pg8::RowOrder, true, true>(F.lds, g, S, E);
        VM_WAIT(); __syncthreads();
        if (r_ + 1 < NREP(8)) GRID_BAR();
    }
    FRAME_REFRESH();
    if (IN(9)) for (int r_ = 0; r_ < NREP(9); ++r_) {
        if (!IN(8)) GRID_BAR();
        peer_phase(F, bar, (unsigned*)(ctl + CW_PACE), args.pad ? args.pad : PEER_MODE);
        SEAM(9, r_);
    }
#ifdef EXP_SAMETILE
    if (IN(10)) {
        pg8::Gemm g{(const bf16*)(ws + WS_HB), (const bf16*)(ws + WS_WPQ), T, 2048, 1024}; pg8::SameTileOrder S{8};
        pg8::EpiBf16<0> E{(bf16*)(ws + WS_PQ), 2048, nullptr, 0, 0, 1.f};
        pg8::gemm_phase<pg8::EpiBf16<0>, pg8::SameTileOrder, true, true>(F.lds, g, S, E);
    }
#endif
#undef IN
#undef BOTH
#undef GRID_BAR
}

extern "C" void kernel_launch(void* const* d_in, const int* in_sizes, int n_in, void* d_out, int out_size, void* d_ws, size_t ws_size, hipStream_t stream) {
    static int grid = 0;
    if (grid == 0) {
        if (n_in != 21 || out_size != T * D || ws_size < WS_END) { fprintf(stderr, "kernel_launch: unexpected problem (n_in %d, out %d, ws %zu); nothing launched\n", n_in, out_size, ws_size); grid = -1; return; }
        int dev = 0, cus = 0, per_cu = 0;
        if (hipGetDevice(&dev) != hipSuccess || hipDeviceGetAttribute(&cus, hipDeviceAttributeMultiprocessorCount, dev) != hipSuccess) { grid = -1; return; }
        if (hipFuncSetAttribute((const void*)mega_fwd, hipFuncAttributeMaxDynamicSharedMemorySize, LDS_BYTES) != hipSuccess) { fprintf(stderr, "kernel_launch: hipFuncSetAttribute failed\n"); grid = -1; return; }
        if (hipOccupancyMaxActiveBlocksPerMultiprocessor(&per_cu, (const void*)mega_fwd, NTHR, LDS_BYTES) != hipSuccess || per_cu < 1) { fprintf(stderr, "kernel_launch: occupancy query says %d blocks per CU\n", per_cu); per_cu = 1; }
        (void)hipGetLastError();
        grid = cus;
    }
    if (grid < 0) return;
    (void)hipMemsetAsync((char*)d_ws + WS_CTL, 0, CTL_ZERO_BYTES, stream);
    Args a{};
    for (int i = 0; i < 21; ++i) a.in[i] = (const float*)d_in[i];
    a.out = (float*)d_out; a.ws = (unsigned char*)d_ws;
#ifdef EXTRA_PHASE
    if (N_LAUNCHES == 1) {
#ifdef EXP_SAMETILE
        a.ph_lo = 0; a.ph_hi = N_PHASES; a.li = 0; hipLaunchKernelGGL(mega_fwd, dim3(grid), dim3(NTHR), LDS_BYTES, stream, a);
        a.ph_lo = 10; a.ph_hi = 11; a.li = 1; hipLaunchKernelGGL(mega_fwd, dim3(grid), dim3(NTHR), LDS_BYTES, stream, a);
#else
        a.ph_lo = 0; a.ph_hi = EXTRA_PHASE + 1; a.li = 0;
#ifdef EXTRA_PEER_MODE
        a.pad = EXTRA_PEER_MODE;
#endif
        hipLaunchKernelGGL(mega_fwd, dim3(grid), dim3(NTHR), LDS_BYTES, stream, a);
        a.pad = 0;
        a.ph_lo = EXTRA_PHASE; a.ph_hi = N_PHASES; a.li = 1;
        hipLaunchKernelGGL(mega_fwd, dim3(grid), dim3(NTHR), LDS_BYTES, stream, a);
#endif
    } else {
#else
    if (N_LAUNCHES == 1) {
        a.ph_lo = 0; a.ph_hi = N_PHASES; a.li = 0;
        hipLaunchKernelGGL(mega_fwd, dim3(grid), dim3(NTHR), LDS_BYTES, stream, a);
    } else {
#endif
        for (int li = 0; li < N_PHASES; ++li) { a.ph_lo = li; a.ph_hi = li + 1; a.li = 0; hipLaunchKernelGGL(mega_fwd, dim3(grid), dim3(NTHR), LDS_BYTES, stream, a); }
    }
}
```
